# Optimizing an MI355X kernel written in HIP

```python
import math
import jax, jax.numpy as jnp
from jax import lax
import numpy as np

D_MODEL = 1024
BATCH = 32
SEQ = 2048
DEPTH = 4

GRID_W = 64
CTX_LEN = 256
EPS = 1e-6
ROPE_BASE = 10000.0
ROT_DIM = 64
Q_BLOCK = 128
CHUNK = 64
N_BRANCH = 4
BRANCH_WIDTH = 512

MLA_HEADS = 4
MLA_NOPE = 128
MLA_ROPE = ROT_DIM
MLA_V = BRANCH_WIDTH // MLA_HEADS
MLA_Q_LORA = 384
MLA_KV_LORA = 256
GLA_HEADS = 4
GLA_DK = 64
GLA_DV = BRANCH_WIDTH // GLA_HEADS
GLA_GATE_RANK = 16
GLA_TAU = 16.0
ML_HEADS = 4
ML_DQK = 64
ML_DV = BRANCH_WIDTH // ML_HEADS
ML_CONV = 3
ML_F_BIAS = 3.0
DF_HEADS = 4
DF_DQK = ROT_DIM
DF_DV = BRANCH_WIDTH // DF_HEADS

IN_SPLITS = (
    ('mla_cq', MLA_Q_LORA), ('mla_ckv', MLA_KV_LORA), ('mla_kr', MLA_ROPE), ('mla_z', BRANCH_WIDTH),
    ('gla_q', GLA_HEADS * GLA_DK), ('gla_k', GLA_HEADS * GLA_DK), ('gla_v', BRANCH_WIDTH),
    ('gla_af', GLA_GATE_RANK), ('gla_ab', GLA_GATE_RANK), ('gla_z', BRANCH_WIDTH),
    ('ml_x', BRANCH_WIDTH), ('ml_v', BRANCH_WIDTH), ('ml_o', BRANCH_WIDTH), ('ml_if', 4 * ML_HEADS),
    ('ml_z', BRANCH_WIDTH),
    ('df_q', DF_HEADS * 2 * DF_DQK), ('df_k', DF_HEADS * 2 * DF_DQK), ('df_v', BRANCH_WIDTH),
    ('df_z', BRANCH_WIDTH),
    ('merge', N_BRANCH * D_MODEL),
)
D_IN = sum(w for _, w in IN_SPLITS)

kernel_name = 'hybrid_mla_gla_mlstm_diffattn_dit_block'

F32 = jnp.float32


def rmsnorm(x, g):
    xf = x.astype(F32)
    y = xf * lax.rsqrt(jnp.mean(xf * xf, axis=-1, keepdims=True) + EPS)
    return (y * g.astype(F32)).astype(x.dtype)


def split_cols(proj):
    out, off = {}, 0
    for name, w in IN_SPLITS:
        out[name] = proj[..., off:off + w]
        off += w
    return out


def axial_rope_tables(rows, n_ctx, dtype):
    quarter = ROT_DIM // 4
    inv_freq = ROPE_BASE ** (-jnp.arange(quarter, dtype=F32) / quarter)
    row = jnp.repeat(jnp.arange(rows, dtype=F32), GRID_W)
    col = jnp.tile(jnp.arange(GRID_W, dtype=F32), rows)
    ar = row[:, None] * inv_freq
    ac = col[:, None] * inv_freq
    ang = jnp.concatenate([ar, ar, ac, ac], axis=-1)
    cos = jnp.concatenate([jnp.ones((n_ctx, ROT_DIM), F32), jnp.cos(ang)], axis=0)
    sin = jnp.concatenate([jnp.zeros((n_ctx, ROT_DIM), F32), jnp.sin(ang)], axis=0)
    return cos.astype(dtype), sin.astype(dtype)


def apply_rope(x, cos, sin):
    a1, a2, b1, b2 = jnp.split(x, 4, axis=-1)
    rot = jnp.concatenate([-a2, a1, -b2, b1], axis=-1)
    return x * cos + rot * sin


def flip_segments(a, n_ctx, axis):
    c_part = lax.slice_in_dim(a, 0, n_ctx, axis=axis)
    l_part = lax.slice_in_dim(a, n_ctx, a.shape[axis], axis=axis)
    return jnp.concatenate([jnp.flip(c_part, axis), jnp.flip(l_part, axis)], axis=axis)


def centred_dwconv(x, w, b):
    pad = w.shape[0] // 2
    y = lax.conv_general_dilated(x, w[:, None, :].astype(x.dtype), window_strides=(1,),
                                 padding=[(pad, pad)], dimension_numbers=('NWC', 'WIO', 'NWC'),
                                 feature_group_count=x.shape[-1])
    return y + b


def _chunks(a):
    B, H, T = a.shape[:3]
    a = a.reshape((B, H, T // CHUNK, CHUNK) + a.shape[3:])
    return jnp.moveaxis(a, 2, 0)


def _unchunks(a):
    a = jnp.moveaxis(a, 0, 2)
    return a.reshape(a.shape[:2] + (-1,) + a.shape[4:])


def mixed_softmax_attention(q, k, v, w, n_ctx, with_ctx):
    B, H, P, T, dq = q.shape
    scale = dq ** -0.5
    wf = w.astype(F32)

    def attend(qb, kb, vb):
        s = jnp.einsum('bhpqd,bhpkd->bhpqk', qb, kb).astype(F32) * scale
        pr = jax.nn.softmax(s, axis=-1)
        pw = jnp.einsum('bhpqk,hp->bhqk', pr, wf)
        return jnp.einsum('bhqk,bhkd->bhqd', pw.astype(vb.dtype), vb)

    n_lat = T - n_ctx
    nb = n_lat // Q_BLOCK
    ql = q[:, :, :, n_ctx:].reshape(B, H, P, nb, Q_BLOCK, dq)
    ql = jnp.moveaxis(ql, 3, 0)
    ol = lax.map(lambda qb: attend(qb, k, v), ql)
    ol = jnp.moveaxis(ol, 0, 2).reshape(B, H, n_lat, v.shape[-1])
    if not with_ctx:
        return ol
    oc = attend(q[:, :, :, :n_ctx], k[:, :, :, :n_ctx], v[:, :, :n_ctx])
    return jnp.concatenate([oc, ol], axis=2)


def gla_chunk_scan(q, k, v, log_a):
    B, H, T, dk = q.shape
    dv = v.shape[-1]
    mask = jnp.tril(jnp.ones((CHUNK, CHUNK), bool))[:, :, None]

    def step(S, inp):
        qc, kc, vc, lac = inp
        b = jnp.cumsum(lac, axis=-2)
        o_inter = jnp.einsum('bhld,bhde->bhle', qc * jnp.exp(b), S)
        diff = jnp.where(mask, b[:, :, :, None, :] - b[:, :, None, :, :], -jnp.inf)
        A = jnp.einsum('bhtd,bhsd,bhtsd->bhts', qc, kc, jnp.exp(diff))
        o_intra = jnp.einsum('bhts,bhse->bhte', A, vc)
        bl = b[:, :, -1:, :]
        S_new = jnp.exp(bl[:, :, 0, :])[..., None] * S + jnp.einsum('bhsd,bhse->bhde', kc * jnp.exp(bl - b), vc)
        return S_new, o_inter + o_intra

    S0 = jnp.zeros((B, H, dk, dv), F32)
    _, o = lax.scan(step, S0, (_chunks(q), _chunks(k), _chunks(v), _chunks(log_a)))
    return _unchunks(o)


def mlstm_chunk_scan(q, k, v, log_i, log_f):
    B, H, T, dk = q.shape
    dv = v.shape[-1]
    mask = jnp.tril(jnp.ones((CHUNK, CHUNK), bool))

    def step(carry, inp):
        C, nv, m = carry
        qc, kc, vc, lic, lfc = inp
        b = jnp.cumsum(lfc, axis=-1)
        log_inter = b + m[..., None]
        log_D = jnp.where(mask, b[..., :, None] - b[..., None, :] + lic[..., None, :], -jnp.inf)
        m_t = jnp.maximum(log_inter, jnp.max(log_D, axis=-1))
        inter_w = jnp.exp(log_inter - m_t)
        s = jnp.einsum('bhtd,bhsd->bhts', qc, kc) * jnp.exp(log_D - m_t[..., None])
        num = inter_w[..., None] * jnp.einsum('bhtd,bhde->bhte', qc, C) + jnp.einsum('bhts,bhse->bhte', s, vc)
        den = inter_w * jnp.einsum('bhtd,bhd->bht', qc, nv) + jnp.sum(s, axis=-1)
        h = num / jnp.maximum(jnp.abs(den), jnp.exp(-m_t))[..., None]
        bL = b[..., -1]
        log_upd = bL[..., None] - b + lic
        m_new = jnp.maximum(bL + m, jnp.max(log_upd, axis=-1))
        decay = jnp.exp(bL + m - m_new)
        wu = jnp.exp(log_upd - m_new[..., None])
        C_new = decay[..., None, None] * C + jnp.einsum('bhs,bhsd,bhse->bhde', wu, kc, vc)
        n_new = decay[..., None] * nv + jnp.einsum('bhs,bhsd->bhd', wu, kc)
        return (C_new, n_new, m_new), h

    init = (jnp.zeros((B, H, dk, dv), F32), jnp.zeros((B, H, dk), F32), jnp.zeros((B, H), F32))
    _, h = lax.scan(step, init, (_chunks(q), _chunks(k), _chunks(v), _chunks(log_i), _chunks(log_f)))
    return _unchunks(h)


def mla_branch(p, cq_g, ckv_g, wuq, wukv, q_g, k_g, cos, sin, n_ctx, t0):
    B, T, _ = p['mla_cq'].shape
    H = MLA_HEADS
    q = (rmsnorm(p['mla_cq'], cq_g) @ wuq).reshape(B, T, H, MLA_NOPE + MLA_ROPE)
    kv = (rmsnorm(p['mla_ckv'], ckv_g) @ wukv).reshape(B, T, H, MLA_NOPE + MLA_V)
    q_nope = rmsnorm(q[..., :MLA_NOPE], q_g[:MLA_NOPE])
    q_rope = apply_rope(rmsnorm(q[..., MLA_NOPE:], q_g[MLA_NOPE:]), cos[:, None], sin[:, None])
    k_nope = rmsnorm(kv[..., :MLA_NOPE], k_g[:MLA_NOPE])
    k_rope = apply_rope(rmsnorm(p['mla_kr'], k_g[MLA_NOPE:]), cos, sin)
    k_rope = jnp.broadcast_to(k_rope[:, :, None, :], (B, T, H, MLA_ROPE))
    qf = jnp.concatenate([q_nope, q_rope], axis=-1).transpose(0, 2, 1, 3)[:, :, None]
    kf = jnp.concatenate([k_nope, k_rope], axis=-1).transpose(0, 2, 1, 3)[:, :, None]
    vf = kv[..., MLA_NOPE:].transpose(0, 2, 1, 3)
    o = mixed_softmax_attention(qf, kf, vf, jnp.ones((H, 1), F32), n_ctx, t0 == 0)
    o = o.transpose(0, 2, 1, 3).reshape(B, -1, BRANCH_WIDTH)
    return o * jax.nn.silu(p['mla_z'][:, t0:])


def gla_branch(p, a_w, a_b, out_g, n_ctx, t0):
    B, T, _ = p['gla_q'].shape
    H = GLA_HEADS

    def heads(a, d):
        return a.reshape(B, T, H, d).transpose(0, 2, 1, 3).astype(F32)

    q = heads(p['gla_q'], GLA_DK) * GLA_DK ** -0.5
    k = heads(p['gla_k'], GLA_DK)
    v = heads(p['gla_v'], GLA_DV)
    la_f = heads(jax.nn.log_sigmoid((p['gla_af'] @ a_w[0] + a_b[0]).astype(F32)) / GLA_TAU, GLA_DK)
    la_b = heads(jax.nn.log_sigmoid((p['gla_ab'] @ a_w[1] + a_b[1]).astype(F32)) / GLA_TAU, GLA_DK)
    o_f = gla_chunk_scan(q, k, v, la_f)
    fl = lambda a: flip_segments(a, n_ctx, 2)
    o_b = fl(gla_chunk_scan(fl(q), fl(k), fl(v), fl(la_b)))
    o = (o_f + o_b).transpose(0, 2, 1, 3)
    o = rmsnorm(o, out_g.reshape(H, GLA_DV)).reshape(B, T, BRANCH_WIDTH).astype(p['gla_z'].dtype)
    return (o * jax.nn.silu(p['gla_z']))[:, t0:]


def mlstm_branch(p, conv_w, conv_b, wq, wk, gate_b, out_g, skip, n_ctx, t0):
    B, T, _ = p['ml_x'].shape
    H = ML_HEADS
    xm = p['ml_x']
    xc = jnp.concatenate([centred_dwconv(xm[:, :n_ctx], conv_w, conv_b),
                          centred_dwconv(xm[:, n_ctx:], conv_w, conv_b)], axis=1)
    xc = jax.nn.silu(xc)
    xh = xc.reshape(B, T, H, ML_DV)
    q = jnp.einsum('bthc,hcd->bhtd', xh, wq).astype(F32)
    k = jnp.einsum('bthc,hcd->bhtd', xh, wk).astype(F32) * ML_DQK ** -0.5
    v = p['ml_v'].reshape(B, T, H, ML_DV).transpose(0, 2, 1, 3).astype(F32)
    g = (p['ml_if'].reshape(B, T, 4, H) + gate_b).astype(F32).transpose(2, 0, 3, 1)
    h_f = mlstm_chunk_scan(q, k, v, g[0], jax.nn.log_sigmoid(g[1]))
    fl = lambda a, ax=2: flip_segments(a, n_ctx, ax)
    h_b = fl(mlstm_chunk_scan(fl(q), fl(k), fl(v), fl(g[2], 2), fl(jax.nn.log_sigmoid(g[3]), 2)))
    h = (h_f + h_b).transpose(0, 2, 1, 3)
    h = jax.nn.sigmoid(p['ml_o'].astype(F32)).reshape(B, T, H, ML_DV) * h
    h = rmsnorm(h, out_g.reshape(H, ML_DV)).reshape(B, T, BRANCH_WIDTH).astype(xm.dtype)
    y = (h + skip * xc) * jax.nn.silu(p['ml_z'])
    return y[:, t0:]


def diff_branch(p, qk_g, lam_p, out_g, lam_init, cos, sin, n_ctx, t0):
    B, T, _ = p['df_q'].shape
    H = DF_HEADS
    cs, sn = cos[:, None, None], sin[:, None, None]
    q = apply_rope(rmsnorm(p['df_q'].reshape(B, T, H, 2, DF_DQK), qk_g[0]), cs, sn)
    k = apply_rope(rmsnorm(p['df_k'].reshape(B, T, H, 2, DF_DQK), qk_g[1]), cs, sn)
    q = q.transpose(0, 2, 3, 1, 4)
    k = k.transpose(0, 2, 3, 1, 4)
    v = p['df_v'].reshape(B, T, H, DF_DV).transpose(0, 2, 1, 3)
    lp = lam_p.astype(F32)
    lam = jnp.exp(jnp.sum(lp[0] * lp[1])) - jnp.exp(jnp.sum(lp[2] * lp[3])) + lam_init
    w = jnp.broadcast_to(jnp.stack([jnp.ones_like(lam), -lam]), (H, 2))
    o = mixed_softmax_attention(q, k, v, w, n_ctx, t0 == 0)
    o = rmsnorm(o, out_g) * (1.0 - lam_init)
    o = o.transpose(0, 2, 1, 3).reshape(B, -1, BRANCH_WIDTH)
    return o * jax.nn.silu(p['df_z'][:, t0:])


def setup_inputs(seed: int = 0) -> dict:
    key = jax.random.key(seed)
    ks = iter(jax.random.split(key, 40))
    L, D = DEPTH, D_MODEL

    def nrm(shape, scale):
        return scale * jax.random.normal(next(ks), shape, F32)

    def gain(shape):
        return 1.0 + nrm(shape, 0.02)

    out = {}
    out['x'] = nrm((BATCH, SEQ, D), 1.0)
    out['c'] = nrm((BATCH, D), 1.0)
    out['ctx'] = nrm((BATCH, CTX_LEN, D), 1.0)
    out['c_ctx'] = nrm((D,), 1.0)
    out['ada_w'] = nrm((L, D, 3 * D), D ** -0.5)
    out['ada_b'] = nrm((L, 3 * D), 0.01)
    out['norm_g'] = gain((L, D))
    out['w_in'] = nrm((L, D, D_IN), D ** -0.5)
    out['mla_cq_g'] = gain((L, MLA_Q_LORA))
    out['mla_ckv_g'] = gain((L, MLA_KV_LORA))
    out['mla_wuq'] = nrm((L, MLA_Q_LORA, MLA_HEADS * (MLA_NOPE + MLA_ROPE)), MLA_Q_LORA ** -0.5)
    out['mla_wukv'] = nrm((L, MLA_KV_LORA, MLA_HEADS * (MLA_NOPE + MLA_V)), MLA_KV_LORA ** -0.5)
    out['mla_q_g'] = gain((L, MLA_NOPE + MLA_ROPE))
    out['mla_k_g'] = gain((L, MLA_NOPE + MLA_ROPE))
    out['gla_a_w'] = nrm((L, 2, GLA_GATE_RANK, GLA_HEADS * GLA_DK), GLA_GATE_RANK ** -0.5)
    out['gla_a_b'] = nrm((L, 2, GLA_HEADS * GLA_DK), 0.01)
    out['gla_out_g'] = gain((L, BRANCH_WIDTH))
    out['ml_conv_w'] = nrm((L, ML_CONV, BRANCH_WIDTH), ML_CONV ** -0.5)
    out['ml_conv_b'] = nrm((L, BRANCH_WIDTH), 0.01)
    out['ml_wq'] = nrm((L, ML_HEADS, ML_DV, ML_DQK), ML_DV ** -0.5)
    out['ml_wk'] = nrm((L, ML_HEADS, ML_DV, ML_DQK), ML_DV ** -0.5)
    out['ml_gate_b'] = jnp.array([0.0, ML_F_BIAS, 0.0, ML_F_BIAS], F32)[None, :, None] + nrm((L, 4, ML_HEADS), 0.1)
    out['ml_out_g'] = gain((L, BRANCH_WIDTH))
    out['ml_skip'] = gain((L, BRANCH_WIDTH))
    out['df_qk_g'] = gain((L, 2, DF_DQK))
    out['df_lambda'] = nrm((L, 4, DF_DQK), 0.1)
    out['df_out_g'] = gain((L, DF_DV))
    out['br_w'] = nrm((L, N_BRANCH, BRANCH_WIDTH, D), BRANCH_WIDTH ** -0.5)
    out['w_out'] = nrm((L, D, D), D ** -0.5)
    return out


def reference(x, c, ctx, c_ctx, ada_w, ada_b, norm_g, w_in, mla_cq_g, mla_ckv_g, mla_wuq, mla_wukv,
              mla_q_g, mla_k_g, gla_a_w, gla_a_b, gla_out_g, ml_conv_w, ml_conv_b, ml_wq, ml_wk,
              ml_gate_b, ml_out_g, ml_skip, df_qk_g, df_lambda, df_out_g, br_w, w_out):
    B, S, D = x.shape
    n_ctx = ctx.shape[1]
    ROWS = S // GRID_W
    cos, sin = axial_rope_tables(ROWS, n_ctx, x.dtype)
    s_c = jax.nn.silu(c)
    s_cc = jax.nn.silu(c_ctx)
    for l in range(DEPTH):
        last = l == DEPTH - 1
        t0 = n_ctx if last else 0
        shift, scale, gate = jnp.split(s_c @ ada_w[l] + ada_b[l], 3, axis=-1)
        shift_c, scale_c, gate_c = jnp.split(s_cc @ ada_w[l] + ada_b[l], 3, axis=-1)
        h = jnp.concatenate([rmsnorm(ctx, norm_g[l]) * (1 + scale_c) + shift_c,
                             rmsnorm(x, norm_g[l]) * (1 + scale[:, None]) + shift[:, None]], axis=1)
        p = split_cols(h @ w_in[l])
        lam_init = 0.8 - 0.6 * math.exp(-0.3 * l)
        ys = (
            mla_branch(p, mla_cq_g[l], mla_ckv_g[l], mla_wuq[l], mla_wukv[l], mla_q_g[l], mla_k_g[l],
                       cos, sin, n_ctx, t0),
            gla_branch(p, gla_a_w[l], gla_a_b[l], gla_out_g[l], n_ctx, t0),
            mlstm_branch(p, ml_conv_w[l], ml_conv_b[l], ml_wq[l], ml_wk[l], ml_gate_b[l], ml_out_g[l],
                         ml_skip[l], n_ctx, t0),
            diff_branch(p, df_qk_g[l], df_lambda[l], df_out_g[l], lam_init, cos, sin, n_ctx, t0),
        )
        gl = p['merge'][:, t0:]
        merged = jax.nn.sigmoid(gl[..., :D]) * (ys[0] @ br_w[l, 0])
        for i in range(1, N_BRANCH):
            merged = merged + jax.nn.sigmoid(gl[..., i * D:(i + 1) * D]) * (ys[i] @ br_w[l, i])
        out = merged @ w_out[l]
        x = x + gate[:, None] * out[:, n_ctx - t0:]
        if not last:
            ctx = ctx + gate_c * out[:, :n_ctx]
    return x
```

```cpp
#include <hip/hip_runtime.h>
#include <cstdio>
#include <cstdint>
#include <cstddef>

#ifndef MK_MULTI
#define MK_MULTI 1
#endif

#define XB_TMO      128
#define XB_XCNT(j)  (256  + 64 * (j))
#define XB_XSUB(j)  (1280 + 64 * (j))
#define XB_XGEN(j)  (2304 + 64 * (j))
#define XB_TOP      3328
#define XB_TOPGEN   3392
#define XCD_BAR_WORDS 3456
#define XB_SPIN_CAP (1u << 18)
#define LAS __attribute__((address_space(3)))

__device__ __forceinline__ unsigned xb_ld(unsigned* p)              { return __hip_atomic_load(p, __ATOMIC_RELAXED, __HIP_MEMORY_SCOPE_AGENT); }
__device__ __forceinline__ unsigned xb_add(unsigned* p, unsigned v) { return __hip_atomic_fetch_add(p, v, __ATOMIC_RELAXED, __HIP_MEMORY_SCOPE_AGENT); }
__device__ __forceinline__ unsigned xb_xcc_id() { return (unsigned)__builtin_amdgcn_s_getreg((3 << 11) | 20) & 0xFu; }
#define XB_SPIN(cond, bar) do { unsigned _sp = 0; while (cond) { __builtin_amdgcn_s_sleep(1); \
    if ((++_sp & 255u) == 0u) { if (xb_ld(&(bar)[XB_TMO])) break; if (_sp > XB_SPIN_CAP) { atomicAdd(&(bar)[XB_TMO], 1u); break; } } } } while (0)

struct XcdBarrier {
    unsigned* bar; unsigned x;
    volatile LAS unsigned* st;
};

__device__ __forceinline__ XcdBarrier xcd_barrier_post(unsigned* bar, volatile LAS unsigned* st) {
    XcdBarrier b; b.bar = bar; b.x = xb_xcc_id(); b.st = st;
    if (threadIdx.x == 0) (void)xb_add(&bar[XB_XCNT(b.x)], 1u);
    return b;
}
__device__ __forceinline__ void xcd_barrier_complete(unsigned* bar, unsigned x, unsigned& nloc, unsigned& nx) {
    const unsigned G = gridDim.x * gridDim.y * gridDim.z;
    unsigned sum, cnt, mine, sp = 0u;
    for (;;) {
        sum = 0u; cnt = 0u; mine = 0u;
#pragma unroll
        for (unsigned j = 0; j < 16; ++j) { const unsigned c = xb_ld(&bar[XB_XCNT(j)]); sum += c; cnt += (c > 0u) ? 1u : 0u; mine = (j == x) ? c : mine; }
        if (sum == G) break;
        __builtin_amdgcn_s_sleep(1);
        if ((++sp & 255u) == 0u) { if (xb_ld(&bar[XB_TMO])) break; if (sp > XB_SPIN_CAP) { atomicAdd(&bar[XB_TMO], 1u); break; } }
    }
    nloc = mine > 0u ? mine : 1u; nx = cnt > 0u ? cnt : 1u;
}

__device__ __forceinline__ void xcd_barrier(const XcdBarrier& b) {
    asm volatile("s_waitcnt vmcnt(0)" ::: "memory");
    __syncthreads();
    if (threadIdx.x == 0) {
        unsigned* bar = b.bar;
        __builtin_amdgcn_s_waitcnt(0);
        unsigned nloc = b.st[0], nx = b.st[1];
        if (nloc == 0u) { xcd_barrier_complete(bar, b.x, nloc, nx); b.st[0] = nloc; b.st[1] = nx; }
        const unsigned old = xb_add(&bar[XB_XSUB(b.x)], 1u);
        const unsigned gen = old / nloc;
        if (old + 1u == (gen + 1u) * nloc) {
            __builtin_amdgcn_fence(__ATOMIC_RELEASE, "agent");
            asm volatile("s_waitcnt vmcnt(0)" ::: "memory");
            const unsigned og = xb_add(&bar[XB_TOP], 1u);
            const unsigned tg = og / nx;
            if (og + 1u == (tg + 1u) * nx) xb_add(&bar[XB_TOPGEN], 1u);
            else XB_SPIN(xb_ld(&bar[XB_TOPGEN]) == tg, bar);
            __builtin_amdgcn_fence(__ATOMIC_ACQUIRE, "agent");
            xb_add(&bar[XB_XGEN(b.x)], 1u);
            asm volatile("s_waitcnt vmcnt(0)" ::: "memory");
        } else {
            XB_SPIN(xb_ld(&bar[XB_XGEN(b.x)]) == gen, bar);
            __builtin_amdgcn_fence(__ATOMIC_ACQUIRE, "agent");
            asm volatile("s_waitcnt vmcnt(0)" ::: "memory");
        }
    }
    __syncthreads();
}

namespace pg8 {
#define PG8_LAS __attribute__((address_space(3)))
typedef unsigned short bf16_t;
typedef short bf16x8 __attribute__((ext_vector_type(8)));
typedef float f32x4 __attribute__((ext_vector_type(4)));
typedef unsigned u32x4 __attribute__((ext_vector_type(4)));
constexpr int BM = 256, BK = 64, HALF = 128, HTB = HALF * BK * 2  , STAGE_BYTES = 8 * HTB, NXCD = 8, WGM = 8;

__host__ __device__ __forceinline__ int lds_byte(int r, int c) { const int st = (r >> 4) * 2 + (c >> 5), rr = r & 15, cc = c & 31, ob = rr * 64 + cc * 2; return st * 1024 + (ob ^ (((ob >> 9) & 1) << 5)); }
__host__ __device__ __forceinline__ void stage_rc(int b, int& R, int& C) { const int st = b / 1024, sb = b % 1024, swz = sb ^ (((sb >> 9) & 1) << 5); R = (st >> 1) * 16 + swz / 64; C = (st & 1) * 32 + (swz % 64) / 2; }
__host__ __device__ __forceinline__ int perm32(int rho) { const int n = rho >> 4, i = rho & 15; return 8 * (i >> 2) + 4 * n + (i & 3); }

struct Unit { int pm, pn; };
struct Gemm { const bf16_t* A; const bf16_t* Bt; int M, N, K, lda; };

struct StaticOrder {
    int nM, nN, nwg, G, c;
    __host__ __device__ void init(int M, int N, int G_, int c_) { nM = M / BM; nN = N / BM; nwg = nM * nN; G = G_; c = c_; }
    __host__ __device__ bool next(int i, Unit& u) const {
        const long L = (long)i * G + c; if (L >= nwg) return false;
        int wgid = (int)L; { const int q = nwg / NXCD, r = nwg % NXCD, xcd = wgid % NXCD, off = wgid / NXCD; wgid = (xcd < r ? xcd * (q + 1) : r * (q + 1) + (xcd - r) * q) + off; }
        const int nig = WGM * nN, gid = wgid / nig, fm = gid * WGM, gsz = (nM - fm) < WGM ? (nM - fm) : WGM;
        u.pm = fm + ((wgid % nig) % gsz); u.pn = (wgid % nig) / gsz; return true;
    }
    __device__ __forceinline__ void a_ready(const Unit&) const {}
    __device__ __forceinline__ void done(const Unit&) const {}
};

template <class Epi, class Sched, bool ALIGN_EPI = false, bool SP2 = false>
__device__ __forceinline__ void gemm_phase(PG8_LAS unsigned char* lds, const Gemm g, const Sched& S, const Epi& E) {
    int tid_ = threadIdx.x; asm volatile("" : "+v"(tid_));
    const int tid = tid_, wid = __builtin_amdgcn_readfirstlane(tid >> 6), lane = tid & 63, wr = wid >> 2, wc = wid & 3, fr = lane & 15, fq = lane >> 4;
    const int K = g.K, nt = K / BK;
    unsigned voffA[2], voffB[2];
#pragma unroll
    for (int i = 0; i < 2; ++i) { int R, C; stage_rc(tid * 16 + i * 8192, R, C); const int Rb = Epi::PERM ? ((R & ~31) + perm32(R & 31)) : R;
        voffA[i] = (unsigned)(R * g.lda + C) * 2u; voffB[i] = (unsigned)(Rb * K + C) * 2u; }
    const size_t kstep = (size_t)(BK * 2);
    const size_t hstep = (size_t)HALF * K * 2;
    const size_t tstep = 2 * hstep; const size_t hstepA = (size_t)HALF * g.lda * 2, tstepA = 2 * hstepA;
    const unsigned ldsw = (unsigned)wid * 1024u;
    const int aoff = lds_byte(wr * 64 + fr, fq * 8), boff = lds_byte(wc * 32 + fr, fq * 8);
#define PG8_SA(b, h) (((b) * 2 + (h)) * HTB)
#define PG8_SB(b, h) ((4 + (b) * 2 + (h)) * HTB)
#define PG8_STAGE(bufoff, gbase, voff) do { _Pragma("unroll") for (int _i = 0; _i < 2; ++_i) \
        __builtin_amdgcn_global_load_lds((const unsigned*)((const char*)(gbase) + (voff)[_i]), (PG8_LAS unsigned*)(lds + (bufoff) + ldsw + _i * 8192), 16, 0, 0); } while (0)
#define PG8_LDA(dst, b, h) do { _Pragma("unroll") for (int m = 0; m < 4; ++m) _Pragma("unroll") for (int k = 0; k < 2; ++k) dst[m][k] = *(const PG8_LAS bf16x8*)(lds + PG8_SA(b, h) + aoff + m * 2048 + k * 1024); } while (0)
#define PG8_LDB(dst, b, h) do { _Pragma("unroll") for (int n = 0; n < 2; ++n) _Pragma("unroll") for (int k = 0; k < 2; ++k) dst[n][k] = *(const PG8_LAS bf16x8*)(lds + PG8_SB(b, h) + boff + n * 2048 + k * 1024); } while (0)
#define PG8_MMA(ai, bj, At, Bt) do { __builtin_amdgcn_s_setprio(1); _Pragma("unroll") for (int m = 0; m < 4; ++m) _Pragma("unroll") for (int n = 0; n < 2; ++n) _Pragma("unroll") for (int k = 0; k < 2; ++k) \
        acc[ai][bj][m][n] = __builtin_amdgcn_mfma_f32_16x16x32_bf16(Bt[n][k], At[m][k], acc[ai][bj][m][n], 0, 0, 0); __builtin_amdgcn_s_setprio(0); } while (0)
#define PG8_WAIT_V(n) asm volatile("s_waitcnt vmcnt(" #n ")" ::: "memory")
#define PG8_WAIT_L(n) asm volatile("s_waitcnt lgkmcnt(" #n ")" ::: "memory")
#define PG8_BAR __builtin_amdgcn_s_barrier()
#define PG8_SCHED __builtin_amdgcn_sched_barrier(0)
    Unit cur, nxt; int ui = 0;
    if (!S.next(0, cur)) return;
    f32x4 acc[2][2][4][2];
#pragma unroll
    for (int a = 0; a < 2; ++a)
#pragma unroll
        for (int b = 0; b < 2; ++b)
#pragma unroll
            for (int m = 0; m < 4; ++m)
#pragma unroll
                for (int n = 0; n < 2; ++n) acc[a][b][m][n] = (f32x4){0.f, 0.f, 0.f, 0.f};
    bf16x8 At[4][2], B0[2][2], B1[2][2];
    const char* cA = (const char*)g.A + (size_t)cur.pm * tstepA; const char* cB = (const char*)g.Bt + (size_t)cur.pn * tstep;
    S.a_ready(cur);
    if constexpr (SP2) {
        PG8_STAGE(PG8_SB(0, 0), cB, voffB); PG8_STAGE(PG8_SB(0, 1), cB + hstep, voffB); PG8_STAGE(PG8_SA(0, 0), cA, voffA); PG8_STAGE(PG8_SA(0, 1), cA + hstepA, voffA);
        if (wr == 1) PG8_BAR;
        PG8_WAIT_V(2); PG8_BAR;
        PG8_STAGE(PG8_SB(1, 0), cB + kstep, voffB); PG8_STAGE(PG8_SA(1, 0), cA + kstep, voffA); PG8_STAGE(PG8_SB(1, 1), cB + hstep + kstep, voffB);
        PG8_WAIT_V(6); PG8_BAR;
    } else {
        PG8_STAGE(PG8_SB(0, 0), cB, voffB); PG8_STAGE(PG8_SA(0, 0), cA, voffA); PG8_STAGE(PG8_SB(0, 1), cB + hstep, voffB); PG8_STAGE(PG8_SA(0, 1), cA + hstepA, voffA);
        if (wr == 1) PG8_BAR;
        PG8_WAIT_V(4); PG8_BAR;
        PG8_STAGE(PG8_SB(1, 0), cB + kstep, voffB); PG8_STAGE(PG8_SA(1, 0), cA + kstep, voffA); PG8_STAGE(PG8_SB(1, 1), cB + hstep + kstep, voffB);
        PG8_WAIT_V(6); PG8_BAR;
    }
    for (;;) {
        const bool has_next = S.next(ui + 1, nxt);
        const char* nA = has_next ? (const char*)g.A + (size_t)nxt.pm * tstepA : cA; const char* nB = has_next ? (const char*)g.Bt + (size_t)nxt.pn * tstep : cB;
        for (int t = 0; t < nt; t += 2) {
            const bool last = (t == nt - 2);
            const char* a1 = cA + (size_t)(t + 1) * kstep;
            const char* a2 = last ? nA : cA + (size_t)(t + 2) * kstep; const char* b2 = last ? nB : cB + (size_t)(t + 2) * kstep;
            const char* a3 = a2 + kstep; const char* b3 = b2 + kstep;
            if (last && has_next) S.a_ready(nxt);
            if constexpr (SP2) {
            PG8_LDB(B0, 0, 0); PG8_LDB(B1, 0, 1); PG8_SCHED; PG8_LDA(At, 0, 0); PG8_STAGE(PG8_SA(1, 1), a1 + hstepA, voffA);
            PG8_WAIT_V(8); PG8_WAIT_L(0); PG8_BAR; PG8_MMA(0, 0, At, B0); PG8_MMA(0, 1, At, B1); PG8_BAR; PG8_SCHED;
            PG8_LDA(At, 0, 1); PG8_STAGE(PG8_SB(0, 0), b2, voffB); PG8_STAGE(PG8_SB(0, 1), b2 + hstep, voffB); PG8_STAGE(PG8_SA(0, 0), a2, voffA);
            PG8_WAIT_V(8); PG8_WAIT_L(0); PG8_BAR; PG8_MMA(1, 0, At, B0); PG8_MMA(1, 1, At, B1); PG8_BAR; PG8_SCHED;
            PG8_LDB(B0, 1, 0); PG8_LDB(B1, 1, 1); PG8_SCHED; PG8_LDA(At, 1, 0); PG8_STAGE(PG8_SA(0, 1), a2 + hstepA, voffA);
            PG8_WAIT_V(8); PG8_WAIT_L(0); PG8_BAR; PG8_MMA(0, 0, At, B0); PG8_MMA(0, 1, At, B1); PG8_BAR; PG8_SCHED;
            PG8_LDA(At, 1, 1); PG8_STAGE(PG8_SB(1, 0), b3, voffB); PG8_STAGE(PG8_SB(1, 1), b3 + hstep, voffB); PG8_STAGE(PG8_SA(1, 0), a3, voffA);
            PG8_WAIT_V(8); PG8_WAIT_L(0); PG8_BAR; PG8_MMA(1, 0, At, B0); PG8_MMA(1, 1, At, B1); PG8_BAR; PG8_SCHED;
            } else {
            PG8_LDB(B0, 0, 0); PG8_SCHED; PG8_LDA(At, 0, 0); PG8_STAGE(PG8_SA(1, 1), a1 + hstepA, voffA);
            PG8_WAIT_L(8); PG8_BAR; PG8_WAIT_L(0); PG8_MMA(0, 0, At, B0); PG8_BAR; PG8_SCHED;
            PG8_LDB(B1, 0, 1); PG8_STAGE(PG8_SB(0, 0), b2, voffB);
            PG8_BAR; PG8_WAIT_L(0); PG8_MMA(0, 1, At, B1); PG8_BAR;
            PG8_LDA(At, 0, 1); PG8_STAGE(PG8_SA(0, 0), a2, voffA);
            PG8_BAR; PG8_WAIT_L(0); PG8_MMA(1, 0, At, B0); PG8_BAR; PG8_SCHED;
            PG8_STAGE(PG8_SB(0, 1), b2 + hstep, voffB);
            PG8_WAIT_V(6); PG8_BAR; PG8_MMA(1, 1, At, B1); PG8_BAR;
            PG8_LDB(B0, 1, 0); PG8_SCHED; PG8_LDA(At, 1, 0); PG8_STAGE(PG8_SA(0, 1), a2 + hstepA, voffA);
            PG8_WAIT_L(8); PG8_BAR; PG8_WAIT_L(0); PG8_MMA(0, 0, At, B0); PG8_BAR; PG8_SCHED;
            PG8_LDB(B1, 1, 1); PG8_STAGE(PG8_SB(1, 0), b3, voffB);
            PG8_BAR; PG8_WAIT_L(0); PG8_MMA(0, 1, At, B1); PG8_BAR;
            PG8_LDA(At, 1, 1); PG8_STAGE(PG8_SA(1, 0), a3, voffA);
            PG8_BAR; PG8_WAIT_L(0); PG8_MMA(1, 0, At, B0); PG8_BAR; PG8_SCHED;
            PG8_STAGE(PG8_SB(1, 1), b3 + hstep, voffB);
            PG8_WAIT_V(6); PG8_BAR; PG8_MMA(1, 1, At, B1); PG8_BAR;
            }
        }
        if constexpr (ALIGN_EPI) { if (wr == 0) PG8_BAR; }
        if constexpr (!Epi::AFTER_DRAIN) { E(acc, cur, wr, wc, fr, fq); S.done(cur); }
        if (!has_next) break;
#pragma unroll
        for (int a = 0; a < 2; ++a)
#pragma unroll
            for (int b = 0; b < 2; ++b)
#pragma unroll
                for (int m = 0; m < 4; ++m)
#pragma unroll
                    for (int n = 0; n < 2; ++n) acc[a][b][m][n] = (f32x4){0.f, 0.f, 0.f, 0.f};
        cur = nxt; cA = nA; cB = nB; ++ui;
        if constexpr (ALIGN_EPI) { if (wr == 1) PG8_BAR; }
    }
    PG8_WAIT_V(0);
    if constexpr (!ALIGN_EPI) { if (wr == 0) PG8_BAR; }
    PG8_BAR;
    if constexpr (Epi::AFTER_DRAIN) { E.fused(acc, cur, wr, wc, fr, fq, lds, wid, lane); S.done(cur); }
#undef PG8_SA
#undef PG8_SB
#undef PG8_STAGE
#undef PG8_LDA
#undef PG8_LDB
#undef PG8_MMA
#undef PG8_WAIT_V
#undef PG8_WAIT_L
#undef PG8_BAR
#undef PG8_SCHED
}
}

typedef unsigned short u16;
typedef short bf16x8 __attribute__((ext_vector_type(8)));
typedef short s16x4 __attribute__((ext_vector_type(4)));
typedef float f32x4 __attribute__((ext_vector_type(4)));
typedef float f32x16 __attribute__((ext_vector_type(16)));
typedef unsigned u32x4 __attribute__((ext_vector_type(4)));
typedef unsigned u32x2 __attribute__((ext_vector_type(2)));
typedef __bf16 bf16x2_t __attribute__((ext_vector_type(2)));
typedef float f32x2_t __attribute__((ext_vector_type(2)));
#define DI __device__ __forceinline__

constexpr int NB = 32, SEQ = 2048, NCTX = 256, TT = 2304, DM = 1024, DEPTH = 4;
constexpr int NGRP = 4, BGR = 8, MG = BGR * TT;
constexpr int DIN = 10992, NP = 11008;
constexpr float EPS = 1e-6f;
constexpr int C_CQ = 0, C_KR = 384, C_AF = 448, C_AB = 464, C_IF = 480, C_CKV = 512, C_MZ = 768, C_GQ = 1280, C_GK = 1536, C_GV = 1792, C_GZ = 2304,
              C_MX = 2816, C_MV = 3328, C_MO = 3840, C_MLZ = 4352, C_DQ = 4864, C_DK = 5376, C_DV = 5888, C_DZ = 6400, C_MG = 6912;
constexpr int NSTEP = 1 + DEPTH * NGRP * 7;
constexpr int LDS_BYTES = 147456;
constexpr int LDS_BARW = LDS_BYTES - 16;
constexpr int LDS_MISC = LDS_BYTES - 64;

constexpr size_t al256(size_t x) { return (x + 255) / 256 * 256; }
constexpr size_t WS_CTL = 0;
constexpr size_t CTL_BYTES = 65536;
constexpr size_t WS_MOD  = WS_CTL + CTL_BYTES;
constexpr size_t WS_ROPE = WS_MOD + al256((size_t)DEPTH * 33 * 3072 * 4);
constexpr size_t WS_LAM  = WS_ROPE + 8192;
constexpr size_t WS_WIN  = WS_LAM + 256;
constexpr size_t WS_BR   = WS_WIN + (size_t)DEPTH * NP * 1024 * 2;
constexpr size_t WS_WO   = WS_BR + (size_t)DEPTH * 4 * 1024 * 512 * 2;
constexpr size_t WS_WUQ  = WS_WO + (size_t)DEPTH * 1024 * 1024 * 2;
constexpr size_t WS_WUKV = WS_WUQ + (size_t)DEPTH * 768 * 384 * 2;
constexpr size_t WS_WQK  = WS_WUKV + (size_t)DEPTH * 1024 * 256 * 2;
constexpr size_t WS_CTX  = WS_WQK + (size_t)DEPTH * 512 * 512 * 2;
constexpr size_t WS_H    = WS_CTX + (size_t)NB * NCTX * DM * 4;
constexpr size_t WS_P    = WS_H + (size_t)MG * 1024 * 2;
constexpr size_t WS_Q    = WS_P + (size_t)MG * NP * 2;
constexpr size_t WS_KV   = WS_Q + (size_t)MG * 768 * 2;
constexpr size_t WS_XC   = WS_KV + (size_t)MG * 1024 * 2;
constexpr size_t WS_QKML = WS_XC + (size_t)MG * 512 * 2;
constexpr size_t WS_BG   = WS_QKML + (size_t)MG * 512 * 2;
constexpr size_t WS_SCAL = WS_BG + (size_t)2 * MG * 256 * 4;
constexpr size_t WS_Y    = WS_SCAL + (size_t)2 * MG * 16 * 4;
constexpr size_t WS_OSC  = WS_Y + (size_t)4 * MG * 512 * 2;
constexpr size_t WS_MF   = WS_OSC;
constexpr size_t WS_MB   = WS_OSC + (size_t)4 * MG * 512 * 2;
constexpr size_t WS_END  = WS_MB + (size_t)MG * 1024 * 2;
static_assert((size_t)MG * 1024 * 4 == (size_t)4 * MG * 512 * 2, "merge accumulator aliases the scan scratch");
static_assert(WS_END <= (size_t)1000 * 1024 * 1024, "workspace map must stay below 1000 MiB");
constexpr int CW_QUEUE = 4096;

struct Params { const float* in[29]; float* out; unsigned char* ws; int s_lo, s_hi; };

struct Ctx {
    const float* const* in; float* out; unsigned char* ws; unsigned* ctl;
    int wave, G;
    LAS unsigned char* lds;
};

DI float bf2f(u16 v) { return __uint_as_float((unsigned)v << 16); }
DI float bflo(unsigned w) { return __uint_as_float(w << 16); }
DI float bfhi(unsigned w) { return __uint_as_float(w & 0xffff0000u); }
DI unsigned pk2(float lo, float hi) { f32x2_t v = {lo, hi}; bf16x2_t b = __builtin_convertvector(v, bf16x2_t); return __builtin_bit_cast(unsigned, b); }
DI u16 f2bf(float f) { return (u16)(pk2(f, 0.f) & 0xffffu); }
DI void unpack8(u32x4 w, float* f) { f[0] = bflo(w.x); f[1] = bfhi(w.x); f[2] = bflo(w.y); f[3] = bfhi(w.y); f[4] = bflo(w.z); f[5] = bfhi(w.z); f[6] = bflo(w.w); f[7] = bfhi(w.w); }
DI u32x4 pack8(const float* f) { u32x4 w; w.x = pk2(f[0], f[1]); w.y = pk2(f[2], f[3]); w.z = pk2(f[4], f[5]); w.w = pk2(f[6], f[7]); return w; }
DI float sigmoid_f(float x) { return __builtin_amdgcn_rcpf(1.f + __expf(-x)); }
DI float silu_f(float x) { return x * sigmoid_f(x); }
DI float logsig_f(float x) { return fminf(x, 0.f) - __logf(1.f + __expf(-fabsf(x))); }
DI int crow(int r, int hi) { return (r & 3) + 8 * (r >> 2) + 4 * hi; }
DI int swz64(int row, int colB) { return row * 128 + (colB ^ (((row >> 1) & 7) << 4)); }
DI int kswz(int row, int colB) { return row * 256 + (colB ^ ((row & 7) << 4)); }
DI int v_st(int k, int c) { const int kk = (k & ~0xC) | ((k & 4) << 1) | ((k & 8) >> 1); return ((kk >> 3) * 4 + (c >> 5)) * 512 + ((kk & 7) * 32 + (c & 31)) * 2; }
DI int v_rd_base(int lane) { return ((lane & 3) << 3) | (((lane >> 2) & 3) << 6) | (((lane >> 4) & 1) << 5) | (((lane >> 5) & 1) << 8); }
template <int OFF> DI s16x4 tr_read(int vb) { s16x4 r; asm volatile("ds_read_b64_tr_b16 %0, %1 offset:%2" : "=&v"(r) : "v"(vb), "i"(OFF) : "memory"); return r; }
#define SBAR() __builtin_amdgcn_sched_barrier(0)
#define MFMA32(a, b, c) __builtin_amdgcn_mfma_f32_32x32x16_bf16((a), (b), (c), 0, 0, 0)
DI bf16x8 ldsv(const LAS unsigned char* p) { return *(const LAS bf16x8*)p; }
DI float wave_sum(float v) {
#pragma unroll
    for (int o = 32; o >= 1; o >>= 1) v += __shfl_xor(v, o);
    return v;
}
DI void v_frags(int vb, bf16x8 (&vf)[4]) {
    const s16x4 l0 = tr_read<0>(vb), h0 = tr_read<2048>(vb), l1 = tr_read<4096>(vb), h1 = tr_read<4096 + 2048>(vb);
    const s16x4 l2 = tr_read<8192>(vb), h2 = tr_read<8192 + 2048>(vb), l3 = tr_read<12288>(vb), h3 = tr_read<12288 + 2048>(vb);
    asm volatile("s_waitcnt lgkmcnt(0)" ::: "memory"); SBAR();
#define PKV(L, H) (bf16x8){L[0], L[1], L[2], L[3], H[0], H[1], H[2], H[3]}
    vf[0] = PKV(l0, h0); vf[1] = PKV(l1, h1); vf[2] = PKV(l2, h2); vf[3] = PKV(l3, h3);
#undef PKV
}
DI void p_to_afrag(const f32x16& p0, const f32x16& p1, bf16x8 (&pa)[4]) {
#define PK4(P, BASE, OUT) do { unsigned a0 = pk2(P[BASE + 0], P[BASE + 1]), a1 = pk2(P[BASE + 2], P[BASE + 3]);   \
    unsigned b0 = pk2(P[BASE + 4], P[BASE + 5]), b1 = pk2(P[BASE + 6], P[BASE + 7]);                              \
    auto r0 = __builtin_amdgcn_permlane32_swap(a0, b0, false, false); auto r1 = __builtin_amdgcn_permlane32_swap(a1, b1, false, false); \
    u32x4 w = {r0[0], r1[0], r0[1], r1[1]}; OUT = __builtin_bit_cast(bf16x8, w); } while (0)
    PK4(p0, 0, pa[0]); PK4(p0, 8, pa[1]); PK4(p1, 0, pa[2]); PK4(p1, 8, pa[3]);
#undef PK4
}
DI void p_half_to_afrag(const f32x16& p, bf16x8& pa0, bf16x8& pa1) {
#define PK4(P, BASE, OUT) do { unsigned a0 = pk2(P[BASE + 0], P[BASE + 1]), a1 = pk2(P[BASE + 2], P[BASE + 3]);   \
    unsigned b0 = pk2(P[BASE + 4], P[BASE + 5]), b1 = pk2(P[BASE + 6], P[BASE + 7]);                              \
    auto r0 = __builtin_amdgcn_permlane32_swap(a0, b0, false, false); auto r1 = __builtin_amdgcn_permlane32_swap(a1, b1, false, false); \
    u32x4 w = {r0[0], r1[0], r0[1], r1[1]}; OUT = __builtin_bit_cast(bf16x8, w); } while (0)
    PK4(p, 0, pa0); PK4(p, 8, pa1);
#undef PK4
}
DI float half_swap_sum(float v) { auto rr = __builtin_amdgcn_permlane32_swap(__float_as_uint(v), __float_as_uint(v), false, false); return __uint_as_float(rr[0]) + __uint_as_float(rr[1]); }
DI float half_swap_max(float v) { auto rr = __builtin_amdgcn_permlane32_swap(__float_as_uint(v), __float_as_uint(v), false, false); return fmaxf(__uint_as_float(rr[0]), __uint_as_float(rr[1])); }
using pg8::Unit;
typedef f32x4 AccT[2][2][4][2];

DI int p_act(int pn) {
    if (pn >= 27) return 2;
    if (pn == 15 || pn == 16) return 2;
    if (pn == 3 || pn == 4 || pn == 9 || pn == 10 || pn == 17 || pn == 18 || pn == 25 || pn == 26) return 1;
    return 0;
}
struct EpiBf {
    static constexpr bool PERM = true, AFTER_DRAIN = false;
    u16* O; int ldc; int actsel;
    DI void operator()(const AccT& acc, const Unit& u, int wr, int wc, int fr, int fq) const {
        const int row0 = u.pm * 256 + wr * 64 + fr, col0 = u.pn * 256 + wc * 32 + 8 * fq;
        const int act = actsel ? p_act(u.pn) : 0;
#pragma unroll
        for (int ai = 0; ai < 2; ++ai)
#pragma unroll
            for (int m = 0; m < 4; ++m) { u16* rowp = O + (size_t)(row0 + ai * 128 + m * 16) * ldc + col0;
#pragma unroll
                for (int bj = 0; bj < 2; ++bj) { f32x4 v0 = acc[ai][bj][m][0], v1 = acc[ai][bj][m][1];
                    float f[8] = {v0[0], v0[1], v0[2], v0[3], v1[0], v1[1], v1[2], v1[3]};
                    if (act == 1) {
#pragma unroll
                        for (int e = 0; e < 8; ++e) f[e] = silu_f(f[e]);
                    } else if (act == 2) {
#pragma unroll
                        for (int e = 0; e < 8; ++e) f[e] = sigmoid_f(f[e]);
                    }
                    *(u32x4*)(rowp + bj * 128) = pack8(f); } }
    }
};
struct EpiMerge {
    static constexpr bool PERM = true, AFTER_DRAIN = false;
    float* MF; u16* MB; const u16* gate; int mode;
    DI void operator()(const AccT& acc, const Unit& u, int wr, int wc, int fr, int fq) const {
        const int row0 = u.pm * 256 + wr * 64 + fr, col0 = u.pn * 256 + wc * 32 + 8 * fq;
#pragma unroll
        for (int ai = 0; ai < 2; ++ai)
#pragma unroll
            for (int m = 0; m < 4; ++m) { const size_t r = (size_t)(row0 + ai * 128 + m * 16);
#pragma unroll
                for (int bj = 0; bj < 2; ++bj) { const int c = col0 + bj * 128;
                    f32x4 v0 = acc[ai][bj][m][0], v1 = acc[ai][bj][m][1];
                    float g[8]; unpack8(*(const u32x4*)(gate + r * NP + c), g);
                    float f[8] = {v0[0] * g[0], v0[1] * g[1], v0[2] * g[2], v0[3] * g[3], v1[0] * g[4], v1[1] * g[5], v1[2] * g[6], v1[3] * g[7]};
                    float* mp = MF + r * 1024 + c;
                    if (mode != 0) { const f32x4 o0 = *(const f32x4*)mp, o1 = *(const f32x4*)(mp + 4);
                        f[0] += o0[0]; f[1] += o0[1]; f[2] += o0[2]; f[3] += o0[3]; f[4] += o1[0]; f[5] += o1[1]; f[6] += o1[2]; f[7] += o1[3]; }
                    if (mode == 2) *(u32x4*)(MB + r * 1024 + c) = pack8(f);
                    else { *(f32x4*)mp = (f32x4){f[0], f[1], f[2], f[3]}; *(f32x4*)(mp + 4) = (f32x4){f[4], f[5], f[6], f[7]}; } } }
    }
};
struct EpiOut {
    static constexpr bool PERM = false, AFTER_DRAIN = false;
    const float* xsrc; float* xdst; const float* csrc; float* cdst; const float* mod; int grp; int last;
    DI void operator()(const AccT& acc, const Unit& u, int wr, int wc, int fr, int fq) const {
        const int bl = u.pm / 9, tb = u.pm % 9, b = grp * BGR + bl;
        if (tb == 0 && last) return;
        const float* src; float* dst; const float* gt;
        if (tb == 0) { src = csrc + (size_t)b * NCTX * DM; dst = cdst + (size_t)b * NCTX * DM; gt = mod + 32 * 3072 + 2048; }
        else { src = xsrc + ((size_t)b * SEQ + (size_t)(tb - 1) * 256) * DM; dst = xdst + ((size_t)b * SEQ + (size_t)(tb - 1) * 256) * DM; gt = mod + b * 3072 + 2048; }
        const int row0 = wr * 64 + fr, col0 = u.pn * 256 + wc * 32 + 4 * fq;
        f32x4 gv[2][2];
#pragma unroll
        for (int bj = 0; bj < 2; ++bj)
#pragma unroll
            for (int n = 0; n < 2; ++n) gv[bj][n] = *(const f32x4*)(gt + col0 + bj * 128 + n * 16);
#pragma unroll
        for (int ai = 0; ai < 2; ++ai)
#pragma unroll
            for (int m = 0; m < 4; ++m) { const size_t ro = (size_t)(row0 + ai * 128 + m * 16) * DM + col0;
#pragma unroll
                for (int bj = 0; bj < 2; ++bj)
#pragma unroll
                    for (int n = 0; n < 2; ++n) { const f32x4 xo = *(const f32x4*)(src + ro + bj * 128 + n * 16);
                        *(f32x4*)(dst + ro + bj * 128 + n * 16) = xo + gv[bj][n] * acc[ai][bj][m][n]; } }
    }
};

DI int pmap(int n, float& sc) {
    sc = 1.f;
    if (n < 384) return n;
    if (n < 448) return 640 + (n - 384);
    if (n < 464) return 2240 + (n - 448);
    if (n < 480) return 2256 + (n - 464);
    if (n < 496) return 4320 + (n - 480);
    if (n < 512) return -1;
    if (n < 768) return 384 + (n - 512);
    if (n < 1280) return 704 + (n - 768);
    if (n < 1536) { sc = 0.125f; return 1216 + (n - 1280); }
    if (n < 1792) return 1472 + (n - 1536);
    if (n < 2304) return 1728 + (n - 1792);
    if (n < 2816) return 2272 + (n - 2304);
    if (n < 3328) return 2784 + (n - 2816);
    if (n < 3840) return 3296 + (n - 3328);
    if (n < 4352) return 3808 + (n - 3840);
    if (n < 4864) return 4336 + (n - 4352);
    if (n < 5376) return 4848 + (n - 4864);
    if (n < 5888) return 5360 + (n - 5376);
    if (n < 6400) return 5872 + (n - 5888);
    if (n < 6912) return 6384 + (n - 6400);
    return 6896 + (n - 6912);
}
struct MapWin { DI int operator()(int n, float& sc) const { return pmap(n, sc); } };
struct MapId  { DI int operator()(int n, float& sc) const { sc = 1.f; return n; } };
struct MapQ   { DI int operator()(int n, float& sc) const { sc = 1.f; return n < 512 ? (n >> 7) * 192 + (n & 127) : ((n - 512) >> 6) * 192 + 128 + ((n - 512) & 63); } };
struct MapKV  { DI int operator()(int n, float& sc) const { sc = 1.f; return n < 512 ? (n >> 7) * 256 + (n & 127) : ((n - 512) >> 7) * 256 + 128 + ((n - 512) & 127); } };

template <class Map>
DI void xpose_tile(const float* __restrict__ src, int ldsrc, u16* __restrict__ dst, int K, int n0, int k0, const float* __restrict__ kscale, Map map, LAS float* tl) {
    const int tid = threadIdx.x;
    { const int kk = tid >> 3, ng = (tid & 7) * 8; float sc; const int sn = map(n0 + ng, sc);
      f32x4 a = {0.f, 0.f, 0.f, 0.f}, b = {0.f, 0.f, 0.f, 0.f};
      if (sn >= 0) { const float* p = src + (size_t)(k0 + kk) * ldsrc + sn; a = *(const f32x4*)p; b = *(const f32x4*)(p + 4); }
      const float ks = (kscale ? kscale[k0 + kk] : 1.f) * sc;
      tl[(ng + 0) * 65 + kk] = a[0] * ks; tl[(ng + 1) * 65 + kk] = a[1] * ks; tl[(ng + 2) * 65 + kk] = a[2] * ks; tl[(ng + 3) * 65 + kk] = a[3] * ks;
      tl[(ng + 4) * 65 + kk] = b[0] * ks; tl[(ng + 5) * 65 + kk] = b[1] * ks; tl[(ng + 6) * 65 + kk] = b[2] * ks; tl[(ng + 7) * 65 + kk] = b[3] * ks; }
    __syncthreads();
    { const int nn = tid >> 3, kg = (tid & 7) * 8; float f[8];
#pragma unroll
      for (int e = 0; e < 8; ++e) f[e] = tl[nn * 65 + kg + e];
      *(u32x4*)(dst + (size_t)(n0 + nn) * K + k0 + kg) = pack8(f); }
    __syncthreads();
}

DI void p0_prologue(const Ctx& F) {
    int tz = (int)threadIdx.x; asm volatile("" : "+v"(tz));
    const int tid = tz;
    LAS float* lf = (LAS float*)F.lds;
    constexpr int U_ADA = 96, U_WIN = DEPTH * (NP / 64) * 16, U_BR = DEPTH * 4 * 16 * 8, U_WO = DEPTH * 16 * 16, U_WUQ = DEPTH * 12 * 6, U_WUKV = DEPTH * 16 * 4, U_WQK = DEPTH * 64, U_MISC = 1;
    constexpr int O_WIN = U_ADA, O_BR = O_WIN + U_WIN, O_WO = O_BR + U_BR, O_WUQ = O_WO + U_WO, O_WUKV = O_WUQ + U_WUQ, O_WQK = O_WUKV + U_WUKV, O_MISC = O_WQK + U_WQK, U_ALL = O_MISC + U_MISC;
    for (int u = blockIdx.x; u < U_ALL; u += F.G) {
        if (u < U_ADA) {
            const int l = u / 24, col0 = (u % 24) * 128, col = tid & 127, kq = tid >> 7;
            const float* aw = F.in[4] + (size_t)l * 1024 * 3072;
            float acc[33];
#pragma unroll
            for (int r = 0; r < 33; ++r) acc[r] = 0.f;
            for (int kc = 0; kc < 1024; kc += 256) {
                __syncthreads();
                for (int idx = tid; idx < 33 * 256; idx += 512) { const int r = idx >> 8, k = idx & 255; const float cv = (r < 32) ? F.in[1][r * 1024 + kc + k] : F.in[3][kc + k]; lf[idx] = silu_f(cv); }
                __syncthreads();
                for (int k = kq * 64; k < kq * 64 + 64; ++k) { const float w = aw[(size_t)(kc + k) * 3072 + col0 + col];
#pragma unroll
                    for (int r = 0; r < 33; ++r) acc[r] += lf[r * 256 + k] * w; }
            }
            __syncthreads();
#pragma unroll
            for (int r = 0; r < 33; ++r) lf[(kq * 33 + r) * 128 + col] = acc[r];
            __syncthreads();
            float* mod = (float*)(F.ws + WS_MOD) + (size_t)l * 33 * 3072;
            for (int idx = tid; idx < 33 * 128; idx += 512) { const int r = idx >> 7, c = idx & 127;
                mod[r * 3072 + col0 + c] = lf[(0 * 33 + r) * 128 + c] + lf[(1 * 33 + r) * 128 + c] + lf[(2 * 33 + r) * 128 + c] + lf[(3 * 33 + r) * 128 + c] + F.in[5][l * 3072 + col0 + c]; }
            __syncthreads();
        } else if (u < O_BR) {
            const int v = u - O_WIN, l = v / ((NP / 64) * 16), t = v % ((NP / 64) * 16), nt = t / 16, kt = t % 16;
            xpose_tile(F.in[7] + (size_t)l * 1024 * DIN, DIN, (u16*)(F.ws + WS_WIN) + (size_t)l * NP * 1024, 1024, nt * 64, kt * 64, nullptr, MapWin(), lf);
        } else if (u < O_WO) {
            const int v = u - O_BR, li = v / 128, t = v % 128, nt = t / 8, kt = t % 8;
            xpose_tile(F.in[27] + (size_t)li * 512 * 1024, 1024, (u16*)(F.ws + WS_BR) + (size_t)li * 1024 * 512, 512, nt * 64, kt * 64, nullptr, MapId(), lf);
        } else if (u < O_WUQ) {
            const int v = u - O_WO, l = v / 256, t = v % 256, nt = t / 16, kt = t % 16;
            xpose_tile(F.in[28] + (size_t)l * 1024 * 1024, 1024, (u16*)(F.ws + WS_WO) + (size_t)l * 1024 * 1024, 1024, nt * 64, kt * 64, nullptr, MapId(), lf);
        } else if (u < O_WUKV) {
            const int v = u - O_WUQ, l = v / 72, t = v % 72, nt = t / 6, kt = t % 6;
            xpose_tile(F.in[10] + (size_t)l * 384 * 768, 768, (u16*)(F.ws + WS_WUQ) + (size_t)l * 768 * 384, 384, nt * 64, kt * 64, F.in[8] + l * 384, MapQ(), lf);
        } else if (u < O_WQK) {
            const int v = u - O_WUKV, l = v / 64, t = v % 64, nt = t / 4, kt = t % 4;
            xpose_tile(F.in[11] + (size_t)l * 256 * 1024, 1024, (u16*)(F.ws + WS_WUKV) + (size_t)l * 1024 * 256, 256, nt * 64, kt * 64, F.in[9] + l * 256, MapKV(), lf);
        } else if (u < O_MISC) {
            const int v = u - O_WQK, l = v / 64, t = v % 64;
            u16* dst = (u16*)(F.ws + WS_WQK) + (size_t)l * 512 * 512;
            for (int e = tid; e < 4096; e += 512) { const int idx = t * 4096 + e, n = idx >> 9, k = idx & 511;
                const int isk = n >> 8, hn = (n & 255) >> 6, dd = n & 63, hk = k >> 7, c = k & 127;
                float val = 0.f;
                if (hn == hk) { const float* w = (isk ? F.in[20] : F.in[19]) + (((size_t)l * 4 + hn) * 128 + c) * 64 + dd; val = isk ? *w * 0.125f : *w; }
                dst[idx] = f2bf(val); }
        } else {
            float* rope = (float*)(F.ws + WS_ROPE);
            for (int e = tid; e < 1024; e += 512) { const int pos = e >> 4, i = e & 15;
                const float inv = powf(10000.f, -(float)i / 16.f); const float ang = (float)pos * inv;
                rope[e] = cosf(ang); rope[1024 + e] = sinf(ang); }
            if (tid < 4) { const float* lp = F.in[25] + tid * 256; float s0 = 0.f, s1 = 0.f;
                for (int d = 0; d < 64; ++d) { s0 += lp[d] * lp[64 + d]; s1 += lp[128 + d] * lp[192 + d]; }
                const float lam_init = 0.8f - 0.6f * expf(-0.3f * (float)tid);
                ((float*)(F.ws + WS_LAM))[tid] = expf(s0) - expf(s1) + lam_init; }
        }
    }
}

DI void p1_norm(const Ctx& F, int l, int g) {
    const float* mod = (const float*)(F.ws + WS_MOD) + (size_t)l * 33 * 3072;
    const float* ng = F.in[6] + l * 1024;
    const float* xs = (l == 0) ? F.in[0] : F.out;
    const float* cs = (l == 0) ? F.in[2] : (const float*)(F.ws + WS_CTX);
    u16* H = (u16*)(F.ws + WS_H);
    int lz = ((int)threadIdx.x & 63); asm volatile("" : "+v"(lz));
    const int lane = lz;
    int row0 = blockIdx.x * 8 + F.wave; asm volatile("" : "+s"(row0));
    for (int row = row0; row < MG; row += F.G * 8) {
        const int bl = row / TT, t = row % TT, b = g * BGR + bl;
        const float* src; const float* md;
        if (t < NCTX) { src = cs + ((size_t)b * NCTX + t) * DM; md = mod + 32 * 3072; } else { src = xs + ((size_t)b * SEQ + (t - NCTX)) * DM; md = mod + b * 3072; }
        f32x4 v[4]; float ss = 0.f;
#pragma unroll
        for (int i = 0; i < 4; ++i) { v[i] = *(const f32x4*)(src + i * 256 + lane * 4); ss += v[i][0] * v[i][0] + v[i][1] * v[i][1] + v[i][2] * v[i][2] + v[i][3] * v[i][3]; }
        ss = wave_sum(ss);
        const float rstd = rsqrtf(ss * (1.f / 1024.f) + EPS);
#pragma unroll
        for (int i = 0; i < 4; ++i) { const int c = i * 256 + lane * 4;
            const f32x4 gg = *(const f32x4*)(ng + c), sh = *(const f32x4*)(md + c), sc = *(const f32x4*)(md + 1024 + c);
            const f32x4 y = v[i] * rstd * gg * (sc + 1.f) + sh;
            u32x2 w; w.x = pk2(y[0], y[1]); w.y = pk2(y[2], y[3]);
            *(u32x2*)(H + (size_t)row * 1024 + c) = w; }
    }
}
DI void rope8(float* x, int j8, int t, const float* __restrict__ rope) {
    float p[8];
#pragma unroll
    for (int e = 0; e < 8; ++e) p[e] = __shfl_xor(x[e], 2);
    if (t < NCTX) return;
    const int s = t - NCTX, pos = (j8 & 4) ? (s & 63) : (s >> 6), i0 = 8 * (j8 & 1);
    const float sg = (j8 & 2) ? 1.f : -1.f;
#pragma unroll
    for (int e = 0; e < 8; ++e) { const float c = rope[pos * 16 + i0 + e], sn = rope[1024 + pos * 16 + i0 + e]; x[e] = x[e] * c + sg * p[e] * sn; }
}
DI float group_sum(float v, int n) {
    v += __shfl_xor(v, 1); v += __shfl_xor(v, 2); v += __shfl_xor(v, 4); if (n == 16) v += __shfl_xor(v, 8); return v;
}

DI void p3_rows(const Ctx& F, int l) {
    u16* P = (u16*)(F.ws + WS_P); u16* XC = (u16*)(F.ws + WS_XC);
    const float* rope = (const float*)(F.ws + WS_ROPE);
    const float* cw = F.in[17] + (size_t)l * 3 * 512; const float* cb = F.in[18] + l * 512;
    const float* qkg = F.in[24] + l * 128; const float* kg = F.in[13] + l * 192 + 128;
    int lz = ((int)threadIdx.x & 63); asm volatile("" : "+v"(lz));
    const int lane = lz, c8 = lane * 8;
    int row0 = blockIdx.x * 8 + F.wave; asm volatile("" : "+s"(row0));
    for (int row = row0; row < MG; row += F.G * 8) {
        const int t = row % TT; u16* pr = P + (size_t)row * NP;
        { const bool hasl = (t != 0 && t != NCTX), hasr = (t != NCTX - 1 && t != TT - 1);
          float x0[8], xm[8], xp[8], o[8];
          unpack8(*(const u32x4*)(pr + C_MX + c8), x0);
          if (hasl) unpack8(*(const u32x4*)(pr - NP + C_MX + c8), xm);
          if (hasr) unpack8(*(const u32x4*)(pr + NP + C_MX + c8), xp);
#pragma unroll
          for (int e = 0; e < 8; ++e) { float a = cb[c8 + e] + cw[512 + c8 + e] * x0[e];
              if (hasl) a += cw[c8 + e] * xm[e];
              if (hasr) a += cw[1024 + c8 + e] * xp[e];
              o[e] = silu_f(a); }
          *(u32x4*)(XC + (size_t)row * 512 + c8) = pack8(o); }
#pragma unroll
        for (int qk = 0; qk < 2; ++qk) { u16* p = pr + (qk ? C_DK : C_DQ) + c8; float x[8]; unpack8(*(const u32x4*)p, x);
            float ss = 0.f;
#pragma unroll
            for (int e = 0; e < 8; ++e) ss += x[e] * x[e];
            ss = group_sum(ss, 8); const float rstd = rsqrtf(ss * (1.f / 64.f) + EPS); const int j8 = lane & 7;
#pragma unroll
            for (int e = 0; e < 8; ++e) x[e] = x[e] * rstd * qkg[qk * 64 + j8 * 8 + e];
            rope8(x, j8, t, rope);
            *(u32x4*)p = pack8(x); }
        { const int j8 = lane & 7; u16* p = pr + C_KR + j8 * 8; float x[8]; unpack8(*(const u32x4*)p, x);
          float ss = 0.f;
#pragma unroll
          for (int e = 0; e < 8; ++e) ss += x[e] * x[e];
          ss = group_sum(ss, 8); const float rstd = rsqrtf(ss * (1.f / 64.f) + EPS);
#pragma unroll
          for (int e = 0; e < 8; ++e) x[e] = x[e] * rstd * kg[j8 * 8 + e];
          rope8(x, j8, t, rope);
          if (lane < 8) *(u32x4*)p = pack8(x); }
    }
}

DI void p3_gates(const Ctx& F, int l) {
    const u16* P = (const u16*)(F.ws + WS_P);
    float* BGp = (float*)(F.ws + WS_BG); float* SC = (float*)(F.ws + WS_SCAL);
    LAS float* af = (LAS float*)F.lds;
    LAS float* gi = af + 64 * 32;
    int tz = (int)threadIdx.x; asm volatile("" : "+v"(tz));
    const int tid = tz;
    const int dir = tid >> 8, col = tid & 255;
    float aw[16];
#pragma unroll
    for (int r = 0; r < 16; ++r) aw[r] = F.in[14][(((size_t)l * 2 + dir) * 16 + r) * 256 + col];
    const float ab = F.in[15][((size_t)l * 2 + dir) * 256 + col];
    for (int ch = blockIdx.x; ch < MG / 64; ch += F.G) {
        const size_t r0 = (size_t)ch * 64;
        __syncthreads();
        if (tid < 256) { const int r = tid >> 2, q = tid & 3; float f[8]; unpack8(*(const u32x4*)(P + (r0 + r) * NP + C_AF + q * 8), f);
#pragma unroll
            for (int e = 0; e < 8; ++e) af[r * 32 + q * 8 + e] = f[e]; }
        else if (tid < 384) { const int r = (tid - 256) >> 1, q = tid & 1; float f[8]; unpack8(*(const u32x4*)(P + (r0 + r) * NP + C_IF + q * 8), f);
#pragma unroll
            for (int e = 0; e < 8; ++e) gi[r * 16 + q * 8 + e] = f[e]; }
        __syncthreads();
        { float run = 0.f; float* bo = BGp + ((size_t)dir * MG + r0) * 256 + col;
          for (int i = 0; i < 64; ++i) { const int tk = dir ? 63 - i : i; float x = ab;
#pragma unroll
              for (int r = 0; r < 16; ++r) x += af[tk * 32 + dir * 16 + r] * aw[r];
              run += logsig_f(x) * (1.f / 16.f); bo[(size_t)tk * 256] = run; } }
        if (tid < 8) { const int d2 = tid >> 2, h = tid & 3, g0 = d2 * 2;
            const float bi = F.in[21][l * 16 + g0 * 4 + h], bf = F.in[21][l * 16 + (g0 + 1) * 4 + h];
            float b = 0.f, pm = -3.0e38f;
            for (int i = 0; i < 64; ++i) { const int tk = d2 ? 63 - i : i;
                const float li = gi[tk * 16 + g0 * 4 + h] + bi, lfv = logsig_f(gi[tk * 16 + (g0 + 1) * 4 + h] + bf);
                b += lfv; const float a = li - b; pm = fmaxf(pm, a);
                *(f32x4*)(SC + (((size_t)d2 * MG + r0 + tk) * 4 + h) * 4) = (f32x4){b, a, pm, 0.f}; } }
    }
}

DI void p3b_rows(const Ctx& F, int l) {
    const u16* P = (const u16*)(F.ws + WS_P); u16* Q = (u16*)(F.ws + WS_Q); u16* KV = (u16*)(F.ws + WS_KV);
    const float* rope = (const float*)(F.ws + WS_ROPE);
    const float* qg = F.in[12] + l * 192; const float* kg = F.in[13] + l * 192;
    int lz = ((int)threadIdx.x & 63); asm volatile("" : "+v"(lz));
    const int lane = lz, c8 = lane * 8;
    int row0 = blockIdx.x * 8 + F.wave; asm volatile("" : "+s"(row0));
    for (int row = row0; row < MG; row += F.G * 8) {
        const int t = row % TT; const u16* pr = P + (size_t)row * NP;
        float ss = 0.f;
        if (lane < 48) { float x[8]; unpack8(*(const u32x4*)(pr + C_CQ + c8), x);
#pragma unroll
            for (int e = 0; e < 8; ++e) ss += x[e] * x[e]; }
        const float rq = rsqrtf(wave_sum(ss) * (1.f / 384.f) + EPS);
        ss = 0.f;
        if (lane < 32) { float x[8]; unpack8(*(const u32x4*)(pr + C_CKV + c8), x);
#pragma unroll
            for (int e = 0; e < 8; ++e) ss += x[e] * x[e]; }
        const float rk = rsqrtf(wave_sum(ss) * (1.f / 256.f) + EPS);
        { u16* p = Q + (size_t)row * 768 + c8; float x[8]; unpack8(*(const u32x4*)p, x); float s2 = 0.f;
#pragma unroll
          for (int e = 0; e < 8; ++e) { x[e] *= rq; s2 += x[e] * x[e]; }
          s2 = group_sum(s2, 16); const float rs = rsqrtf(s2 * (1.f / 128.f) + EPS); const int d0 = (lane & 15) * 8;
#pragma unroll
          for (int e = 0; e < 8; ++e) x[e] = x[e] * rs * qg[d0 + e];
          *(u32x4*)p = pack8(x); }
        { const int l32 = lane & 31; u16* p = Q + (size_t)row * 768 + 512 + l32 * 8; float x[8]; unpack8(*(const u32x4*)p, x); float s2 = 0.f;
#pragma unroll
          for (int e = 0; e < 8; ++e) { x[e] *= rq; s2 += x[e] * x[e]; }
          s2 = group_sum(s2, 8); const float rs = rsqrtf(s2 * (1.f / 64.f) + EPS); const int j8 = lane & 7;
#pragma unroll
          for (int e = 0; e < 8; ++e) x[e] = x[e] * rs * qg[128 + j8 * 8 + e];
          rope8(x, j8, t, rope);
          if (lane < 32) *(u32x4*)p = pack8(x); }
        { u16* p = KV + (size_t)row * 1024 + c8; float x[8]; unpack8(*(const u32x4*)p, x); float s2 = 0.f;
#pragma unroll
          for (int e = 0; e < 8; ++e) { x[e] *= rk; s2 += x[e] * x[e]; }
          s2 = group_sum(s2, 16); const float rs = rsqrtf(s2 * (1.f / 128.f) + EPS); const int d0 = (lane & 15) * 8;
#pragma unroll
          for (int e = 0; e < 8; ++e) x[e] = x[e] * rs * kg[d0 + e];
          *(u32x4*)p = pack8(x); }
        { u16* p = KV + (size_t)row * 1024 + 512 + c8; float x[8]; unpack8(*(const u32x4*)p, x);
#pragma unroll
          for (int e = 0; e < 8; ++e) x[e] *= rk;
          *(u32x4*)p = pack8(x); }
    }
}
constexpr int AT_KN = 16384, AT_KR = 8192, AT_V = 16384;
constexpr int AT_BUF = AT_V + AT_KN + AT_KR;
constexpr int AT_WS = 2 * AT_BUF;
template <int MODE>
DI void attn_unit(const Ctx& F, int l, int bl, int h, int q0, int nkeys) {
    int tz = (int)threadIdx.x; asm volatile("" : "+v"(tz));
    const int tid = tz, wid = F.wave, lane = tz & 63;
    LAS unsigned char* lds = F.lds;
    const u16* P = (const u16*)(F.ws + WS_P); const u16* Qb = (const u16*)(F.ws + WS_Q); const u16* KVb = (const u16*)(F.ws + WS_KV);
    const size_t rb = (size_t)bl * TT;
    constexpr int NDQ = MODE == 0 ? 12 : 4;
    const float SC = MODE == 0 ? 0.07216878364870322f : 0.125f;
    const float C = SC * 1.4426950408889634f;
    LAS float* wsf = (LAS float*)(lds + AT_WS) + wid * 64;
    const int r32 = lane & 31, hi = lane >> 5;
    const int qrow = q0 + (MODE == 0 ? wid * 32 : (wid & 3) * 32) + r32;
    bf16x8 qr[NDQ];
    if constexpr (MODE == 0) { const u16* qp = Qb + (rb + qrow) * 768;
#pragma unroll
        for (int d0 = 0; d0 < 8; ++d0) qr[d0] = *(const bf16x8*)(qp + h * 128 + d0 * 16 + hi * 8);
#pragma unroll
        for (int d0 = 0; d0 < 4; ++d0) qr[8 + d0] = *(const bf16x8*)(qp + 512 + h * 64 + d0 * 16 + hi * 8);
    } else { const u16* qp = P + (rb + qrow) * NP + C_DQ + h * 128 + (wid >> 2) * 64;
#pragma unroll
        for (int d0 = 0; d0 < 4; ++d0) qr[d0] = *(const bf16x8*)(qp + d0 * 16 + hi * 8); }
    const int sr = tid >> 4, sc = (tid & 15) * 8, vst0 = v_st(sr, sc), vst1 = v_st(32 + sr, sc);
    const int kr_r = tid >> 3, kr_c = (tid & 7) * 8;
    const u16* kbase; const u16* vbase; size_t kld;
    if (MODE == 0) { kbase = KVb + rb * 1024 + h * 128; vbase = KVb + rb * 1024 + 512 + h * 128; kld = 1024; }
    else { kbase = P + rb * NP + C_DK + h * 128; vbase = P + rb * NP + C_DV + h * 128; kld = NP; }
    const u16* krbase = P + rb * NP + C_KR;
    u32x4 sv0, sv1, sk0, sk1, skr;
#define SLOAD(k0) do { sv0 = *(const u32x4*)(vbase + (size_t)((k0) + sr) * kld + sc); sv1 = *(const u32x4*)(vbase + (size_t)((k0) + 32 + sr) * kld + sc); \
        sk0 = *(const u32x4*)(kbase + (size_t)((k0) + sr) * kld + sc); sk1 = *(const u32x4*)(kbase + (size_t)((k0) + 32 + sr) * kld + sc); \
        if (MODE == 0) skr = *(const u32x4*)(krbase + (size_t)((k0) + kr_r) * NP + kr_c); } while (0)
#define SWRITE(b) do { LAS unsigned char* bb = lds + (b) * AT_BUF; *(LAS u32x4*)(bb + vst0) = sv0; *(LAS u32x4*)(bb + vst1) = sv1; \
        *(LAS u32x4*)(bb + AT_V + kswz(sr, sc * 2)) = sk0; *(LAS u32x4*)(bb + AT_V + kswz(32 + sr, sc * 2)) = sk1; \
        if (MODE == 0) *(LAS u32x4*)(bb + AT_V + AT_KN + swz64(kr_r, kr_c * 2)) = skr; } while (0)
    float m_reg = -1e30f, l_reg = 0.f; f32x16 o[4];
#pragma unroll
    for (int d = 0; d < 4; ++d)
#pragma unroll
        for (int r = 0; r < 16; ++r) o[d][r] = 0.f;
    const int NT = nkeys / 64;
    const int vrb = (int)(uintptr_t)lds + v_rd_base(lane);
    const int kcol0 = (MODE == 1) ? (wid >> 2) * 128 : 0;
    SLOAD(0); SWRITE(0); if (NT > 1) SLOAD(64); __syncthreads();
    for (int j = 0; j < NT; ++j) {
        const int cur = j & 1;
        f32x16 p0, p1;
#pragma unroll
        for (int r = 0; r < 16; ++r) { p0[r] = 0.f; p1[r] = 0.f; }
        { const LAS unsigned char* kb = lds + cur * AT_BUF + AT_V;
#pragma unroll
          for (int d0 = 0; d0 < (MODE == 0 ? 8 : 4); ++d0) { const int cb = kcol0 + (d0 * 16 + hi * 8) * 2;
              const bf16x8 b0 = ldsv(kb + kswz(r32, cb)), b1 = ldsv(kb + kswz(32 + r32, cb));
              p0 = MFMA32(b0, qr[d0], p0); p1 = MFMA32(b1, qr[d0], p1); }
          if constexpr (MODE == 0) {
#pragma unroll
              for (int d0 = 0; d0 < 4; ++d0) { const int cb = (d0 * 16 + hi * 8) * 2;
                  const bf16x8 b0 = ldsv(kb + AT_KN + swz64(r32, cb)), b1 = ldsv(kb + AT_KN + swz64(32 + r32, cb));
                  p0 = MFMA32(b0, qr[8 + d0], p0); p1 = MFMA32(b1, qr[8 + d0], p1); } } }
        if (j + 1 < NT) SWRITE(cur ^ 1);
        SBAR();
        float pmax = p0[0];
#pragma unroll
        for (int r = 1; r < 16; ++r) pmax = fmaxf(pmax, p0[r]);
#pragma unroll
        for (int r = 0; r < 16; ++r) pmax = fmaxf(pmax, p1[r]);
        pmax = half_swap_max(pmax);
        const float mn = fmaxf(m_reg, pmax), alpha = __builtin_amdgcn_exp2f((m_reg - mn) * C); m_reg = mn;
        const float mnC = -mn * C; float ps = 0.f;
#pragma unroll
        for (int r = 0; r < 16; ++r) { p0[r] = __builtin_amdgcn_exp2f(fmaf(p0[r], C, mnC)); ps += p0[r]; }
#pragma unroll
        for (int r = 0; r < 16; ++r) { p1[r] = __builtin_amdgcn_exp2f(fmaf(p1[r], C, mnC)); ps += p1[r]; }
        ps = half_swap_sum(ps);
        l_reg = l_reg * alpha + ps;
        bf16x8 pa[4]; p_to_afrag(p0, p1, pa);
        SBAR();
        if (j + 2 < NT) SLOAD((j + 2) * 64);
        if (__any(alpha < 1.f)) { if (hi == 0) wsf[r32] = alpha; asm volatile("s_waitcnt lgkmcnt(0)" ::: "memory");
#pragma unroll
            for (int r = 0; r < 16; ++r) { const float a = wsf[crow(r, hi)];
#pragma unroll
                for (int d = 0; d < 4; ++d) o[d][r] *= a; } }
#pragma unroll
        for (int d0 = 0; d0 < 4; ++d0) { bf16x8 vf[4]; v_frags(vrb + cur * AT_BUF + d0 * 512, vf);
#pragma unroll
            for (int ks = 0; ks < 4; ++ks) o[d0] = MFMA32(pa[ks], vf[ks], o[d0]); }
        __syncthreads();
    }
#undef SLOAD
#undef SWRITE
    int lz = lane; asm volatile("" : "+v"(lz));
    const int er = lz & 31, eh = lz >> 5;
    if (eh == 0) wsf[er] = l_reg; asm volatile("s_waitcnt lgkmcnt(0)" ::: "memory");
    float rli[16];
#pragma unroll
    for (int r = 0; r < 16; ++r) rli[r] = __builtin_amdgcn_rcpf(wsf[crow(r, eh)]);
    if constexpr (MODE == 0) {
        u16* Y = (u16*)(F.ws + WS_Y);
        const size_t row0 = rb + q0 + wid * 32;
#pragma unroll
        for (int r = 0; r < 16; ++r) { const size_t row = row0 + crow(r, eh);
#pragma unroll
            for (int d0 = 0; d0 < 4; ++d0) { const int col = h * 128 + d0 * 32 + er;
                const float z = bf2f(P[row * NP + C_MZ + col]);
                Y[row * 512 + col] = f2bf(o[d0][r] * rli[r] * z); } }
    } else {
        LAS float* ex = (LAS float*)lds;
        const int lr0 = (wid & 3) * 32;
        if (wid >= 4) {
#pragma unroll
            for (int r = 0; r < 16; ++r)
#pragma unroll
                for (int d0 = 0; d0 < 4; ++d0) ex[(lr0 + crow(r, eh)) * 128 + d0 * 32 + er] = o[d0][r] * rli[r];
        }
        __syncthreads();
        if (wid < 4) {
            const float lam = ((const float*)(F.ws + WS_LAM))[l];
            const float lam_init = 0.8f - 0.6f * __expf(-0.3f * (float)l);
            const float* og = F.in[26] + l * 128;
            u16* Y = (u16*)(F.ws + WS_Y) + (size_t)3 * MG * 512;
            const size_t row0 = rb + q0 + lr0;
            float gg[4];
#pragma unroll
            for (int d0 = 0; d0 < 4; ++d0) gg[d0] = og[d0 * 32 + er] * (1.f - lam_init);
#pragma unroll
            for (int r = 0; r < 16; ++r) { const int lr = lr0 + crow(r, eh); float v[4]; float ss = 0.f;
#pragma unroll
                for (int d0 = 0; d0 < 4; ++d0) { v[d0] = o[d0][r] * rli[r] - lam * ex[lr * 128 + d0 * 32 + er]; ss += v[d0] * v[d0]; }
                ss += __shfl_xor(ss, 1); ss += __shfl_xor(ss, 2); ss += __shfl_xor(ss, 4); ss += __shfl_xor(ss, 8); ss += __shfl_xor(ss, 16);
                const float rs = rsqrtf(ss * (1.f / 128.f) + EPS); const size_t row = row0 + crow(r, eh);
#pragma unroll
                for (int d0 = 0; d0 < 4; ++d0) { const int col = h * 128 + d0 * 32 + er;
                    const float z = bf2f(P[row * NP + C_DZ + col]);
                    Y[row * 512 + col] = f2bf(v[d0] * rs * gg[d0] * z); } }
        }
        __syncthreads();
    }
}
constexpr int SC_DIR = 40960;
constexpr int SC_QB = 0, SC_KA = 8192, SC_KT = 16384, SC_VI = 24576;
constexpr int SC_ST = 2 * SC_DIR;
constexpr int SC_SCL = SC_ST + 8 * 4096;
template <int MIX>
DI void scan_unit(const Ctx& F, int l, int bl, int h) {
    int tz = (int)threadIdx.x; asm volatile("" : "+v"(tz));
    const int tid = tz, wid = F.wave, lane = tz & 63;
    const int dir = wid >> 2, w4 = wid & 3, tl = tid & 255;
    LAS unsigned char* lds = F.lds;
    LAS unsigned char* db = lds + dir * SC_DIR;
    LAS unsigned char* stp = lds + SC_ST + wid * 4096;
    LAS float* scl = (LAS float*)(lds + SC_SCL + dir * 2048);
    LAS float* xch = scl + 256 + w4 * 32;
    const u16* P = (const u16*)(F.ws + WS_P);
    const size_t rb = (size_t)bl * TT;
    u16* osc = (u16*)(F.ws + WS_OSC) + ((size_t)(MIX * 2 + dir) * MG) * 512;
    for (int e = lane; e < 1024; e += 64) ((LAS unsigned*)stp)[e] = 0u;
    if (tid < 128) { const int d2 = tid >> 6; ((LAS float*)(lds + SC_SCL + d2 * 2048))[192 + (tid & 63)] = 0.f; }
    f32x16 S[2];
#pragma unroll
    for (int k = 0; k < 2; ++k)
#pragma unroll
        for (int r = 0; r < 16; ++r) S[k][r] = 0.f;
    float m_run = 0.f;
    const int pi = tl >> 2, pd0 = (tl & 3) * 16;
    const int vr = tl >> 4, vc = (tl & 15) * 8;
    const int vrb = (int)(uintptr_t)db + SC_VI + v_rd_base(lane) + w4 * 512;
    u32x4 rq[2], rk[2]; f32x4 rb4[4], rl4[1];
#define TOK(c, i) (dir == 0 ? (c) * 64 + (i) : ((c) < 4 ? (3 - (c)) : (39 - (c))) * 64 + 63 - (i))
#define CLOAD(c) do { const size_t g = rb + TOK(c, pi), gl = rb + TOK(c, 63); \
        if (MIX == 0) { const u16* qp = P + g * NP + C_GQ + h * 64 + pd0; rq[0] = *(const u32x4*)qp; rq[1] = *(const u32x4*)(qp + 8); \
            const u16* kp = P + g * NP + C_GK + h * 64 + pd0; rk[0] = *(const u32x4*)kp; rk[1] = *(const u32x4*)(kp + 8); \
            const float* bp = (const float*)(F.ws + WS_BG) + ((size_t)dir * MG + g) * 256 + h * 64 + pd0; \
            _Pragma("unroll") for (int z = 0; z < 4; ++z) rb4[z] = *(const f32x4*)(bp + 4 * z); \
        } else { const u16* qp = (const u16*)(F.ws + WS_QKML) + g * 512 + h * 64 + pd0; rq[0] = *(const u32x4*)qp; rq[1] = *(const u32x4*)(qp + 8); \
            rk[0] = *(const u32x4*)(qp + 256); rk[1] = *(const u32x4*)(qp + 264); \
            rb4[0] = *(const f32x4*)((const float*)(F.ws + WS_SCAL) + (((size_t)dir * MG + g) * 4 + h) * 4); rl4[0] = *(const f32x4*)((const float*)(F.ws + WS_SCAL) + (((size_t)dir * MG + gl) * 4 + h) * 4); } } while (0)
    CLOAD(0);
    __syncthreads();
    for (int c = 0; c < 36; ++c) {
        float m_new = 0.f, decay = 1.f, M63 = 0.f;
        u32x4 rv[4];
#pragma unroll
        for (int z = 0; z < 4; ++z) rv[z] = *(const u32x4*)(P + (rb + TOK(c, vr + 16 * z)) * NP + (MIX == 0 ? C_GV : C_MV) + h * 128 + vc);
        { float q[16], k[16]; unpack8(rq[0], q); unpack8(rq[1], q + 8); unpack8(rk[0], k); unpack8(rk[1], k + 8);
          float qe[16], ke[16], kt[16];
          if (MIX == 0) {
#pragma unroll
              for (int e = 0; e < 16; ++e) { const float bb = rb4[e >> 2][e & 3];
                  qe[e] = q[e] * __expf(bb); ke[e] = k[e] * __expf(-bb); kt[e] = ke[e]; }
              if (pi == 63) {
#pragma unroll
                  for (int e = 0; e < 16; ++e) scl[pd0 + e] = __expf(rb4[e >> 2][e & 3]); }
          } else {
              const float b_i = rb4[0][0], a_i = rb4[0][1], pm_i = rb4[0][2], bL = rl4[0][0], pmL = rl4[0][2];
              M63 = fmaxf(m_run, pmL); m_new = bL + M63; decay = __expf(m_run - M63);
              const float wu = __expf(a_i - M63);
#pragma unroll
              for (int e = 0; e < 16; ++e) { qe[e] = q[e]; ke[e] = k[e]; kt[e] = k[e] * wu; }
              float qn = 0.f;
#pragma unroll
              for (int e = 0; e < 16; ++e) qn += q[e] * scl[192 + pd0 + e];
              qn += __shfl_xor(qn, 1); qn += __shfl_xor(qn, 2);
              if ((tl & 3) == 0) { scl[pi] = b_i; scl[64 + pi] = a_i; scl[128 + pi] = pm_i; scl[384 + pi] = qn; }
          }
          *(LAS u32x4*)(db + SC_QB + swz64(pi, pd0 * 2)) = pack8(qe); *(LAS u32x4*)(db + SC_QB + swz64(pi, pd0 * 2 + 16)) = pack8(qe + 8);
          *(LAS u32x4*)(db + SC_KA + swz64(pi, pd0 * 2)) = pack8(ke); *(LAS u32x4*)(db + SC_KA + swz64(pi, pd0 * 2 + 16)) = pack8(ke + 8);
#pragma unroll
          for (int e = 0; e < 16; ++e) *(LAS u16*)(db + SC_KT + swz64(pd0 + e, pi * 2)) = f2bf(kt[e]);
        }
#pragma unroll
        for (int z = 0; z < 4; ++z) *(LAS u32x4*)(db + SC_VI + v_st(vr + 16 * z, vc)) = rv[z];
        if (c + 1 < 36) CLOAD(c + 1);
        __syncthreads();
        int lz = lane; asm volatile("" : "+v"(lz));
        const int r32 = lz & 31, hi = lz >> 5;
        bf16x8 bs[4];
#pragma unroll
        for (int ks = 0; ks < 4; ++ks) bs[ks] = ldsv(stp + swz64(r32, (ks * 16 + hi * 8) * 2));
        bf16x8 vf[4]; v_frags(vrb, vf);
#pragma nounroll
        for (int qb = 0; qb < 2; ++qb) {
            bf16x8 qf[4];
#pragma unroll
            for (int ks = 0; ks < 4; ++ks) qf[ks] = ldsv(db + SC_QB + qb * 4096 + swz64(r32, (ks * 16 + hi * 8) * 2));
            f32x16 o;
#pragma unroll
            for (int r = 0; r < 16; ++r) o[r] = 0.f;
#pragma unroll
            for (int ks = 0; ks < 4; ++ks) o = MFMA32(qf[ks], bs[ks], o);
            const int qi = 32 * qb + r32;
            float scale_q = 1.f, rs = 0.f;
            const float Mq = (MIX == 1) ? fmaxf(m_run, scl[128 + qi]) : 0.f;
            bf16x8 pa[4];
#pragma unroll
            for (int kh = 0; kh < 2; ++kh) {
                f32x16 p;
#pragma unroll
                for (int r = 0; r < 16; ++r) p[r] = 0.f;
#pragma unroll
                for (int ks = 0; ks < 4; ++ks) p = MFMA32(ldsv(db + SC_KA + kh * 4096 + swz64(r32, (ks * 16 + hi * 8) * 2)), qf[ks], p);
                if (MIX == 0) {
#pragma unroll
                    for (int r = 0; r < 16; ++r) p[r] = (crow(r, hi) + 32 * kh <= qi) ? p[r] : 0.f;
                } else {
#pragma unroll
                    for (int r = 0; r < 16; ++r) { const int kk = crow(r, hi) + 32 * kh; p[r] = (kk <= qi) ? p[r] * __expf(scl[64 + kk] - Mq) : 0.f; rs += p[r]; }
                }
                if (kh == 0) p_half_to_afrag(p, pa[0], pa[1]); else p_half_to_afrag(p, pa[2], pa[3]);
            }
            if (MIX == 1) {
                rs = half_swap_sum(rs);
                const float iw = __expf(m_run - Mq), den = iw * scl[384 + qi] + rs, mi = scl[qi] + Mq;
                scale_q = 1.f / fmaxf(fabsf(den), __expf(-mi));
#pragma unroll
                for (int r = 0; r < 16; ++r) o[r] *= __expf(m_run - fmaxf(m_run, scl[128 + 32 * qb + crow(r, hi)]));
            }
#pragma unroll
            for (int ks = 0; ks < 4; ++ks) o = MFMA32(pa[ks], vf[ks], o);
            if (MIX == 1) {
                if (hi == 0) xch[r32] = scale_q;
                asm volatile("s_waitcnt lgkmcnt(0)" ::: "memory");
#pragma unroll
                for (int r = 0; r < 16; ++r) o[r] *= xch[crow(r, hi)];
            }
#pragma unroll
            for (int r = 0; r < 16; ++r) { const int qq = 32 * qb + crow(r, hi); osc[(rb + TOK(c, qq)) * 512 + h * 128 + w4 * 32 + r32] = f2bf(o[r]); }
        }
        float nnew = 0.f;
#pragma unroll
        for (int dk = 0; dk < 2; ++dk) {
            if (MIX == 1) {
#pragma unroll
                for (int r = 0; r < 16; ++r) S[dk][r] *= decay;
            }
#pragma unroll
            for (int ks = 0; ks < 4; ++ks) { const bf16x8 a = ldsv(db + SC_KT + swz64(32 * dk + r32, (ks * 16 + hi * 8) * 2)); S[dk] = MFMA32(a, vf[ks], S[dk]); }
            if (MIX == 0) {
#pragma unroll
                for (int r = 0; r < 16; ++r) S[dk][r] *= scl[32 * dk + crow(r, hi)];
            }
        }
        if (MIX == 1 && w4 == 0) {
            float sum = 0.f;
#pragma unroll
            for (int j = 0; j < 8; ++j) { float kv[8]; unpack8(__builtin_bit_cast(u32x4, ldsv(db + SC_KT + swz64(lane, j * 16))), kv);
#pragma unroll
                for (int e = 0; e < 8; ++e) sum += kv[e]; }
            nnew = decay * scl[192 + lane] + sum;
            scl[192 + lane] = nnew;
        }
#pragma unroll
        for (int dk = 0; dk < 2; ++dk)
#pragma unroll
            for (int g4 = 0; g4 < 4; ++g4) { u32x2 w; w.x = pk2(S[dk][4 * g4], S[dk][4 * g4 + 1]); w.y = pk2(S[dk][4 * g4 + 2], S[dk][4 * g4 + 3]);
                *(LAS u32x2*)(stp + swz64(r32, (32 * dk + 8 * g4 + 4 * hi) * 2)) = w; }
        if (MIX == 1) m_run = m_new;
        __syncthreads();
    }
#undef CLOAD
    asm volatile("s_waitcnt vmcnt(0)" ::: "memory");
    __syncthreads();
    {
        const u16* of = (const u16*)(F.ws + WS_OSC) + ((size_t)(MIX * 2 + 0) * MG) * 512;
        const u16* ob = (const u16*)(F.ws + WS_OSC) + ((size_t)(MIX * 2 + 1) * MG) * 512;
        u16* Y = (u16*)(F.ws + WS_Y) + (size_t)(MIX == 0 ? 1 : 2) * MG * 512;
        const float* og = (MIX == 0 ? F.in[16] : F.in[22]) + l * 512 + h * 128;
        const float* skp = F.in[23] + l * 512 + h * 128;
        const u16* XC = (const u16*)(F.ws + WS_XC);
        int tq = (int)threadIdx.x; asm volatile("" : "+v"(tq));
        const int c8 = (tq & 15) * 8;
        float g8[8], s8[8];
#pragma unroll
        for (int e = 0; e < 8; ++e) { g8[e] = og[c8 + e]; s8[e] = (MIX == 1) ? skp[c8 + e] : 0.f; }
        for (int t = tq >> 4; t < TT; t += 32) {
            const size_t row = rb + t; const int col = h * 128 + c8;
            float a[8], b[8], v[8]; unpack8(*(const u32x4*)(of + row * 512 + col), a); unpack8(*(const u32x4*)(ob + row * 512 + col), b);
            float ss = 0.f;
            if (MIX == 1) { float og8[8]; unpack8(*(const u32x4*)(P + row * NP + C_MO + col), og8);
#pragma unroll
                for (int e = 0; e < 8; ++e) { v[e] = (a[e] + b[e]) * og8[e]; ss += v[e] * v[e]; }
            } else {
#pragma unroll
                for (int e = 0; e < 8; ++e) { v[e] = a[e] + b[e]; ss += v[e] * v[e]; } }
            ss = group_sum(ss, 16);
            const float rs = rsqrtf(ss * (1.f / 128.f) + EPS);
            float z[8]; unpack8(*(const u32x4*)(P + row * NP + (MIX == 0 ? C_GZ : C_MLZ) + col), z);
            if (MIX == 1) { float xc[8]; unpack8(*(const u32x4*)(XC + row * 512 + col), xc);
#pragma unroll
                for (int e = 0; e < 8; ++e) v[e] = (v[e] * rs * g8[e] + s8[e] * xc[e]) * z[e];
            } else {
#pragma unroll
                for (int e = 0; e < 8; ++e) v[e] = v[e] * rs * g8[e] * z[e]; }
            *(u32x4*)(Y + row * 512 + col) = pack8(v);
        }
    }
    __syncthreads();
#undef TOK
}
DI void p4_mixers(const Ctx& F, int l, int it) {
    const bool last = (l == DEPTH - 1);
    constexpr int N_SCAN = 2 * BGR * 4, N_MLA = BGR * 4 * 8, N_DF = BGR * 4 * 16, N_MLAC = BGR * 4, N_DFC = BGR * 4 * 2;
    constexpr int O_MLA = N_SCAN, O_DF = O_MLA + N_MLA, O_MLAC = O_DF + N_DF, O_DFC = O_MLAC + N_MLAC, N_ALL = O_DFC + N_DFC;
    const int total = last ? O_MLAC : N_ALL;
    unsigned* head = F.ctl + CW_QUEUE + 64 * it;
    volatile LAS unsigned* misc = (volatile LAS unsigned*)(F.lds + LDS_MISC);
    for (;;) {
        __syncthreads();
        if ((int)threadIdx.x == 0) misc[0] = __hip_atomic_fetch_add(head, 1u, __ATOMIC_RELAXED, __HIP_MEMORY_SCOPE_AGENT);
        __syncthreads();
        const int u = (int)misc[0];
        if (u >= total) break;
#ifndef P4_MASK
#define P4_MASK 0xf
#endif
        if (u < O_MLA) { const int mix = u >> 5, rem = u & 31, bl = rem >> 2, h = rem & 3;
            if (mix == 0) { if (P4_MASK & 1) scan_unit<0>(F, l, bl, h); } else { if (P4_MASK & 2) scan_unit<1>(F, l, bl, h); } }
        else if (u < O_DF) { const int v = u - O_MLA, bl = v >> 5, h = (v >> 3) & 3, qb = v & 7; if (P4_MASK & 4) attn_unit<0>(F, l, bl, h, NCTX + qb * 256, TT); }
        else if (u < O_MLAC) { const int v = u - O_DF, bl = v >> 6, h = (v >> 4) & 3, qb = v & 15; if (P4_MASK & 8) attn_unit<1>(F, l, bl, h, NCTX + qb * 128, TT); }
        else if (u < O_DFC) { const int v = u - O_MLAC, bl = v >> 2, h = v & 3; if (P4_MASK & 4) attn_unit<0>(F, l, bl, h, 0, NCTX); }
        else { const int v = u - O_DFC, bl = v >> 3, h = (v >> 1) & 3, qb = v & 1; if (P4_MASK & 8) attn_unit<1>(F, l, bl, h, qb * 128, NCTX); }
    }
}

__global__ void __launch_bounds__(512, 2) fwd_kernel(Params prm) {
    extern __shared__ __attribute__((aligned(16))) unsigned char lds_raw[];
    Ctx F;
    F.in = prm.in;
    F.out = prm.out; F.ws = prm.ws; F.ctl = (unsigned*)(prm.ws + WS_CTL);
    F.wave = __builtin_amdgcn_readfirstlane((int)threadIdx.x >> 6); F.G = gridDim.x;
    F.lds = (LAS unsigned char*)lds_raw;
    if ((int)threadIdx.x < 16) ((LAS unsigned*)(F.lds + LDS_MISC))[(int)threadIdx.x] = 0u;
    __syncthreads();
    XcdBarrier bar = xcd_barrier_post(F.ctl, (volatile LAS unsigned*)(F.lds + LDS_BARW));
    const int s_lo = prm.s_lo, s_hi = prm.s_hi;
#ifndef PH_MASK
#define PH_MASK 0xff
#endif
#define IN(s) (s_lo <= (s) && (s) < s_hi)
#define PHON(k) ((PH_MASK >> (k)) & 1)
#define FRESH() do { unsigned char* w_ = prm.ws; float* o_ = prm.out; asm volatile("" : "+s"(w_), "+s"(o_)); F.ws = w_; F.ctl = (unsigned*)w_; F.out = o_; } while (0)
#define SEAM(s) do { if ((s) + 1 < s_hi) { XcdBarrier b_ = bar; asm volatile("" : "+s"(b_.bar)); xcd_barrier(b_); } } while (0)
    if (PHON(0) && IN(0)) { FRESH(); p0_prologue(F); SEAM(0); }
    for (int it = 0; it < DEPTH * NGRP; ++it) {
        const int l = it / NGRP, g = it % NGRP, sb = 1 + it * 7;
        if (sb + 7 <= s_lo || sb >= s_hi) continue;
        if (PHON(1) && IN(sb + 0)) { FRESH(); p1_norm(F, l, g); SEAM(sb + 0); }
        if (PHON(2) && IN(sb + 1)) {
            FRESH(); u16* Pb = (u16*)(F.ws + WS_P);
            pg8::Gemm gm{(const u16*)(F.ws + WS_H), (const u16*)(F.ws + WS_WIN) + (size_t)l * NP * 1024, MG, NP, 1024, 1024};
            pg8::StaticOrder S; S.init(MG, NP, F.G, (int)blockIdx.x);
            EpiBf E{Pb, NP, 1};
            pg8::gemm_phase<EpiBf, pg8::StaticOrder, true, true>(F.lds, gm, S, E);
            SEAM(sb + 1);
        }
        if (PHON(3) && IN(sb + 2)) {
            FRESH(); u16* Pb = (u16*)(F.ws + WS_P);
            { pg8::Gemm gm{Pb + C_CQ, (const u16*)(F.ws + WS_WUQ) + (size_t)l * 768 * 384, MG, 768, 384, NP};
              pg8::StaticOrder S; S.init(MG, 768, F.G, (int)blockIdx.x);
              EpiBf E{(u16*)(F.ws + WS_Q), 768, 0};
              pg8::gemm_phase<EpiBf, pg8::StaticOrder, true, true>(F.lds, gm, S, E); }
            { pg8::Gemm gm{Pb + C_CKV, (const u16*)(F.ws + WS_WUKV) + (size_t)l * 1024 * 256, MG, 1024, 256, NP};
              int c2 = (int)blockIdx.x + 40; if (c2 >= F.G) c2 -= F.G;
              pg8::StaticOrder S; S.init(MG, 1024, F.G, c2);
              EpiBf E{(u16*)(F.ws + WS_KV), 1024, 0};
              pg8::gemm_phase<EpiBf, pg8::StaticOrder, true, true>(F.lds, gm, S, E); }
            __syncthreads();
            p3_rows(F, l);
            p3_gates(F, l);
            SEAM(sb + 2);
        }
        if (PHON(4) && IN(sb + 3)) {
            FRESH();
            p3b_rows(F, l);
            { pg8::Gemm gm{(const u16*)(F.ws + WS_XC), (const u16*)(F.ws + WS_WQK) + (size_t)l * 512 * 512, MG, 512, 512, 512};
              pg8::StaticOrder S; S.init(MG, 512, F.G, (int)blockIdx.x);
              EpiBf E{(u16*)(F.ws + WS_QKML), 512, 0};
              pg8::gemm_phase<EpiBf, pg8::StaticOrder, true, true>(F.lds, gm, S, E); }
            SEAM(sb + 3);
        }
        if (PHON(5) && IN(sb + 4)) { FRESH(); p4_mixers(F, l, it); SEAM(sb + 4); }
        if (PHON(6) && IN(sb + 5)) {
            FRESH(); u16* Pb = (u16*)(F.ws + WS_P);
#pragma nounroll
            for (int i = 0; i < 4; ++i) {
                pg8::Gemm gm{(const u16*)(F.ws + WS_Y) + (size_t)i * MG * 512, (const u16*)(F.ws + WS_BR) + ((size_t)l * 4 + i) * 1024 * 512, MG, 1024, 512, 512};
                pg8::StaticOrder S; S.init(MG, 1024, F.G, (int)blockIdx.x);
                EpiMerge E{(float*)(F.ws + WS_MF), (u16*)(F.ws + WS_MB), Pb + C_MG + i * 1024, i == 0 ? 0 : (i == 3 ? 2 : 1)};
                pg8::gemm_phase<EpiMerge, pg8::StaticOrder, true, true>(F.lds, gm, S, E);
            }
            SEAM(sb + 5);
        }
        if (PHON(7) && IN(sb + 6)) {
            FRESH();
            pg8::Gemm gm{(const u16*)(F.ws + WS_MB), (const u16*)(F.ws + WS_WO) + (size_t)l * 1024 * 1024, MG, 1024, 1024, 1024};
            pg8::StaticOrder S; S.init(MG, 1024, F.G, (int)blockIdx.x);
            EpiOut E{l == 0 ? F.in[0] : F.out, F.out, l == 0 ? F.in[2] : (const float*)(F.ws + WS_CTX), (float*)(F.ws + WS_CTX),
                     (const float*)(F.ws + WS_MOD) + (size_t)l * 33 * 3072, g, l == DEPTH - 1 ? 1 : 0};
            pg8::gemm_phase<EpiOut, pg8::StaticOrder, true, true>(F.lds, gm, S, E);
            SEAM(sb + 6);
        }
    }
#undef IN
#undef SEAM
}

extern "C" void kernel_launch(void* const* d_in, const int* in_sizes, int n_in, void* d_out, int out_size, void* d_ws, size_t ws_size, hipStream_t stream) {
    static int grid = 0;
    if (grid == 0) {
        if (n_in != 29 || out_size != NB * SEQ * DM || ws_size < WS_END) { fprintf(stderr, "kernel_launch: unexpected shapes (n_in %d, out %d, ws %zu < %zu)\n", n_in, out_size, ws_size, (size_t)WS_END); grid = -1; return; }
        int dev = 0, cus = 0, per_cu = 0;
        if (hipGetDevice(&dev) != hipSuccess || hipDeviceGetAttribute(&cus, hipDeviceAttributeMultiprocessorCount, dev) != hipSuccess) { grid = -1; return; }
        if (hipFuncSetAttribute((const void*)fwd_kernel, hipFuncAttributeMaxDynamicSharedMemorySize, LDS_BYTES) != hipSuccess) { fprintf(stderr, "kernel_launch: hipFuncSetAttribute failed\n"); grid = -1; return; }
        if (hipOccupancyMaxActiveBlocksPerMultiprocessor(&per_cu, (const void*)fwd_kernel, 512, LDS_BYTES) != hipSuccess || per_cu < 1) { fprintf(stderr, "kernel_launch: occupancy query reports %d blocks per CU\n", per_cu); }
        (void)hipGetLastError();
        grid = cus;
    }
    if (grid < 0) return;
    (void)hipMemsetAsync((char*)d_ws + WS_CTL, 0, CTL_BYTES, stream);
    Params p{};
    for (int i = 0; i < 29; ++i) p.in[i] = (const float*)d_in[i];
    p.out = (float*)d_out; p.ws = (unsigned char*)d_ws;
#if MK_MULTI
    for (int s = 0; s < NSTEP; ++s) { p.s_lo = s; p.s_hi = s + 1; hipLaunchKernelGGL(fwd_kernel, dim3(grid), dim3(512), LDS_BYTES, stream, p); }
#else
    p.s_lo = 0; p.s_hi = NSTEP;
    hipLaunchKernelGGL(fwd_kernel, dim3(grid), dim3(512), LDS_BYTES, stream, p);
#endif
    const hipError_t le = hipPeekAtLastError();
    if (le != hipSuccess) fprintf(stderr, "kernel_launch: launch failed: %s\n", hipGetErrorName(le));
}
```

```cpp
#include <hip/hip_runtime.h>
#include <cstdio>
#include <cstdint>
#include <cstddef>

#ifndef MK_MULTI
#define MK_MULTI 0
#endif

#define XB_TMO      128
#define XB_XCNT(j)  (256  + 64 * (j))
#define XB_XSUB(j)  (1280 + 64 * (j))
#define XB_XGEN(j)  (2304 + 64 * (j))
#define XB_TOP      3328
#define XB_TOPGEN   3392
#define XCD_BAR_WORDS 3456
#define XB_SPIN_CAP (1u << 18)
#define LAS __attribute__((address_space(3)))

__device__ __forceinline__ unsigned xb_ld(unsigned* p)              { return __hip_atomic_load(p, __ATOMIC_RELAXED, __HIP_MEMORY_SCOPE_AGENT); }
__device__ __forceinline__ unsigned xb_add(unsigned* p, unsigned v) { return __hip_atomic_fetch_add(p, v, __ATOMIC_RELAXED, __HIP_MEMORY_SCOPE_AGENT); }
__device__ __forceinline__ unsigned xb_xcc_id() { return (unsigned)__builtin_amdgcn_s_getreg((3 << 11) | 20) & 0xFu; }
#define XB_SPIN(cond, bar) do { unsigned _sp = 0; while (cond) { __builtin_amdgcn_s_sleep(1); \
    if ((++_sp & 255u) == 0u) { if (xb_ld(&(bar)[XB_TMO])) break; if (_sp > XB_SPIN_CAP) { atomicAdd(&(bar)[XB_TMO], 1u); break; } } } } while (0)

struct XcdBarrier {
    unsigned* bar; unsigned x;
    volatile LAS unsigned* st;
};

__device__ __forceinline__ XcdBarrier xcd_barrier_post(unsigned* bar, volatile LAS unsigned* st) {
    XcdBarrier b; b.bar = bar; b.x = xb_xcc_id(); b.st = st;
    if (threadIdx.x == 0) (void)xb_add(&bar[XB_XCNT(b.x)], 1u);
    return b;
}
__device__ __forceinline__ void xcd_barrier_complete(unsigned* bar, unsigned x, unsigned& nloc, unsigned& nx) {
    const unsigned G = gridDim.x * gridDim.y * gridDim.z;
    unsigned sum, cnt, mine, sp = 0u;
    for (;;) {
        sum = 0u; cnt = 0u; mine = 0u;
#pragma unroll
        for (unsigned j = 0; j < 16; ++j) { const unsigned c = xb_ld(&bar[XB_XCNT(j)]); sum += c; cnt += (c > 0u) ? 1u : 0u; mine = (j == x) ? c : mine; }
        if (sum == G) break;
        __builtin_amdgcn_s_sleep(1);
        if ((++sp & 255u) == 0u) { if (xb_ld(&bar[XB_TMO])) break; if (sp > XB_SPIN_CAP) { atomicAdd(&bar[XB_TMO], 1u); break; } }
    }
    nloc = mine > 0u ? mine : 1u; nx = cnt > 0u ? cnt : 1u;
}

__device__ __forceinline__ void xcd_barrier(const XcdBarrier& b) {
    asm volatile("s_waitcnt vmcnt(0)" ::: "memory");
    __syncthreads();
    if (threadIdx.x == 0) {
        unsigned* bar = b.bar;
        __builtin_amdgcn_s_waitcnt(0);
        unsigned nloc = b.st[0], nx = b.st[1];
        if (nloc == 0u) { xcd_barrier_complete(bar, b.x, nloc, nx); b.st[0] = nloc; b.st[1] = nx; }
        const unsigned old = xb_add(&bar[XB_XSUB(b.x)], 1u);
        const unsigned gen = old / nloc;
        if (old + 1u == (gen + 1u) * nloc) {
            __builtin_amdgcn_fence(__ATOMIC_RELEASE, "agent");
            asm volatile("s_waitcnt vmcnt(0)" ::: "memory");
            const unsigned og = xb_add(&bar[XB_TOP], 1u);
            const unsigned tg = og / nx;
            if (og + 1u == (tg + 1u) * nx) xb_add(&bar[XB_TOPGEN], 1u);
            else XB_SPIN(xb_ld(&bar[XB_TOPGEN]) == tg, bar);
            __builtin_amdgcn_fence(__ATOMIC_ACQUIRE, "agent");
            xb_add(&bar[XB_XGEN(b.x)], 1u);
            asm volatile("s_waitcnt vmcnt(0)" ::: "memory");
        } else {
            XB_SPIN(xb_ld(&bar[XB_XGEN(b.x)]) == gen, bar);
            __builtin_amdgcn_fence(__ATOMIC_ACQUIRE, "agent");
            asm volatile("s_waitcnt vmcnt(0)" ::: "memory");
        }
    }
    __syncthreads();
}

namespace pg8 {
#define PG8_LAS __attribute__((address_space(3)))
typedef unsigned short bf16_t;
typedef short bf16x8 __attribute__((ext_vector_type(8)));
typedef float f32x4 __attribute__((ext_vector_type(4)));
typedef unsigned u32x4 __attribute__((ext_vector_type(4)));
constexpr int BM = 256, BK = 64, HALF = 128, HTB = HALF * BK * 2  , STAGE_BYTES = 8 * HTB, NXCD = 8, WGM = 8;

__host__ __device__ __forceinline__ int lds_byte(int r, int c) { const int st = (r >> 4) * 2 + (c >> 5), rr = r & 15, cc = c & 31, ob = rr * 64 + cc * 2; return st * 1024 + (ob ^ (((ob >> 9) & 1) << 5)); }
__host__ __device__ __forceinline__ void stage_rc(int b, int& R, int& C) { const int st = b / 1024, sb = b % 1024, swz = sb ^ (((sb >> 9) & 1) << 5); R = (st >> 1) * 16 + swz / 64; C = (st & 1) * 32 + (swz % 64) / 2; }
__host__ __device__ __forceinline__ int perm32(int rho) { const int n = rho >> 4, i = rho & 15; return 8 * (i >> 2) + 4 * n + (i & 3); }

struct Unit { int pm, pn; };
struct Gemm { const bf16_t* A; const bf16_t* Bt; int M, N, K, lda; };

struct StaticOrder {
    int nM, nN, nwg, G, c;
    __host__ __device__ void init(int M, int N, int G_, int c_) { nM = M / BM; nN = N / BM; nwg = nM * nN; G = G_; c = c_; }
    __host__ __device__ bool next(int i, Unit& u) const {
        const long L = (long)i * G + c; if (L >= nwg) return false;
        int wgid = (int)L; { const int q = nwg / NXCD, r = nwg % NXCD, xcd = wgid % NXCD, off = wgid / NXCD; wgid = (xcd < r ? xcd * (q + 1) : r * (q + 1) + (xcd - r) * q) + off; }
        const int nig = WGM * nN, gid = wgid / nig, fm = gid * WGM, gsz = (nM - fm) < WGM ? (nM - fm) : WGM;
        u.pm = fm + ((wgid % nig) % gsz); u.pn = (wgid % nig) / gsz; return true;
    }
    __device__ __forceinline__ void a_ready(const Unit&) const {}
    __device__ __forceinline__ void done(const Unit&) const {}
};

template <class Epi, class Sched, bool ALIGN_EPI = false, bool SP2 = false>
__device__ __forceinline__ void gemm_phase(PG8_LAS unsigned char* lds, const Gemm g, const Sched& S, const Epi& E) {
    int tid_ = threadIdx.x; asm volatile("" : "+v"(tid_));
    const int tid = tid_, wid = __builtin_amdgcn_readfirstlane(tid >> 6), lane = tid & 63, wr = wid >> 2, wc = wid & 3, fr = lane & 15, fq = lane >> 4;
    const int K = g.K, nt = K / BK;
    unsigned voffA[2], voffB[2];
#pragma unroll
    for (int i = 0; i < 2; ++i) { int R, C; stage_rc(tid * 16 + i * 8192, R, C); const int Rb = Epi::PERM ? ((R & ~31) + perm32(R & 31)) : R;
        voffA[i] = (unsigned)(R * g.lda + C) * 2u; voffB[i] = (unsigned)(Rb * K + C) * 2u; }
    const size_t kstep = (size_t)(BK * 2);
    const size_t hstep = (size_t)HALF * K * 2;
    const size_t tstep = 2 * hstep; const size_t hstepA = (size_t)HALF * g.lda * 2, tstepA = 2 * hstepA;
    const unsigned ldsw = (unsigned)wid * 1024u;
    const int aoff = lds_byte(wr * 64 + fr, fq * 8), boff = lds_byte(wc * 32 + fr, fq * 8);
#define PG8_SA(b, h) (((b) * 2 + (h)) * HTB)
#define PG8_SB(b, h) ((4 + (b) * 2 + (h)) * HTB)
#define PG8_STAGE(bufoff, gbase, voff) do { _Pragma("unroll") for (int _i = 0; _i < 2; ++_i) \
        __builtin_amdgcn_global_load_lds((const unsigned*)((const char*)(gbase) + (voff)[_i]), (PG8_LAS unsigned*)(lds + (bufoff) + ldsw + _i * 8192), 16, 0, 0); } while (0)
#define PG8_LDA(dst, b, h) do { _Pragma("unroll") for (int m = 0; m < 4; ++m) _Pragma("unroll") for (int k = 0; k < 2; ++k) dst[m][k] = *(const PG8_LAS bf16x8*)(lds + PG8_SA(b, h) + aoff + m * 2048 + k * 1024); } while (0)
#define PG8_LDB(dst, b, h) do { _Pragma("unroll") for (int n = 0; n < 2; ++n) _Pragma("unroll") for (int k = 0; k < 2; ++k) dst[n][k] = *(const PG8_LAS bf16x8*)(lds + PG8_SB(b, h) + boff + n * 2048 + k * 1024); } while (0)
#define PG8_MMA(ai, bj, At, Bt) do { __builtin_amdgcn_s_setprio(1); _Pragma("unroll") for (int m = 0; m < 4; ++m) _Pragma("unroll") for (int n = 0; n < 2; ++n) _Pragma("unroll") for (int k = 0; k < 2; ++k) \
        acc[ai][bj][m][n] = __builtin_amdgcn_mfma_f32_16x16x32_bf16(Bt[n][k], At[m][k], acc[ai][bj][m][n], 0, 0, 0); __builtin_amdgcn_s_setprio(0); } while (0)
#define PG8_WAIT_V(n) asm volatile("s_waitcnt vmcnt(" #n ")" ::: "memory")
#define PG8_WAIT_L(n) asm volatile("s_waitcnt lgkmcnt(" #n ")" ::: "memory")
#define PG8_BAR __builtin_amdgcn_s_barrier()
#define PG8_SCHED __builtin_amdgcn_sched_barrier(0)
    Unit cur, nxt; int ui = 0;
    if (!S.next(0, cur)) return;
    f32x4 acc[2][2][4][2];
#pragma unroll
    for (int a = 0; a < 2; ++a)
#pragma unroll
        for (int b = 0; b < 2; ++b)
#pragma unroll
            for (int m = 0; m < 4; ++m)
#pragma unroll
                for (int n = 0; n < 2; ++n) acc[a][b][m][n] = (f32x4){0.f, 0.f, 0.f, 0.f};
    bf16x8 At[4][2], B0[2][2], B1[2][2];
    const char* cA = (const char*)g.A + (size_t)cur.pm * tstepA; const char* cB = (const char*)g.Bt + (size_t)cur.pn * tstep;
    S.a_ready(cur);
    if constexpr (SP2) {
        PG8_STAGE(PG8_SB(0, 0), cB, voffB); PG8_STAGE(PG8_SB(0, 1), cB + hstep, voffB); PG8_STAGE(PG8_SA(0, 0), cA, voffA); PG8_STAGE(PG8_SA(0, 1), cA + hstepA, voffA);
        if (wr == 1) PG8_BAR;
        PG8_WAIT_V(2); PG8_BAR;
        PG8_STAGE(PG8_SB(1, 0), cB + kstep, voffB); PG8_STAGE(PG8_SA(1, 0), cA + kstep, voffA); PG8_STAGE(PG8_SB(1, 1), cB + hstep + kstep, voffB);
        PG8_WAIT_V(6); PG8_BAR;
    } else {
        PG8_STAGE(PG8_SB(0, 0), cB, voffB); PG8_STAGE(PG8_SA(0, 0), cA, voffA); PG8_STAGE(PG8_SB(0, 1), cB + hstep, voffB); PG8_STAGE(PG8_SA(0, 1), cA + hstepA, voffA);
        if (wr == 1) PG8_BAR;
        PG8_WAIT_V(4); PG8_BAR;
        PG8_STAGE(PG8_SB(1, 0), cB + kstep, voffB); PG8_STAGE(PG8_SA(1, 0), cA + kstep, voffA); PG8_STAGE(PG8_SB(1, 1), cB + hstep + kstep, voffB);
        PG8_WAIT_V(6); PG8_BAR;
    }
    for (;;) {
        const bool has_next = S.next(ui + 1, nxt);
        const char* nA = has_next ? (const char*)g.A + (size_t)nxt.pm * tstepA : cA; const char* nB = has_next ? (const char*)g.Bt + (size_t)nxt.pn * tstep : cB;
        for (int t = 0; t < nt; t += 2) {
            const bool last = (t == nt - 2);
            const char* a1 = cA + (size_t)(t + 1) * kstep;
            const char* a2 = last ? nA : cA + (size_t)(t + 2) * kstep; const char* b2 = last ? nB : cB + (size_t)(t + 2) * kstep;
            const char* a3 = a2 + kstep; const char* b3 = b2 + kstep;
            if (last && has_next) S.a_ready(nxt);
            if constexpr (SP2) {
            PG8_LDB(B0, 0, 0); PG8_LDB(B1, 0, 1); PG8_SCHED; PG8_LDA(At, 0, 0); PG8_STAGE(PG8_SA(1, 1), a1 + hstepA, voffA);
            PG8_WAIT_V(8); PG8_WAIT_L(0); PG8_BAR; PG8_MMA(0, 0, At, B0); PG8_MMA(0, 1, At, B1); PG8_BAR; PG8_SCHED;
            PG8_LDA(At, 0, 1); PG8_STAGE(PG8_SB(0, 0), b2, voffB); PG8_STAGE(PG8_SB(0, 1), b2 + hstep, voffB); PG8_STAGE(PG8_SA(0, 0), a2, voffA);
            PG8_WAIT_V(8); PG8_WAIT_L(0); PG8_BAR; PG8_MMA(1, 0, At, B0); PG8_MMA(1, 1, At, B1); PG8_BAR; PG8_SCHED;
            PG8_LDB(B0, 1, 0); PG8_LDB(B1, 1, 1); PG8_SCHED; PG8_LDA(At, 1, 0); PG8_STAGE(PG8_SA(0, 1), a2 + hstepA, voffA);
            PG8_WAIT_V(8); PG8_WAIT_L(0); PG8_BAR; PG8_MMA(0, 0, At, B0); PG8_MMA(0, 1, At, B1); PG8_BAR; PG8_SCHED;
            PG8_LDA(At, 1, 1); PG8_STAGE(PG8_SB(1, 0), b3, voffB); PG8_STAGE(PG8_SB(1, 1), b3 + hstep, voffB); PG8_STAGE(PG8_SA(1, 0), a3, voffA);
            PG8_WAIT_V(8); PG8_WAIT_L(0); PG8_BAR; PG8_MMA(1, 0, At, B0); PG8_MMA(1, 1, At, B1); PG8_BAR; PG8_SCHED;
            } else {
            PG8_LDB(B0, 0, 0); PG8_SCHED; PG8_LDA(At, 0, 0); PG8_STAGE(PG8_SA(1, 1), a1 + hstepA, voffA);
            PG8_WAIT_L(8); PG8_BAR; PG8_WAIT_L(0); PG8_MMA(0, 0, At, B0); PG8_BAR; PG8_SCHED;
            PG8_LDB(B1, 0, 1); PG8_STAGE(PG8_SB(0, 0), b2, voffB);
            PG8_BAR; PG8_WAIT_L(0); PG8_MMA(0, 1, At, B1); PG8_BAR;
            PG8_LDA(At, 0, 1); PG8_STAGE(PG8_SA(0, 0), a2, voffA);
            PG8_BAR; PG8_WAIT_L(0); PG8_MMA(1, 0, At, B0); PG8_BAR; PG8_SCHED;
            PG8_STAGE(PG8_SB(0, 1), b2 + hstep, voffB);
            PG8_WAIT_V(6); PG8_BAR; PG8_MMA(1, 1, At, B1); PG8_BAR;
            PG8_LDB(B0, 1, 0); PG8_SCHED; PG8_LDA(At, 1, 0); PG8_STAGE(PG8_SA(0, 1), a2 + hstepA, voffA);
            PG8_WAIT_L(8); PG8_BAR; PG8_WAIT_L(0); PG8_MMA(0, 0, At, B0); PG8_BAR; PG8_SCHED;
            PG8_LDB(B1, 1, 1); PG8_STAGE(PG8_SB(1, 0), b3, voffB);
            PG8_BAR; PG8_WAIT_L(0); PG8_MMA(0, 1, At, B1); PG8_BAR;
            PG8_LDA(At, 1, 1); PG8_STAGE(PG8_SA(1, 0), a3, voffA);
            PG8_BAR; PG8_WAIT_L(0); PG8_MMA(1, 0, At, B0); PG8_BAR; PG8_SCHED;
            PG8_STAGE(PG8_SB(1, 1), b3 + hstep, voffB);
            PG8_WAIT_V(6); PG8_BAR; PG8_MMA(1, 1, At, B1); PG8_BAR;
            }
        }
        if constexpr (ALIGN_EPI) { if (wr == 0) PG8_BAR; }
        if constexpr (!Epi::AFTER_DRAIN) { E(acc, cur, wr, wc, fr, fq); S.done(cur); }
        if (!has_next) break;
#pragma unroll
        for (int a = 0; a < 2; ++a)
#pragma unroll
            for (int b = 0; b < 2; ++b)
#pragma unroll
                for (int m = 0; m < 4; ++m)
#pragma unroll
                    for (int n = 0; n < 2; ++n) acc[a][b][m][n] = (f32x4){0.f, 0.f, 0.f, 0.f};
        cur = nxt; cA = nA; cB = nB; ++ui;
        if constexpr (ALIGN_EPI) { if (wr == 1) PG8_BAR; }
    }
    PG8_WAIT_V(0);
    if constexpr (!ALIGN_EPI) { if (wr == 0) PG8_BAR; }
    PG8_BAR;
    if constexpr (Epi::AFTER_DRAIN) { E.fused(acc, cur, wr, wc, fr, fq, lds, wid, lane); S.done(cur); }
#undef PG8_SA
#undef PG8_SB
#undef PG8_STAGE
#undef PG8_LDA
#undef PG8_LDB
#undef PG8_MMA
#undef PG8_WAIT_V
#undef PG8_WAIT_L
#undef PG8_BAR
#undef PG8_SCHED
}
}

typedef unsigned short u16;
typedef short bf16x8 __attribute__((ext_vector_type(8)));
typedef short s16x4 __attribute__((ext_vector_type(4)));
typedef float f32x4 __attribute__((ext_vector_type(4)));
typedef float f32x16 __attribute__((ext_vector_type(16)));
typedef unsigned u32x4 __attribute__((ext_vector_type(4)));
typedef unsigned u32x2 __attribute__((ext_vector_type(2)));
typedef __bf16 bf16x2_t __attribute__((ext_vector_type(2)));
typedef float f32x2_t __attribute__((ext_vector_type(2)));
#define DI __device__ __forceinline__

constexpr int NB = 32, SEQ = 2048, NCTX = 256, TT = 2304, DM = 1024, DEPTH = 4;
constexpr int NGRP = 4, BGR = 8, MG = BGR * TT;
constexpr int DIN = 10992, NP = 11008;
constexpr float EPS = 1e-6f;
constexpr int C_CQ = 0, C_KR = 384, C_AF = 448, C_AB = 464, C_IF = 480, C_CKV = 512, C_MZ = 768, C_GQ = 1280, C_GK = 1536, C_GV = 1792, C_GZ = 2304,
              C_MX = 2816, C_MV = 3328, C_MO = 3840, C_MLZ = 4352, C_DQ = 4864, C_DK = 5376, C_DV = 5888, C_DZ = 6400, C_MG = 6912;
constexpr int NSTEP = 1 + DEPTH * NGRP * 7;
constexpr int LDS_BYTES = 147456;
constexpr int LDS_BARW = LDS_BYTES - 16;
constexpr int LDS_MISC = LDS_BYTES - 64;

constexpr size_t al256(size_t x) { return (x + 255) / 256 * 256; }
constexpr size_t WS_CTL = 0;
constexpr size_t CTL_BYTES = 65536;
constexpr size_t WS_MOD  = WS_CTL + CTL_BYTES;
constexpr size_t WS_ROPE = WS_MOD + al256((size_t)DEPTH * 33 * 3072 * 4);
constexpr size_t WS_LAM  = WS_ROPE + 8192;
constexpr size_t WS_WIN  = WS_LAM + 256;
constexpr size_t WS_BR   = WS_WIN + (size_t)DEPTH * NP * 1024 * 2;
constexpr size_t WS_WO   = WS_BR + (size_t)DEPTH * 4 * 1024 * 512 * 2;
constexpr size_t WS_WUQ  = WS_WO + (size_t)DEPTH * 1024 * 1024 * 2;
constexpr size_t WS_WUKV = WS_WUQ + (size_t)DEPTH * 768 * 384 * 2;
constexpr size_t WS_WQK  = WS_WUKV + (size_t)DEPTH * 1024 * 256 * 2;
constexpr size_t WS_CTX  = WS_WQK + (size_t)DEPTH * 512 * 512 * 2;
constexpr size_t WS_H    = WS_CTX + (size_t)NB * NCTX * DM * 4;
constexpr size_t WS_P    = WS_H + (size_t)MG * 1024 * 2;
constexpr size_t WS_Q    = WS_P + (size_t)MG * NP * 2;
constexpr size_t WS_KV   = WS_Q + (size_t)MG * 768 * 2;
constexpr size_t WS_XC   = WS_KV + (size_t)MG * 1024 * 2;
constexpr size_t WS_QKML = WS_XC + (size_t)MG * 512 * 2;
constexpr size_t WS_BG   = WS_QKML + (size_t)MG * 512 * 2;
constexpr size_t WS_SCAL = WS_BG + (size_t)2 * MG * 256 * 4;
constexpr size_t WS_Y    = WS_SCAL + (size_t)2 * MG * 16 * 4;
constexpr size_t WS_OSC  = WS_Y + (size_t)4 * MG * 512 * 2;
constexpr size_t WS_MF   = WS_OSC;
constexpr size_t WS_MB   = WS_OSC + (size_t)4 * MG * 512 * 2;
constexpr size_t WS_END  = WS_MB + (size_t)MG * 1024 * 2;
static_assert((size_t)MG * 1024 * 4 == (size_t)4 * MG * 512 * 2, "merge accumulator aliases the scan scratch");
static_assert(WS_END <= (size_t)1000 * 1024 * 1024, "workspace map must stay below 1000 MiB");
constexpr int CW_QUEUE = 4096;

struct Params { const float* in[29]; float* out; unsigned char* ws; int s_lo, s_hi; };

struct Ctx {
    const float* const* in; float* out; unsigned char* ws; unsigned* ctl;
    int wave, G;
    LAS unsigned char* lds;
};

DI float bf2f(u16 v) { return __uint_as_float((unsigned)v << 16); }
DI float bflo(unsigned w) { return __uint_as_float(w << 16); }
DI float bfhi(unsigned w) { return __uint_as_float(w & 0xffff0000u); }
DI unsigned pk2(float lo, float hi) { f32x2_t v = {lo, hi}; bf16x2_t b = __builtin_convertvector(v, bf16x2_t); return __builtin_bit_cast(unsigned, b); }
DI u16 f2bf(float f) { return (u16)(pk2(f, 0.f) & 0xffffu); }
DI void unpack8(u32x4 w, float* f) { f[0] = bflo(w.x); f[1] = bfhi(w.x); f[2] = bflo(w.y); f[3] = bfhi(w.y); f[4] = bflo(w.z); f[5] = bfhi(w.z); f[6] = bflo(w.w); f[7] = bfhi(w.w); }
DI u32x4 pack8(const float* f) { u32x4 w; w.x = pk2(f[0], f[1]); w.y = pk2(f[2], f[3]); w.z = pk2(f[4], f[5]); w.w = pk2(f[6], f[7]); return w; }
DI float sigmoid_f(float x) { return __builtin_amdgcn_rcpf(1.f + __expf(-x)); }
DI float silu_f(float x) { return x * sigmoid_f(x); }
DI float logsig_f(float x) { return fminf(x, 0.f) - __logf(1.f + __expf(-fabsf(x))); }
DI int crow(int r, int hi) { return (r & 3) + 8 * (r >> 2) + 4 * hi; }
DI int swz64(int row, int colB) { return row * 128 + (colB ^ (((row >> 1) & 7) << 4)); }
DI int kswz(int row, int colB) { return row * 256 + (colB ^ ((row & 7) << 4)); }
DI int v_st(int k, int c) { const int kk = (k & ~0xC) | ((k & 4) << 1) | ((k & 8) >> 1); return ((kk >> 3) * 4 + (c >> 5)) * 512 + ((kk & 7) * 32 + (c & 31)) * 2; }
DI int v_rd_base(int lane) { return ((lane & 3) << 3) | (((lane >> 2) & 3) << 6) | (((lane >> 4) & 1) << 5) | (((lane >> 5) & 1) << 8); }
template <int OFF> DI s16x4 tr_read(int vb) { s16x4 r; asm volatile("ds_read_b64_tr_b16 %0, %1 offset:%2" : "=&v"(r) : "v"(vb), "i"(OFF) : "memory"); return r; }
#define SBAR() __builtin_amdgcn_sched_barrier(0)
#define MFMA32(a, b, c) __builtin_amdgcn_mfma_f32_32x32x16_bf16((a), (b), (c), 0, 0, 0)
DI bf16x8 ldsv(const LAS unsigned char* p) { return *(const LAS bf16x8*)p; }
DI float wave_sum(float v) {
#pragma unroll
    for (int o = 32; o >= 1; o >>= 1) v += __shfl_xor(v, o);
    return v;
}
DI void v_frags(int vb, bf16x8 (&vf)[4]) {
    const s16x4 l0 = tr_read<0>(vb), h0 = tr_read<2048>(vb), l1 = tr_read<4096>(vb), h1 = tr_read<4096 + 2048>(vb);
    const s16x4 l2 = tr_read<8192>(vb), h2 = tr_read<8192 + 2048>(vb), l3 = tr_read<12288>(vb), h3 = tr_read<12288 + 2048>(vb);
    asm volatile("s_waitcnt lgkmcnt(0)" ::: "memory"); SBAR();
#define PKV(L, H) (bf16x8){L[0], L[1], L[2], L[3], H[0], H[1], H[2], H[3]}
    vf[0] = PKV(l0, h0); vf[1] = PKV(l1, h1); vf[2] = PKV(l2, h2); vf[3] = PKV(l3, h3);
#undef PKV
}
DI void p_to_afrag(const f32x16& p0, const f32x16& p1, bf16x8 (&pa)[4]) {
#define PK4(P, BASE, OUT) do { unsigned a0 = pk2(P[BASE + 0], P[BASE + 1]), a1 = pk2(P[BASE + 2], P[BASE + 3]);   \
    unsigned b0 = pk2(P[BASE + 4], P[BASE + 5]), b1 = pk2(P[BASE + 6], P[BASE + 7]);                              \
    auto r0 = __builtin_amdgcn_permlane32_swap(a0, b0, false, false); auto r1 = __builtin_amdgcn_permlane32_swap(a1, b1, false, false); \
    u32x4 w = {r0[0], r1[0], r0[1], r1[1]}; OUT = __builtin_bit_cast(bf16x8, w); } while (0)
    PK4(p0, 0, pa[0]); PK4(p0, 8, pa[1]); PK4(p1, 0, pa[2]); PK4(p1, 8, pa[3]);
#undef PK4
}
DI void p_half_to_afrag(const f32x16& p, bf16x8& pa0, bf16x8& pa1) {
#define PK4(P, BASE, OUT) do { unsigned a0 = pk2(P[BASE + 0], P[BASE + 1]), a1 = pk2(P[BASE + 2], P[BASE + 3]);   \
    unsigned b0 = pk2(P[BASE + 4], P[BASE + 5]), b1 = pk2(P[BASE + 6], P[BASE + 7]);                              \
    auto r0 = __builtin_amdgcn_permlane32_swap(a0, b0, false, false); auto r1 = __builtin_amdgcn_permlane32_swap(a1, b1, false, false); \
    u32x4 w = {r0[0], r1[0], r0[1], r1[1]}; OUT = __builtin_bit_cast(bf16x8, w); } while (0)
    PK4(p, 0, pa0); PK4(p, 8, pa1);
#undef PK4
}
DI float half_swap_sum(float v) { auto rr = __builtin_amdgcn_permlane32_swap(__float_as_uint(v), __float_as_uint(v), false, false); return __uint_as_float(rr[0]) + __uint_as_float(rr[1]); }
DI float half_swap_max(float v) { auto rr = __builtin_amdgcn_permlane32_swap(__float_as_uint(v), __float_as_uint(v), false, false); return fmaxf(__uint_as_float(rr[0]), __uint_as_float(rr[1])); }
using pg8::Unit;
typedef f32x4 AccT[2][2][4][2];

DI int p_act(int pn) {
    if (pn >= 27) return 2;
    if (pn == 15 || pn == 16) return 2;
    if (pn == 3 || pn == 4 || pn == 9 || pn == 10 || pn == 17 || pn == 18 || pn == 25 || pn == 26) return 1;
    return 0;
}
struct EpiBf {
    static constexpr bool PERM = true, AFTER_DRAIN = false;
    u16* O; int ldc; int actsel;
    DI void operator()(const AccT& acc, const Unit& u, int wr, int wc, int fr, int fq) const {
        const int row0 = u.pm * 256 + wr * 64 + fr, col0 = u.pn * 256 + wc * 32 + 8 * fq;
        const int act = actsel ? p_act(u.pn) : 0;
#pragma unroll
        for (int ai = 0; ai < 2; ++ai)
#pragma unroll
            for (int m = 0; m < 4; ++m) { u16* rowp = O + (size_t)(row0 + ai * 128 + m * 16) * ldc + col0;
#pragma unroll
                for (int bj = 0; bj < 2; ++bj) { f32x4 v0 = acc[ai][bj][m][0], v1 = acc[ai][bj][m][1];
                    float f[8] = {v0[0], v0[1], v0[2], v0[3], v1[0], v1[1], v1[2], v1[3]};
                    if (act == 1) {
#pragma unroll
                        for (int e = 0; e < 8; ++e) f[e] = silu_f(f[e]);
                    } else if (act == 2) {
#pragma unroll
                        for (int e = 0; e < 8; ++e) f[e] = sigmoid_f(f[e]);
                    }
                    *(u32x4*)(rowp + bj * 128) = pack8(f); } }
    }
};
struct EpiMerge {
    static constexpr bool PERM = true, AFTER_DRAIN = false;
    float* MF; u16* MB; const u16* gate; int mode;
    DI void operator()(const AccT& acc, const Unit& u, int wr, int wc, int fr, int fq) const {
        const int row0 = u.pm * 256 + wr * 64 + fr, col0 = u.pn * 256 + wc * 32 + 8 * fq;
#pragma unroll
        for (int ai = 0; ai < 2; ++ai)
#pragma unroll
            for (int m = 0; m < 4; ++m) { const size_t r = (size_t)(row0 + ai * 128 + m * 16);
#pragma unroll
                for (int bj = 0; bj < 2; ++bj) { const int c = col0 + bj * 128;
                    f32x4 v0 = acc[ai][bj][m][0], v1 = acc[ai][bj][m][1];
                    float g[8]; unpack8(*(const u32x4*)(gate + r * NP + c), g);
                    float f[8] = {v0[0] * g[0], v0[1] * g[1], v0[2] * g[2], v0[3] * g[3], v1[0] * g[4], v1[1] * g[5], v1[2] * g[6], v1[3] * g[7]};
                    float* mp = MF + r * 1024 + c;
                    if (mode != 0) { const f32x4 o0 = *(const f32x4*)mp, o1 = *(const f32x4*)(mp + 4);
                        f[0] += o0[0]; f[1] += o0[1]; f[2] += o0[2]; f[3] += o0[3]; f[4] += o1[0]; f[5] += o1[1]; f[6] += o1[2]; f[7] += o1[3]; }
                    if (mode == 2) *(u32x4*)(MB + r * 1024 + c) = pack8(f);
                    else { *(f32x4*)mp = (f32x4){f[0], f[1], f[2], f[3]}; *(f32x4*)(mp + 4) = (f32x4){f[4], f[5], f[6], f[7]}; } } }
    }
};
struct EpiOut {
    static constexpr bool PERM = false, AFTER_DRAIN = false;
    const float* xsrc; float* xdst; const float* csrc; float* cdst; const float* mod; int grp; int last;
    DI void operator()(const AccT& acc, const Unit& u, int wr, int wc, int fr, int fq) const {
        const int bl = u.pm / 9, tb = u.pm % 9, b = grp * BGR + bl;
        if (tb == 0 && last) return;
        const float* src; float* dst; const float* gt;
        if (tb == 0) { src = csrc + (size_t)b * NCTX * DM; dst = cdst + (size_t)b * NCTX * DM; gt = mod + 32 * 3072 + 2048; }
        else { src = xsrc + ((size_t)b * SEQ + (size_t)(tb - 1) * 256) * DM; dst = xdst + ((size_t)b * SEQ + (size_t)(tb - 1) * 256) * DM; gt = mod + b * 3072 + 2048; }
        const int row0 = wr * 64 + fr, col0 = u.pn * 256 + wc * 32 + 4 * fq;
        f32x4 gv[2][2];
#pragma unroll
        for (int bj = 0; bj < 2; ++bj)
#pragma unroll
            for (int n = 0; n < 2; ++n) gv[bj][n] = *(const f32x4*)(gt + col0 + bj * 128 + n * 16);
#pragma unroll
        for (int ai = 0; ai < 2; ++ai)
#pragma unroll
            for (int m = 0; m < 4; ++m) { const size_t ro = (size_t)(row0 + ai * 128 + m * 16) * DM + col0;
#pragma unroll
                for (int bj = 0; bj < 2; ++bj)
#pragma unroll
                    for (int n = 0; n < 2; ++n) { const f32x4 xo = *(const f32x4*)(src + ro + bj * 128 + n * 16);
                        *(f32x4*)(dst + ro + bj * 128 + n * 16) = xo + gv[bj][n] * acc[ai][bj][m][n]; } }
    }
};

DI int pmap(int n, float& sc) {
    sc = 1.f;
    if (n < 384) return n;
    if (n < 448) return 640 + (n - 384);
    if (n < 464) return 2240 + (n - 448);
    if (n < 480) return 2256 + (n - 464);
    if (n < 496) return 4320 + (n - 480);
    if (n < 512) return -1;
    if (n < 768) return 384 + (n - 512);
    if (n < 1280) return 704 + (n - 768);
    if (n < 1536) { sc = 0.125f; return 1216 + (n - 1280); }
    if (n < 1792) return 1472 + (n - 1536);
    if (n < 2304) return 1728 + (n - 1792);
    if (n < 2816) return 2272 + (n - 2304);
    if (n < 3328) return 2784 + (n - 2816);
    if (n < 3840) return 3296 + (n - 3328);
    if (n < 4352) return 3808 + (n - 3840);
    if (n < 4864) return 4336 + (n - 4352);
    if (n < 5376) return 4848 + (n - 4864);
    if (n < 5888) return 5360 + (n - 5376);
    if (n < 6400) return 5872 + (n - 5888);
    if (n < 6912) return 6384 + (n - 6400);
    return 6896 + (n - 6912);
}
struct MapWin { DI int operator()(int n, float& sc) const { return pmap(n, sc); } };
struct MapId  { DI int operator()(int n, float& sc) const { sc = 1.f; return n; } };
struct MapQ   { DI int operator()(int n, float& sc) const { sc = 1.f; return n < 512 ? (n >> 7) * 192 + (n & 127) : ((n - 512) >> 6) * 192 + 128 + ((n - 512) & 63); } };
struct MapKV  { DI int operator()(int n, float& sc) const { sc = 1.f; return n < 512 ? (n >> 7) * 256 + (n & 127) : ((n - 512) >> 7) * 256 + 128 + ((n - 512) & 127); } };

template <class Map>
DI void xpose_tile(const float* __restrict__ src, int ldsrc, u16* __restrict__ dst, int K, int n0, int k0, const float* __restrict__ kscale, Map map, LAS float* tl) {
    const int tid = threadIdx.x;
    { const int kk = tid >> 3, ng = (tid & 7) * 8; float sc; const int sn = map(n0 + ng, sc);
      f32x4 a = {0.f, 0.f, 0.f, 0.f}, b = {0.f, 0.f, 0.f, 0.f};
      if (sn >= 0) { const float* p = src + (size_t)(k0 + kk) * ldsrc + sn; a = *(const f32x4*)p; b = *(const f32x4*)(p + 4); }
      const float ks = (kscale ? kscale[k0 + kk] : 1.f) * sc;
      tl[(ng + 0) * 65 + kk] = a[0] * ks; tl[(ng + 1) * 65 + kk] = a[1] * ks; tl[(ng + 2) * 65 + kk] = a[2] * ks; tl[(ng + 3) * 65 + kk] = a[3] * ks;
      tl[(ng + 4) * 65 + kk] = b[0] * ks; tl[(ng + 5) * 65 + kk] = b[1] * ks; tl[(ng + 6) * 65 + kk] = b[2] * ks; tl[(ng + 7) * 65 + kk] = b[3] * ks; }
    __syncthreads();
    { const int nn = tid >> 3, kg = (tid & 7) * 8; float f[8];
#pragma unroll
      for (int e = 0; e < 8; ++e) f[e] = tl[nn * 65 + kg + e];
      *(u32x4*)(dst + (size_t)(n0 + nn) * K + k0 + kg) = pack8(f); }
    __syncthreads();
}

DI void p0_prologue(const Ctx& F) {
    int tz = (int)threadIdx.x; asm volatile("" : "+v"(tz));
    const int tid = tz;
    LAS float* lf = (LAS float*)F.lds;
    constexpr int U_ADA = 96, U_WIN = DEPTH * (NP / 64) * 16, U_BR = DEPTH * 4 * 16 * 8, U_WO = DEPTH * 16 * 16, U_WUQ = DEPTH * 12 * 6, U_WUKV = DEPTH * 16 * 4, U_WQK = DEPTH * 64, U_MISC = 1;
    constexpr int O_WIN = U_ADA, O_BR = O_WIN + U_WIN, O_WO = O_BR + U_BR, O_WUQ = O_WO + U_WO, O_WUKV = O_WUQ + U_WUQ, O_WQK = O_WUKV + U_WUKV, O_MISC = O_WQK + U_WQK, U_ALL = O_MISC + U_MISC;
    for (int u = blockIdx.x; u < U_ALL; u += F.G) {
        if (u < U_ADA) {
            const int l = u / 24, col0 = (u % 24) * 128, col = tid & 127, kq = tid >> 7;
            const float* aw = F.in[4] + (size_t)l * 1024 * 3072;
            float acc[33];
#pragma unroll
            for (int r = 0; r < 33; ++r) acc[r] = 0.f;
            for (int kc = 0; kc < 1024; kc += 256) {
                __syncthreads();
                for (int idx = tid; idx < 33 * 256; idx += 512) { const int r = idx >> 8, k = idx & 255; const float cv = (r < 32) ? F.in[1][r * 1024 + kc + k] : F.in[3][kc + k]; lf[idx] = silu_f(cv); }
                __syncthreads();
                for (int k = kq * 64; k < kq * 64 + 64; ++k) { const float w = aw[(size_t)(kc + k) * 3072 + col0 + col];
#pragma unroll
                    for (int r = 0; r < 33; ++r) acc[r] += lf[r * 256 + k] * w; }
            }
            __syncthreads();
#pragma unroll
            for (int r = 0; r < 33; ++r) lf[(kq * 33 + r) * 128 + col] = acc[r];
            __syncthreads();
            float* mod = (float*)(F.ws + WS_MOD) + (size_t)l * 33 * 3072;
            for (int idx = tid; idx < 33 * 128; idx += 512) { const int r = idx >> 7, c = idx & 127;
                mod[r * 3072 + col0 + c] = lf[(0 * 33 + r) * 128 + c] + lf[(1 * 33 + r) * 128 + c] + lf[(2 * 33 + r) * 128 + c] + lf[(3 * 33 + r) * 128 + c] + F.in[5][l * 3072 + col0 + c]; }
            __syncthreads();
        } else if (u < O_BR) {
            const int v = u - O_WIN, l = v / ((NP / 64) * 16), t = v % ((NP / 64) * 16), nt = t / 16, kt = t % 16;
            xpose_tile(F.in[7] + (size_t)l * 1024 * DIN, DIN, (u16*)(F.ws + WS_WIN) + (size_t)l * NP * 1024, 1024, nt * 64, kt * 64, nullptr, MapWin(), lf);
        } else if (u < O_WO) {
            const int v = u - O_BR, li = v / 128, t = v % 128, nt = t / 8, kt = t % 8;
            xpose_tile(F.in[27] + (size_t)li * 512 * 1024, 1024, (u16*)(F.ws + WS_BR) + (size_t)li * 1024 * 512, 512, nt * 64, kt * 64, nullptr, MapId(), lf);
        } else if (u < O_WUQ) {
            const int v = u - O_WO, l = v / 256, t = v % 256, nt = t / 16, kt = t % 16;
            xpose_tile(F.in[28] + (size_t)l * 1024 * 1024, 1024, (u16*)(F.ws + WS_WO) + (size_t)l * 1024 * 1024, 1024, nt * 64, kt * 64, nullptr, MapId(), lf);
        } else if (u < O_WUKV) {
            const int v = u - O_WUQ, l = v / 72, t = v % 72, nt = t / 6, kt = t % 6;
            xpose_tile(F.in[10] + (size_t)l * 384 * 768, 768, (u16*)(F.ws + WS_WUQ) + (size_t)l * 768 * 384, 384, nt * 64, kt * 64, F.in[8] + l * 384, MapQ(), lf);
        } else if (u < O_WQK) {
            const int v = u - O_WUKV, l = v / 64, t = v % 64, nt = t / 4, kt = t % 4;
            xpose_tile(F.in[11] + (size_t)l * 256 * 1024, 1024, (u16*)(F.ws + WS_WUKV) + (size_t)l * 1024 * 256, 256, nt * 64, kt * 64, F.in[9] + l * 256, MapKV(), lf);
        } else if (u < O_MISC) {
            const int v = u - O_WQK, l = v / 64, t = v % 64;
            u16* dst = (u16*)(F.ws + WS_WQK) + (size_t)l * 512 * 512;
            for (int e = tid; e < 4096; e += 512) { const int idx = t * 4096 + e, n = idx >> 9, k = idx & 511;
                const int isk = n >> 8, hn = (n & 255) >> 6, dd = n & 63, hk = k >> 7, c = k & 127;
                float val = 0.f;
                if (hn == hk) { const float* w = (isk ? F.in[20] : F.in[19]) + (((size_t)l * 4 + hn) * 128 + c) * 64 + dd; val = isk ? *w * 0.125f : *w; }
                dst[idx] = f2bf(val); }
        } else {
            float* rope = (float*)(F.ws + WS_ROPE);
            for (int e = tid; e < 1024; e += 512) { const int pos = e >> 4, i = e & 15;
                const float inv = powf(10000.f, -(float)i / 16.f); const float ang = (float)pos * inv;
                rope[e] = cosf(ang); rope[1024 + e] = sinf(ang); }
            if (tid < 4) { const float* lp = F.in[25] + tid * 256; float s0 = 0.f, s1 = 0.f;
                for (int d = 0; d < 64; ++d) { s0 += lp[d] * lp[64 + d]; s1 += lp[128 + d] * lp[192 + d]; }
                const float lam_init = 0.8f - 0.6f * expf(-0.3f * (float)tid);
                ((float*)(F.ws + WS_LAM))[tid] = expf(s0) - expf(s1) + lam_init; }
        }
    }
}

DI void p1_norm(const Ctx& F, int l, int g) {
    const float* mod = (const float*)(F.ws + WS_MOD) + (size_t)l * 33 * 3072;
    const float* ng = F.in[6] + l * 1024;
    const float* xs = (l == 0) ? F.in[0] : F.out;
    const float* cs = (l == 0) ? F.in[2] : (const float*)(F.ws + WS_CTX);
    u16* H = (u16*)(F.ws + WS_H);
    int lz = ((int)threadIdx.x & 63); asm volatile("" : "+v"(lz));
    const int lane = lz;
    int row0 = blockIdx.x * 8 + F.wave; asm volatile("" : "+s"(row0));
    for (int row = row0; row < MG; row += F.G * 8) {
        const int bl = row / TT, t = row % TT, b = g * BGR + bl;
        const float* src; const float* md;
        if (t < NCTX) { src = cs + ((size_t)b * NCTX + t) * DM; md = mod + 32 * 3072; } else { src = xs + ((size_t)b * SEQ + (t - NCTX)) * DM; md = mod + b * 3072; }
        f32x4 v[4]; float ss = 0.f;
#pragma unroll
        for (int i = 0; i < 4; ++i) { v[i] = *(const f32x4*)(src + i * 256 + lane * 4); ss += v[i][0] * v[i][0] + v[i][1] * v[i][1] + v[i][2] * v[i][2] + v[i][3] * v[i][3]; }
        ss = wave_sum(ss);
        const float rstd = rsqrtf(ss * (1.f / 1024.f) + EPS);
#pragma unroll
        for (int i = 0; i < 4; ++i) { const int c = i * 256 + lane * 4;
            const f32x4 gg = *(const f32x4*)(ng + c), sh = *(const f32x4*)(md + c), sc = *(const f32x4*)(md + 1024 + c);
            const f32x4 y = v[i] * rstd * gg * (sc + 1.f) + sh;
            u32x2 w; w.x = pk2(y[0], y[1]); w.y = pk2(y[2], y[3]);
            *(u32x2*)(H + (size_t)row * 1024 + c) = w; }
    }
}
DI void rope8(float* x, int j8, int t, const float* __restrict__ rope) {
    float p[8];
#pragma unroll
    for (int e = 0; e < 8; ++e) p[e] = __shfl_xor(x[e], 2);
    if (t < NCTX) return;
    const int s = t - NCTX, pos = (j8 & 4) ? (s & 63) : (s >> 6), i0 = 8 * (j8 & 1);
    const float sg = (j8 & 2) ? 1.f : -1.f;
#pragma unroll
    for (int e = 0; e < 8; ++e) { const float c = rope[pos * 16 + i0 + e], sn = rope[1024 + pos * 16 + i0 + e]; x[e] = x[e] * c + sg * p[e] * sn; }
}
DI float group_sum(float v, int n) {
    v += __shfl_xor(v, 1); v += __shfl_xor(v, 2); v += __shfl_xor(v, 4); if (n == 16) v += __shfl_xor(v, 8); return v;
}

DI void p3_rows(const Ctx& F, int l) {
    u16* P = (u16*)(F.ws + WS_P); u16* XC = (u16*)(F.ws + WS_XC);
    const float* rope = (const float*)(F.ws + WS_ROPE);
    const float* cw = F.in[17] + (size_t)l * 3 * 512; const float* cb = F.in[18] + l * 512;
    const float* qkg = F.in[24] + l * 128; const float* kg = F.in[13] + l * 192 + 128;
    int lz = ((int)threadIdx.x & 63); asm volatile("" : "+v"(lz));
    const int lane = lz, c8 = lane * 8;
    int row0 = blockIdx.x * 8 + F.wave; asm volatile("" : "+s"(row0));
    for (int row = row0; row < MG; row += F.G * 8) {
        const int t = row % TT; u16* pr = P + (size_t)row * NP;
        { const bool hasl = (t != 0 && t != NCTX), hasr = (t != NCTX - 1 && t != TT - 1);
          float x0[8], xm[8], xp[8], o[8];
          unpack8(*(const u32x4*)(pr + C_MX + c8), x0);
          if (hasl) unpack8(*(const u32x4*)(pr - NP + C_MX + c8), xm);
          if (hasr) unpack8(*(const u32x4*)(pr + NP + C_MX + c8), xp);
#pragma unroll
          for (int e = 0; e < 8; ++e) { float a = cb[c8 + e] + cw[512 + c8 + e] * x0[e];
              if (hasl) a += cw[c8 + e] * xm[e];
              if (hasr) a += cw[1024 + c8 + e] * xp[e];
              o[e] = silu_f(a); }
          *(u32x4*)(XC + (size_t)row * 512 + c8) = pack8(o); }
#pragma unroll
        for (int qk = 0; qk < 2; ++qk) { u16* p = pr + (qk ? C_DK : C_DQ) + c8; float x[8]; unpack8(*(const u32x4*)p, x);
            float ss = 0.f;
#pragma unroll
            for (int e = 0; e < 8; ++e) ss += x[e] * x[e];
            ss = group_sum(ss, 8); const float rstd = rsqrtf(ss * (1.f / 64.f) + EPS); const int j8 = lane & 7;
#pragma unroll
            for (int e = 0; e < 8; ++e) x[e] = x[e] * rstd * qkg[qk * 64 + j8 * 8 + e];
            rope8(x, j8, t, rope);
            *(u32x4*)p = pack8(x); }
        { const int j8 = lane & 7; u16* p = pr + C_KR + j8 * 8; float x[8]; unpack8(*(const u32x4*)p, x);
          float ss = 0.f;
#pragma unroll
          for (int e = 0; e < 8; ++e) ss += x[e] * x[e];
          ss = group_sum(ss, 8); const float rstd = rsqrtf(ss * (1.f / 64.f) + EPS);
#pragma unroll
          for (int e = 0; e < 8; ++e) x[e] = x[e] * rstd * kg[j8 * 8 + e];
          rope8(x, j8, t, rope);
          if (lane < 8) *(u32x4*)p = pack8(x); }
    }
}

DI void p3_gates(const Ctx& F, int l) {
    const u16* P = (const u16*)(F.ws + WS_P);
    float* BGp = (float*)(F.ws + WS_BG); float* SC = (float*)(F.ws + WS_SCAL);
    LAS float* af = (LAS float*)F.lds;
    LAS float* gi = af + 64 * 32;
    int tz = (int)threadIdx.x; asm volatile("" : "+v"(tz));
    const int tid = tz;
    const int dir = tid >> 8, col = tid & 255;
    float aw[16];
#pragma unroll
    for (int r = 0; r < 16; ++r) aw[r] = F.in[14][(((size_t)l * 2 + dir) * 16 + r) * 256 + col];
    const float ab = F.in[15][((size_t)l * 2 + dir) * 256 + col];
    for (int ch = blockIdx.x; ch < MG / 64; ch += F.G) {
        const size_t r0 = (size_t)ch * 64;
        __syncthreads();
        if (tid < 256) { const int r = tid >> 2, q = tid & 3; float f[8]; unpack8(*(const u32x4*)(P + (r0 + r) * NP + C_AF + q * 8), f);
#pragma unroll
            for (int e = 0; e < 8; ++e) af[r * 32 + q * 8 + e] = f[e]; }
        else if (tid < 384) { const int r = (tid - 256) >> 1, q = tid & 1; float f[8]; unpack8(*(const u32x4*)(P + (r0 + r) * NP + C_IF + q * 8), f);
#pragma unroll
            for (int e = 0; e < 8; ++e) gi[r * 16 + q * 8 + e] = f[e]; }
        __syncthreads();
        { float run = 0.f; float* bo = BGp + ((size_t)dir * MG + r0) * 256 + col;
          for (int i = 0; i < 64; ++i) { const int tk = dir ? 63 - i : i; float x = ab;
#pragma unroll
              for (int r = 0; r < 16; ++r) x += af[tk * 32 + dir * 16 + r] * aw[r];
              run += logsig_f(x) * (1.f / 16.f); bo[(size_t)tk * 256] = run; } }
        if (tid < 8) { const int d2 = tid >> 2, h = tid & 3, g0 = d2 * 2;
            const float bi = F.in[21][l * 16 + g0 * 4 + h], bf = F.in[21][l * 16 + (g0 + 1) * 4 + h];
            float b = 0.f, pm = -3.0e38f;
            for (int i = 0; i < 64; ++i) { const int tk = d2 ? 63 - i : i;
                const float li = gi[tk * 16 + g0 * 4 + h] + bi, lfv = logsig_f(gi[tk * 16 + (g0 + 1) * 4 + h] + bf);
                b += lfv; const float a = li - b; pm = fmaxf(pm, a);
                *(f32x4*)(SC + (((size_t)d2 * MG + r0 + tk) * 4 + h) * 4) = (f32x4){b, a, pm, 0.f}; } }
    }
}

DI void p3b_rows(const Ctx& F, int l) {
    const u16* P = (const u16*)(F.ws + WS_P); u16* Q = (u16*)(F.ws + WS_Q); u16* KV = (u16*)(F.ws + WS_KV);
    const float* rope = (const float*)(F.ws + WS_ROPE);
    const float* qg = F.in[12] + l * 192; const float* kg = F.in[13] + l * 192;
    int lz = ((int)threadIdx.x & 63); asm volatile("" : "+v"(lz));
    const int lane = lz, c8 = lane * 8;
    int row0 = blockIdx.x * 8 + F.wave; asm volatile("" : "+s"(row0));
    for (int row = row0; row < MG; row += F.G * 8) {
        const int t = row % TT; const u16* pr = P + (size_t)row * NP;
        float ss = 0.f;
        if (lane < 48) { float x[8]; unpack8(*(const u32x4*)(pr + C_CQ + c8), x);
#pragma unroll
            for (int e = 0; e < 8; ++e) ss += x[e] * x[e]; }
        const float rq = rsqrtf(wave_sum(ss) * (1.f / 384.f) + EPS);
        ss = 0.f;
        if (lane < 32) { float x[8]; unpack8(*(const u32x4*)(pr + C_CKV + c8), x);
#pragma unroll
            for (int e = 0; e < 8; ++e) ss += x[e] * x[e]; }
        const float rk = rsqrtf(wave_sum(ss) * (1.f / 256.f) + EPS);
        { u16* p = Q + (size_t)row * 768 + c8; float x[8]; unpack8(*(const u32x4*)p, x); float s2 = 0.f;
#pragma unroll
          for (int e = 0; e < 8; ++e) { x[e] *= rq; s2 += x[e] * x[e]; }
          s2 = group_sum(s2, 16); const float rs = rsqrtf(s2 * (1.f / 128.f) + EPS); const int d0 = (lane & 15) * 8;
#pragma unroll
          for (int e = 0; e < 8; ++e) x[e] = x[e] * rs * qg[d0 + e];
          *(u32x4*)p = pack8(x); }
        { const int l32 = lane & 31; u16* p = Q + (size_t)row * 768 + 512 + l32 * 8; float x[8]; unpack8(*(const u32x4*)p, x); float s2 = 0.f;
#pragma unroll
          for (int e = 0; e < 8; ++e) { x[e] *= rq; s2 += x[e] * x[e]; }
          s2 = group_sum(s2, 8); const float rs = rsqrtf(s2 * (1.f / 64.f) + EPS); const int j8 = lane & 7;
#pragma unroll
          for (int e = 0; e < 8; ++e) x[e] = x[e] * rs * qg[128 + j8 * 8 + e];
          rope8(x, j8, t, rope);
          if (lane < 32) *(u32x4*)p = pack8(x); }
        { u16* p = KV + (size_t)row * 1024 + c8; float x[8]; unpack8(*(const u32x4*)p, x); float s2 = 0.f;
#pragma unroll
          for (int e = 0; e < 8; ++e) { x[e] *= rk; s2 += x[e] * x[e]; }
          s2 = group_sum(s2, 16); const float rs = rsqrtf(s2 * (1.f / 128.f) + EPS); const int d0 = (lane & 15) * 8;
#pragma unroll
          for (int e = 0; e < 8; ++e) x[e] = x[e] * rs * kg[d0 + e];
          *(u32x4*)p = pack8(x); }
        { u16* p = KV + (size_t)row * 1024 + 512 + c8; float x[8]; unpack8(*(const u32x4*)p, x);
#pragma unroll
          for (int e = 0; e < 8; ++e) x[e] *= rk;
          *(u32x4*)p = pack8(x); }
    }
}
constexpr int AT_KN = 16384, AT_KR = 8192, AT_V = 16384;
constexpr int AT_BUF = AT_V + AT_KN + AT_KR;
constexpr int AT_WS = 2 * AT_BUF;
template <int MODE>
DI void attn_unit(const Ctx& F, int l, int bl, int h, int q0, int nkeys) {
    int tz = (int)threadIdx.x; asm volatile("" : "+v"(tz));
    const int tid = tz, wid = F.wave, lane = tz & 63;
    LAS unsigned char* lds = F.lds;
    const u16* P = (const u16*)(F.ws + WS_P); const u16* Qb = (const u16*)(F.ws + WS_Q); const u16* KVb = (const u16*)(F.ws + WS_KV);
    const size_t rb = (size_t)bl * TT;
    constexpr int NDQ = MODE == 0 ? 12 : 4;
    const float SC = MODE == 0 ? 0.07216878364870322f : 0.125f;
    const float C = SC * 1.4426950408889634f;
    LAS float* wsf = (LAS float*)(lds + AT_WS) + wid * 64;
    const int r32 = lane & 31, hi = lane >> 5;
    const int qrow = q0 + (MODE == 0 ? wid * 32 : (wid & 3) * 32) + r32;
    bf16x8 qr[NDQ];
    if constexpr (MODE == 0) { const u16* qp = Qb + (rb + qrow) * 768;
#pragma unroll
        for (int d0 = 0; d0 < 8; ++d0) qr[d0] = *(const bf16x8*)(qp + h * 128 + d0 * 16 + hi * 8);
#pragma unroll
        for (int d0 = 0; d0 < 4; ++d0) qr[8 + d0] = *(const bf16x8*)(qp + 512 + h * 64 + d0 * 16 + hi * 8);
    } else { const u16* qp = P + (rb + qrow) * NP + C_DQ + h * 128 + (wid >> 2) * 64;
#pragma unroll
        for (int d0 = 0; d0 < 4; ++d0) qr[d0] = *(const bf16x8*)(qp + d0 * 16 + hi * 8); }
    const int sr = tid >> 4, sc = (tid & 15) * 8, vst0 = v_st(sr, sc), vst1 = v_st(32 + sr, sc);
    const int kr_r = tid >> 3, kr_c = (tid & 7) * 8;
    const u16* kbase; const u16* vbase; size_t kld;
    if (MODE == 0) { kbase = KVb + rb * 1024 + h * 128; vbase = KVb + rb * 1024 + 512 + h * 128; kld = 1024; }
    else { kbase = P + rb * NP + C_DK + h * 128; vbase = P + rb * NP + C_DV + h * 128; kld = NP; }
    const u16* krbase = P + rb * NP + C_KR;
    u32x4 sv0, sv1, sk0, sk1, skr;
#define SLOAD(k0) do { sv0 = *(const u32x4*)(vbase + (size_t)((k0) + sr) * kld + sc); sv1 = *(const u32x4*)(vbase + (size_t)((k0) + 32 + sr) * kld + sc); \
        sk0 = *(const u32x4*)(kbase + (size_t)((k0) + sr) * kld + sc); sk1 = *(const u32x4*)(kbase + (size_t)((k0) + 32 + sr) * kld + sc); \
        if (MODE == 0) skr = *(const u32x4*)(krbase + (size_t)((k0) + kr_r) * NP + kr_c); } while (0)
#define SWRITE(b) do { LAS unsigned char* bb = lds + (b) * AT_BUF; *(LAS u32x4*)(bb + vst0) = sv0; *(LAS u32x4*)(bb + vst1) = sv1; \
        *(LAS u32x4*)(bb + AT_V + kswz(sr, sc * 2)) = sk0; *(LAS u32x4*)(bb + AT_V + kswz(32 + sr, sc * 2)) = sk1; \
        if (MODE == 0) *(LAS u32x4*)(bb + AT_V + AT_KN + swz64(kr_r, kr_c * 2)) = skr; } while (0)
    float m_reg = -1e30f, l_reg = 0.f; f32x16 o[4];
#pragma unroll
    for (int d = 0; d < 4; ++d)
#pragma unroll
        for (int r = 0; r < 16; ++r) o[d][r] = 0.f;
    const int NT = nkeys / 64;
    const int vrb = (int)(uintptr_t)lds + v_rd_base(lane);
    const int kcol0 = (MODE == 1) ? (wid >> 2) * 128 : 0;
    SLOAD(0); SWRITE(0); if (NT > 1) SLOAD(64); __syncthreads();
    for (int j = 0; j < NT; ++j) {
        const int cur = j & 1;
        f32x16 p0, p1;
#pragma unroll
        for (int r = 0; r < 16; ++r) { p0[r] = 0.f; p1[r] = 0.f; }
        { const LAS unsigned char* kb = lds + cur * AT_BUF + AT_V;
#pragma unroll
          for (int d0 = 0; d0 < (MODE == 0 ? 8 : 4); ++d0) { const int cb = kcol0 + (d0 * 16 + hi * 8) * 2;
              const bf16x8 b0 = ldsv(kb + kswz(r32, cb)), b1 = ldsv(kb + kswz(32 + r32, cb));
              p0 = MFMA32(b0, qr[d0], p0); p1 = MFMA32(b1, qr[d0], p1); }
          if constexpr (MODE == 0) {
#pragma unroll
              for (int d0 = 0; d0 < 4; ++d0) { const int cb = (d0 * 16 + hi * 8) * 2;
                  const bf16x8 b0 = ldsv(kb + AT_KN + swz64(r32, cb)), b1 = ldsv(kb + AT_KN + swz64(32 + r32, cb));
                  p0 = MFMA32(b0, qr[8 + d0], p0); p1 = MFMA32(b1, qr[8 + d0], p1); } } }
        if (j + 1 < NT) SWRITE(cur ^ 1);
        SBAR();
        float pmax = p0[0];
#pragma unroll
        for (int r = 1; r < 16; ++r) pmax = fmaxf(pmax, p0[r]);
#pragma unroll
        for (int r = 0; r < 16; ++r) pmax = fmaxf(pmax, p1[r]);
        pmax = half_swap_max(pmax);
        const float mn = fmaxf(m_reg, pmax), alpha = __builtin_amdgcn_exp2f((m_reg - mn) * C); m_reg = mn;
        const float mnC = -mn * C; float ps = 0.f;
#pragma unroll
        for (int r = 0; r < 16; ++r) { p0[r] = __builtin_amdgcn_exp2f(fmaf(p0[r], C, mnC)); ps += p0[r]; }
#pragma unroll
        for (int r = 0; r < 16; ++r) { p1[r] = __builtin_amdgcn_exp2f(fmaf(p1[r], C, mnC)); ps += p1[r]; }
        ps = half_swap_sum(ps);
        l_reg = l_reg * alpha + ps;
        bf16x8 pa[4]; p_to_afrag(p0, p1, pa);
        SBAR();
        if (j + 2 < NT) SLOAD((j + 2) * 64);
        if (__any(alpha < 1.f)) { if (hi == 0) wsf[r32] = alpha; asm volatile("s_waitcnt lgkmcnt(0)" ::: "memory");
#pragma unroll
            for (int r = 0; r < 16; ++r) { const float a = wsf[crow(r, hi)];
#pragma unroll
                for (int d = 0; d < 4; ++d) o[d][r] *= a; } }
#pragma unroll
        for (int d0 = 0; d0 < 4; ++d0) { bf16x8 vf[4]; v_frags(vrb + cur * AT_BUF + d0 * 512, vf);
#pragma unroll
            for (int ks = 0; ks < 4; ++ks) o[d0] = MFMA32(pa[ks], vf[ks], o[d0]); }
        __syncthreads();
    }
#undef SLOAD
#undef SWRITE
    int lz = lane; asm volatile("" : "+v"(lz));
    const int er = lz & 31, eh = lz >> 5;
    if (eh == 0) wsf[er] = l_reg; asm volatile("s_waitcnt lgkmcnt(0)" ::: "memory");
    float rli[16];
#pragma unroll
    for (int r = 0; r < 16; ++r) rli[r] = __builtin_amdgcn_rcpf(wsf[crow(r, eh)]);
    if constexpr (MODE == 0) {
        u16* Y = (u16*)(F.ws + WS_Y);
        const size_t row0 = rb + q0 + wid * 32;
#pragma unroll
        for (int r = 0; r < 16; ++r) { const size_t row = row0 + crow(r, eh);
#pragma unroll
            for (int d0 = 0; d0 < 4; ++d0) { const int col = h * 128 + d0 * 32 + er;
                const float z = bf2f(P[row * NP + C_MZ + col]);
                Y[row * 512 + col] = f2bf(o[d0][r] * rli[r] * z); } }
    } else {
        LAS float* ex = (LAS float*)lds;
        const int lr0 = (wid & 3) * 32;
        if (wid >= 4) {
#pragma unroll
            for (int r = 0; r < 16; ++r)
#pragma unroll
                for (int d0 = 0; d0 < 4; ++d0) ex[(lr0 + crow(r, eh)) * 128 + d0 * 32 + er] = o[d0][r] * rli[r];
        }
        __syncthreads();
        if (wid < 4) {
            const float lam = ((const float*)(F.ws + WS_LAM))[l];
            const float lam_init = 0.8f - 0.6f * __expf(-0.3f * (float)l);
            const float* og = F.in[26] + l * 128;
            u16* Y = (u16*)(F.ws + WS_Y) + (size_t)3 * MG * 512;
            const size_t row0 = rb + q0 + lr0;
            float gg[4];
#pragma unroll
            for (int d0 = 0; d0 < 4; ++d0) gg[d0] = og[d0 * 32 + er] * (1.f - lam_init);
#pragma unroll
            for (int r = 0; r < 16; ++r) { const int lr = lr0 + crow(r, eh); float v[4]; float ss = 0.f;
#pragma unroll
                for (int d0 = 0; d0 < 4; ++d0) { v[d0] = o[d0][r] * rli[r] - lam * ex[lr * 128 + d0 * 32 + er]; ss += v[d0] * v[d0]; }
                ss += __shfl_xor(ss, 1); ss += __shfl_xor(ss, 2); ss += __shfl_xor(ss, 4); ss += __shfl_xor(ss, 8); ss += __shfl_xor(ss, 16);
                const float rs = rsqrtf(ss * (1.f / 128.f) + EPS); const size_t row = row0 + crow(r, eh);
#pragma unroll
                for (int d0 = 0; d0 < 4; ++d0) { const int col = h * 128 + d0 * 32 + er;
                    const float z = bf2f(P[row * NP + C_DZ + col]);
                    Y[row * 512 + col] = f2bf(v[d0] * rs * gg[d0] * z); } }
        }
        __syncthreads();
    }
}
constexpr int SC_DIR = 40960;
constexpr int SC_QB = 0, SC_KA = 8192, SC_KT = 16384, SC_VI = 24576;
constexpr int SC_ST = 2 * SC_DIR;
constexpr int SC_SCL = SC_ST + 8 * 4096;
template <int MIX>
DI void scan_unit(const Ctx& F, int l, int bl, int h) {
    int tz = (int)threadIdx.x; asm volatile("" : "+v"(tz));
    const int tid = tz, wid = F.wave, lane = tz & 63;
    const int dir = wid >> 2, w4 = wid & 3, tl = tid & 255;
    LAS unsigned char* lds = F.lds;
    LAS unsigned char* db = lds + dir * SC_DIR;
    LAS unsigned char* stp = lds + SC_ST + wid * 4096;
    LAS float* scl = (LAS float*)(lds + SC_SCL + dir * 2048);
    LAS float* xch = scl + 256 + w4 * 32;
    const u16* P = (const u16*)(F.ws + WS_P);
    const size_t rb = (size_t)bl * TT;
    u16* osc = (u16*)(F.ws + WS_OSC) + ((size_t)(MIX * 2 + dir) * MG) * 512;
    for (int e = lane; e < 1024; e += 64) ((LAS unsigned*)stp)[e] = 0u;
    if (tid < 128) { const int d2 = tid >> 6; ((LAS float*)(lds + SC_SCL + d2 * 2048))[192 + (tid & 63)] = 0.f; }
    f32x16 S[2];
#pragma unroll
    for (int k = 0; k < 2; ++k)
#pragma unroll
        for (int r = 0; r < 16; ++r) S[k][r] = 0.f;
    float m_run = 0.f;
    const int pi = tl >> 2, pd0 = (tl & 3) * 16;
    const int vr = tl >> 4, vc = (tl & 15) * 8;
    const int vrb = (int)(uintptr_t)db + SC_VI + v_rd_base(lane) + w4 * 512;
    u32x4 rq[2], rk[2]; f32x4 rb4[4], rl4[1];
#define TOK(c, i) (dir == 0 ? (c) * 64 + (i) : ((c) < 4 ? (3 - (c)) : (39 - (c))) * 64 + 63 - (i))
#define CLOAD(c) do { const size_t g = rb + TOK(c, pi), gl = rb + TOK(c, 63); \
        if (MIX == 0) { const u16* qp = P + g * NP + C_GQ + h * 64 + pd0; rq[0] = *(const u32x4*)qp; rq[1] = *(const u32x4*)(qp + 8); \
            const u16* kp = P + g * NP + C_GK + h * 64 + pd0; rk[0] = *(const u32x4*)kp; rk[1] = *(const u32x4*)(kp + 8); \
            const float* bp = (const float*)(F.ws + WS_BG) + ((size_t)dir * MG + g) * 256 + h * 64 + pd0; \
            _Pragma("unroll") for (int z = 0; z < 4; ++z) rb4[z] = *(const f32x4*)(bp + 4 * z); \
        } else { const u16* qp = (const u16*)(F.ws + WS_QKML) + g * 512 + h * 64 + pd0; rq[0] = *(const u32x4*)qp; rq[1] = *(const u32x4*)(qp + 8); \
            rk[0] = *(const u32x4*)(qp + 256); rk[1] = *(const u32x4*)(qp + 264); \
            rb4[0] = *(const f32x4*)((const float*)(F.ws + WS_SCAL) + (((size_t)dir * MG + g) * 4 + h) * 4); rl4[0] = *(const f32x4*)((const float*)(F.ws + WS_SCAL) + (((size_t)dir * MG + gl) * 4 + h) * 4); } } while (0)
    CLOAD(0);
    __syncthreads();
    for (int c = 0; c < 36; ++c) {
        float m_new = 0.f, decay = 1.f, M63 = 0.f;
        u32x4 rv[4];
#pragma unroll
        for (int z = 0; z < 4; ++z) rv[z] = *(const u32x4*)(P + (rb + TOK(c, vr + 16 * z)) * NP + (MIX == 0 ? C_GV : C_MV) + h * 128 + vc);
        { float q[16], k[16]; unpack8(rq[0], q); unpack8(rq[1], q + 8); unpack8(rk[0], k); unpack8(rk[1], k + 8);
          float qe[16], ke[16], kt[16];
          if (MIX == 0) {
#pragma unroll
              for (int e = 0; e < 16; ++e) { const float bb = rb4[e >> 2][e & 3];
                  qe[e] = q[e] * __expf(bb); ke[e] = k[e] * __expf(-bb); kt[e] = ke[e]; }
              if (pi == 63) {
#pragma unroll
                  for (int e = 0; e < 16; ++e) scl[pd0 + e] = __expf(rb4[e >> 2][e & 3]); }
          } else {
              const float b_i = rb4[0][0], a_i = rb4[0][1], pm_i = rb4[0][2], bL = rl4[0][0], pmL = rl4[0][2];
              M63 = fmaxf(m_run, pmL); m_new = bL + M63; decay = __expf(m_run - M63);
              const float wu = __expf(a_i - M63);
#pragma unroll
              for (int e = 0; e < 16; ++e) { qe[e] = q[e]; ke[e] = k[e]; kt[e] = k[e] * wu; }
              float qn = 0.f;
#pragma unroll
              for (int e = 0; e < 16; ++e) qn += q[e] * scl[192 + pd0 + e];
              qn += __shfl_xor(qn, 1); qn += __shfl_xor(qn, 2);
              if ((tl & 3) == 0) { scl[pi] = b_i; scl[64 + pi] = a_i; scl[128 + pi] = pm_i; scl[384 + pi] = qn; }
          }
          *(LAS u32x4*)(db + SC_QB + swz64(pi, pd0 * 2)) = pack8(qe); *(LAS u32x4*)(db + SC_QB + swz64(pi, pd0 * 2 + 16)) = pack8(qe + 8);
          *(LAS u32x4*)(db + SC_KA + swz64(pi, pd0 * 2)) = pack8(ke); *(LAS u32x4*)(db + SC_KA + swz64(pi, pd0 * 2 + 16)) = pack8(ke + 8);
#pragma unroll
          for (int e = 0; e < 16; ++e) *(LAS u16*)(db + SC_KT + swz64(pd0 + e, pi * 2)) = f2bf(kt[e]);
        }
#pragma unroll
        for (int z = 0; z < 4; ++z) *(LAS u32x4*)(db + SC_VI + v_st(vr + 16 * z, vc)) = rv[z];
        if (c + 1 < 36) CLOAD(c + 1);
        __syncthreads();
        int lz = lane; asm volatile("" : "+v"(lz));
        const int r32 = lz & 31, hi = lz >> 5;
        bf16x8 bs[4];
#pragma unroll
        for (int ks = 0; ks < 4; ++ks) bs[ks] = ldsv(stp + swz64(r32, (ks * 16 + hi * 8) * 2));
        bf16x8 vf[4]; v_frags(vrb, vf);
#pragma nounroll
        for (int qb = 0; qb < 2; ++qb) {
            bf16x8 qf[4];
#pragma unroll
            for (int ks = 0; ks < 4; ++ks) qf[ks] = ldsv(db + SC_QB + qb * 4096 + swz64(r32, (ks * 16 + hi * 8) * 2));
            f32x16 o;
#pragma unroll
            for (int r = 0; r < 16; ++r) o[r] = 0.f;
#pragma unroll
            for (int ks = 0; ks < 4; ++ks) o = MFMA32(qf[ks], bs[ks], o);
            const int qi = 32 * qb + r32;
            float scale_q = 1.f, rs = 0.f;
            const float Mq = (MIX == 1) ? fmaxf(m_run, scl[128 + qi]) : 0.f;
            bf16x8 pa[4];
#pragma unroll
            for (int kh = 0; kh < 2; ++kh) {
                f32x16 p;
#pragma unroll
                for (int r = 0; r < 16; ++r) p[r] = 0.f;
#pragma unroll
                for (int ks = 0; ks < 4; ++ks) p = MFMA32(ldsv(db + SC_KA + kh * 4096 + swz64(r32, (ks * 16 + hi * 8) * 2)), qf[ks], p);
                if (MIX == 0) {
#pragma unroll
                    for (int r = 0; r < 16; ++r) p[r] = (crow(r, hi) + 32 * kh <= qi) ? p[r] : 0.f;
                } else {
#pragma unroll
                    for (int r = 0; r < 16; ++r) { const int kk = crow(r, hi) + 32 * kh; p[r] = (kk <= qi) ? p[r] * __expf(scl[64 + kk] - Mq) : 0.f; rs += p[r]; }
                }
                if (kh == 0) p_half_to_afrag(p, pa[0], pa[1]); else p_half_to_afrag(p, pa[2], pa[3]);
            }
            if (MIX == 1) {
                rs = half_swap_sum(rs);
                const float iw = __expf(m_run - Mq), den = iw * scl[384 + qi] + rs, mi = scl[qi] + Mq;
                scale_q = 1.f / fmaxf(fabsf(den), __expf(-mi));
#pragma unroll
                for (int r = 0; r < 16; ++r) o[r] *= __expf(m_run - fmaxf(m_run, scl[128 + 32 * qb + crow(r, hi)]));
            }
#pragma unroll
            for (int ks = 0; ks < 4; ++ks) o = MFMA32(pa[ks], vf[ks], o);
            if (MIX == 1) {
                if (hi == 0) xch[r32] = scale_q;
                asm volatile("s_waitcnt lgkmcnt(0)" ::: "memory");
#pragma unroll
                for (int r = 0; r < 16; ++r) o[r] *= xch[crow(r, hi)];
            }
#pragma unroll
            for (int r = 0; r < 16; ++r) { const int qq = 32 * qb + crow(r, hi); osc[(rb + TOK(c, qq)) * 512 + h * 128 + w4 * 32 + r32] = f2bf(o[r]); }
        }
        float nnew = 0.f;
#pragma unroll
        for (int dk = 0; dk < 2; ++dk) {
            if (MIX == 1) {
#pragma unroll
                for (int r = 0; r < 16; ++r) S[dk][r] *= decay;
            }
#pragma unroll
            for (int ks = 0; ks < 4; ++ks) { const bf16x8 a = ldsv(db + SC_KT + swz64(32 * dk + r32, (ks * 16 + hi * 8) * 2)); S[dk] = MFMA32(a, vf[ks], S[dk]); }
            if (MIX == 0) {
#pragma unroll
                for (int r = 0; r < 16; ++r) S[dk][r] *= scl[32 * dk + crow(r, hi)];
            }
        }
        if (MIX == 1 && w4 == 0) {
            float sum = 0.f;
#pragma unroll
            for (int j = 0; j < 8; ++j) { float kv[8]; unpack8(__builtin_bit_cast(u32x4, ldsv(db + SC_KT + swz64(lane, j * 16))), kv);
#pragma unroll
                for (int e = 0; e < 8; ++e) sum += kv[e]; }
            nnew = decay * scl[192 + lane] + sum;
            scl[192 + lane] = nnew;
        }
#pragma unroll
        for (int dk = 0; dk < 2; ++dk)
#pragma unroll
            for (int g4 = 0; g4 < 4; ++g4) { u32x2 w; w.x = pk2(S[dk][4 * g4], S[dk][4 * g4 + 1]); w.y = pk2(S[dk][4 * g4 + 2], S[dk][4 * g4 + 3]);
                *(LAS u32x2*)(stp + swz64(r32, (32 * dk + 8 * g4 + 4 * hi) * 2)) = w; }
        if (MIX == 1) m_run = m_new;
        __syncthreads();
    }
#undef CLOAD
    asm volatile("s_waitcnt vmcnt(0)" ::: "memory");
    __syncthreads();
    {
        const u16* of = (const u16*)(F.ws + WS_OSC) + ((size_t)(MIX * 2 + 0) * MG) * 512;
        const u16* ob = (const u16*)(F.ws + WS_OSC) + ((size_t)(MIX * 2 + 1) * MG) * 512;
        u16* Y = (u16*)(F.ws + WS_Y) + (size_t)(MIX == 0 ? 1 : 2) * MG * 512;
        const float* og = (MIX == 0 ? F.in[16] : F.in[22]) + l * 512 + h * 128;
        const float* skp = F.in[23] + l * 512 + h * 128;
        const u16* XC = (const u16*)(F.ws + WS_XC);
        int tq = (int)threadIdx.x; asm volatile("" : "+v"(tq));
        const int c8 = (tq & 15) * 8;
        float g8[8], s8[8];
#pragma unroll
        for (int e = 0; e < 8; ++e) { g8[e] = og[c8 + e]; s8[e] = (MIX == 1) ? skp[c8 + e] : 0.f; }
        for (int t = tq >> 4; t < TT; t += 32) {
            const size_t row = rb + t; const int col = h * 128 + c8;
            float a[8], b[8], v[8]; unpack8(*(const u32x4*)(of + row * 512 + col), a); unpack8(*(const u32x4*)(ob + row * 512 + col), b);
            float ss = 0.f;
            if (MIX == 1) { float og8[8]; unpack8(*(const u32x4*)(P + row * NP + C_MO + col), og8);
#pragma unroll
                for (int e = 0; e < 8; ++e) { v[e] = (a[e] + b[e]) * og8[e]; ss += v[e] * v[e]; }
            } else {
#pragma unroll
                for (int e = 0; e < 8; ++e) { v[e] = a[e] + b[e]; ss += v[e] * v[e]; } }
            ss = group_sum(ss, 16);
            const float rs = rsqrtf(ss * (1.f / 128.f) + EPS);
            float z[8]; unpack8(*(const u32x4*)(P + row * NP + (MIX == 0 ? C_GZ : C_MLZ) + col), z);
            if (MIX == 1) { float xc[8]; unpack8(*(const u32x4*)(XC + row * 512 + col), xc);
#pragma unroll
                for (int e = 0; e < 8; ++e) v[e] = (v[e] * rs * g8[e] + s8[e] * xc[e]) * z[e];
            } else {
#pragma unroll
                for (int e = 0; e < 8; ++e) v[e] = v[e] * rs * g8[e] * z[e]; }
            *(u32x4*)(Y + row * 512 + col) = pack8(v);
        }
    }
    __syncthreads();
#undef TOK
}
DI void p4_mixers(const Ctx& F, int l, int it) {
    const bool last = (l == DEPTH - 1);
    constexpr int N_SCAN = 2 * BGR * 4, N_MLA = BGR * 4 * 8, N_DF = BGR * 4 * 16, N_MLAC = BGR * 4, N_DFC = BGR * 4 * 2;
    constexpr int O_MLA = N_SCAN, O_DF = O_MLA + N_MLA, O_MLAC = O_DF + N_DF, O_DFC = O_MLAC + N_MLAC, N_ALL = O_DFC + N_DFC;
    const int total = last ? O_MLAC : N_ALL;
    unsigned* head = F.ctl + CW_QUEUE + 64 * it;
    volatile LAS unsigned* misc = (volatile LAS unsigned*)(F.lds + LDS_MISC);
    for (;;) {
        __syncthreads();
        if ((int)threadIdx.x == 0) misc[0] = __hip_atomic_fetch_add(head, 1u, __ATOMIC_RELAXED, __HIP_MEMORY_SCOPE_AGENT);
        __syncthreads();
        const int u = (int)misc[0];
        if (u >= total) break;
#ifndef P4_MASK
#define P4_MASK 0xf
#endif
        if (u < O_MLA) { const int mix = u >> 5, rem = u & 31, bl = rem >> 2, h = rem & 3;
            if (mix == 0) { if (P4_MASK & 1) scan_unit<0>(F, l, bl, h); } else { if (P4_MASK & 2) scan_unit<1>(F, l, bl, h); } }
        else if (u < O_DF) { const int v = u - O_MLA, bl = v >> 5, h = (v >> 3) & 3, qb = v & 7; if (P4_MASK & 4) attn_unit<0>(F, l, bl, h, NCTX + qb * 256, TT); }
        else if (u < O_MLAC) { const int v = u - O_DF, bl = v >> 6, h = (v >> 4) & 3, qb = v & 15; if (P4_MASK & 8) attn_unit<1>(F, l, bl, h, NCTX + qb * 128, TT); }
        else if (u < O_DFC) { const int v = u - O_MLAC, bl = v >> 2, h = v & 3; if (P4_MASK & 4) attn_unit<0>(F, l, bl, h, 0, NCTX); }
        else { const int v = u - O_DFC, bl = v >> 3, h = (v >> 1) & 3, qb = v & 1; if (P4_MASK & 8) attn_unit<1>(F, l, bl, h, qb * 128, NCTX); }
    }
}

__global__ void __launch_bounds__(512, 2) fwd_kernel(Params prm) {
    extern __shared__ __attribute__((aligned(16))) unsigned char lds_raw[];
    Ctx F;
    F.in = prm.in;
    F.out = prm.out; F.ws = prm.ws; F.ctl = (unsigned*)(prm.ws + WS_CTL);
    F.wave = __builtin_amdgcn_readfirstlane((int)threadIdx.x >> 6); F.G = gridDim.x;
    F.lds = (LAS unsigned char*)lds_raw;
    if ((int)threadIdx.x < 16) ((LAS unsigned*)(F.lds + LDS_MISC))[(int)threadIdx.x] = 0u;
    __syncthreads();
    XcdBarrier bar = xcd_barrier_post(F.ctl, (volatile LAS unsigned*)(F.lds + LDS_BARW));
    const int s_lo = prm.s_lo, s_hi = prm.s_hi;
#ifndef PH_MASK
#define PH_MASK 0xff
#endif
#define IN(s) (s_lo <= (s) && (s) < s_hi)
#define PHON(k) ((PH_MASK >> (k)) & 1)
#define FRESH() do { unsigned char* w_ = prm.ws; float* o_ = prm.out; asm volatile("" : "+s"(w_), "+s"(o_)); F.ws = w_; F.ctl = (unsigned*)w_; F.out = o_; } while (0)
#define SEAM(s) do { if ((s) + 1 < s_hi) { XcdBarrier b_ = bar; asm volatile("" : "+s"(b_.bar)); xcd_barrier(b_); } } while (0)
    if (PHON(0) && IN(0)) { FRESH(); p0_prologue(F); SEAM(0); }
    for (int it = 0; it < DEPTH * NGRP; ++it) {
        const int l = it / NGRP, g = it % NGRP, sb = 1 + it * 7;
        if (sb + 7 <= s_lo || sb >= s_hi) continue;
        if (PHON(1) && IN(sb + 0)) { FRESH(); p1_norm(F, l, g); SEAM(sb + 0); }
        if (PHON(2) && IN(sb + 1)) {
            FRESH(); u16* Pb = (u16*)(F.ws + WS_P);
            pg8::Gemm gm{(const u16*)(F.ws + WS_H), (const u16*)(F.ws + WS_WIN) + (size_t)l * NP * 1024, MG, NP, 1024, 1024};
            pg8::StaticOrder S; S.init(MG, NP, F.G, (int)blockIdx.x);
            EpiBf E{Pb, NP, 1};
            pg8::gemm_phase<EpiBf, pg8::StaticOrder, true, true>(F.lds, gm, S, E);
            SEAM(sb + 1);
        }
        if (PHON(3) && IN(sb + 2)) {
            FRESH(); u16* Pb = (u16*)(F.ws + WS_P);
            { pg8::Gemm gm{Pb + C_CQ, (const u16*)(F.ws + WS_WUQ) + (size_t)l * 768 * 384, MG, 768, 384, NP};
              pg8::StaticOrder S; S.init(MG, 768, F.G, (int)blockIdx.x);
              EpiBf E{(u16*)(F.ws + WS_Q), 768, 0};
              pg8::gemm_phase<EpiBf, pg8::StaticOrder, true, true>(F.lds, gm, S, E); }
            { pg8::Gemm gm{Pb + C_CKV, (const u16*)(F.ws + WS_WUKV) + (size_t)l * 1024 * 256, MG, 1024, 256, NP};
              int c2 = (int)blockIdx.x + 40; if (c2 >= F.G) c2 -= F.G;
              pg8::StaticOrder S; S.init(MG, 1024, F.G, c2);
              EpiBf E{(u16*)(F.ws + WS_KV), 1024, 0};
              pg8::gemm_phase<EpiBf, pg8::StaticOrder, true, true>(F.lds, gm, S, E); }
            __syncthreads();
            p3_rows(F, l);
            p3_gates(F, l);
            SEAM(sb + 2);
        }
        if (PHON(4) && IN(sb + 3)) {
            FRESH();
            p3b_rows(F, l);
            { pg8::Gemm gm{(const u16*)(F.ws + WS_XC), (const u16*)(F.ws + WS_WQK) + (size_t)l * 512 * 512, MG, 512, 512, 512};
              pg8::StaticOrder S; S.init(MG, 512, F.G, (int)blockIdx.x);
              EpiBf E{(u16*)(F.ws + WS_QKML), 512, 0};
              pg8::gemm_phase<EpiBf, pg8::StaticOrder, true, true>(F.lds, gm, S, E); }
            SEAM(sb + 3);
        }
        if (PHON(5) && IN(sb + 4)) { FRESH(); p4_mixers(F, l, it); SEAM(sb + 4); }
        if (PHON(6) && IN(sb + 5)) {
            FRESH(); u16* Pb = (u16*)(F.ws + WS_P);
#pragma nounroll
            for (int i = 0; i < 4; ++i) {
                pg8::Gemm gm{(const u16*)(F.ws + WS_Y) + (size_t)i * MG * 512, (const u16*)(F.ws + WS_BR) + ((size_t)l * 4 + i) * 1024 * 512, MG, 1024, 512, 512};
                pg8::StaticOrder S; S.init(MG, 1024, F.G, (int)blockIdx.x);
                EpiMerge E{(float*)(F.ws + WS_MF), (u16*)(F.ws + WS_MB), Pb + C_MG + i * 1024, i == 0 ? 0 : (i == 3 ? 2 : 1)};
                pg8::gemm_phase<EpiMerge, pg8::StaticOrder, true, true>(F.lds, gm, S, E);
            }
            SEAM(sb + 5);
        }
        if (PHON(7) && IN(sb + 6)) {
            FRESH();
            pg8::Gemm gm{(const u16*)(F.ws + WS_MB), (const u16*)(F.ws + WS_WO) + (size_t)l * 1024 * 1024, MG, 1024, 1024, 1024};
            pg8::StaticOrder S; S.init(MG, 1024, F.G, (int)blockIdx.x);
            EpiOut E{l == 0 ? F.in[0] : F.out, F.out, l == 0 ? F.in[2] : (const float*)(F.ws + WS_CTX), (float*)(F.ws + WS_CTX),
                     (const float*)(F.ws + WS_MOD) + (size_t)l * 33 * 3072, g, l == DEPTH - 1 ? 1 : 0};
            pg8::gemm_phase<EpiOut, pg8::StaticOrder, true, true>(F.lds, gm, S, E);
            SEAM(sb + 6);
        }
    }
#undef IN
#undef SEAM
}

extern "C" void kernel_launch(void* const* d_in, const int* in_sizes, int n_in, void* d_out, int out_size, void* d_ws, size_t ws_size, hipStream_t stream) {
    static int grid = 0;
    if (grid == 0) {
        if (n_in != 29 || out_size != NB * SEQ * DM || ws_size < WS_END) { fprintf(stderr, "kernel_launch: unexpected shapes (n_in %d, out %d, ws %zu < %zu)\n", n_in, out_size, ws_size, (size_t)WS_END); grid = -1; return; }
        int dev = 0, cus = 0, per_cu = 0;
        if (hipGetDevice(&dev) != hipSuccess || hipDeviceGetAttribute(&cus, hipDeviceAttributeMultiprocessorCount, dev) != hipSuccess) { grid = -1; return; }
        if (hipFuncSetAttribute((const void*)fwd_kernel, hipFuncAttributeMaxDynamicSharedMemorySize, LDS_BYTES) != hipSuccess) { fprintf(stderr, "kernel_launch: hipFuncSetAttribute failed\n"); grid = -1; return; }
        if (hipOccupancyMaxActiveBlocksPerMultiprocessor(&per_cu, (const void*)fwd_kernel, 512, LDS_BYTES) != hipSuccess || per_cu < 1) { fprintf(stderr, "kernel_launch: occupancy query reports %d blocks per CU\n", per_cu); }
        (void)hipGetLastError();
        grid = cus;
    }
    if (grid < 0) return;
    (void)hipMemsetAsync((char*)d_ws + WS_CTL, 0, CTL_BYTES, stream);
    Params p{};
    for (int i = 0; i < 29; ++i) p.in[i] = (const float*)d_in[i];
    p.out = (float*)d_out; p.ws = (unsigned char*)d_ws;
#if MK_MULTI
    for (int s = 0; s < NSTEP; ++s) { p.s_lo = s; p.s_hi = s + 1; hipLaunchKernelGGL(fwd_kernel, dim3(grid), dim3(512), LDS_BYTES, stream, p); }
#else
    p.s_lo = 0; p.s_hi = NSTEP;
    hipLaunchKernelGGL(fwd_kernel, dim3(grid), dim3(512), LDS_BYTES, stream, p);
#endif
    const hipError_t le = hipPeekAtLastError();
    if (le != hipSuccess) fprintf(stderr, "kernel_launch: launch failed: %s\n", hipGetErrorName(le));
}
```

```cpp
#include <hip/hip_runtime.h>
#include <cstdio>
#include <cstdint>
#include <cstddef>

#ifndef MK_MULTI
#define MK_MULTI 0
#endif

#define XB_TMO      128
#define XB_XCNT(j)  (256  + 64 * (j))
#define XB_XSUB(j)  (1280 + 64 * (j))
#define XB_XGEN(j)  (2304 + 64 * (j))
#define XB_TOP      3328
#define XB_TOPGEN   3392
#define XCD_BAR_WORDS 3456
#define XB_SPIN_CAP (1u << 18)
#define LAS __attribute__((address_space(3)))
#define XB_GAS __attribute__((address_space(1)))

__device__ __forceinline__ unsigned xb_ld(XB_GAS unsigned* p)              { return __hip_atomic_load(p, __ATOMIC_RELAXED, __HIP_MEMORY_SCOPE_AGENT); }
__device__ __forceinline__ unsigned xb_add(XB_GAS unsigned* p, unsigned v) { return __hip_atomic_fetch_add(p, v, __ATOMIC_RELAXED, __HIP_MEMORY_SCOPE_AGENT); }
__device__ __forceinline__ unsigned xb_xcc_id() { return (unsigned)__builtin_amdgcn_s_getreg((3 << 11) | 20) & 0xFu; }
#define XB_SPIN(cond, bar) do { unsigned _sp = 0; while (cond) { __builtin_amdgcn_s_sleep(1); \
    if ((++_sp & 255u) == 0u) { if (xb_ld(&(bar)[XB_TMO])) break; if (_sp > XB_SPIN_CAP) { (void)xb_add(&(bar)[XB_TMO], 1u); break; } } } } while (0)

struct XcdBarrier {
    XB_GAS unsigned* bar; unsigned x;
    volatile LAS unsigned* st;
};

__device__ __forceinline__ XcdBarrier xcd_barrier_post(XB_GAS unsigned* bar, volatile LAS unsigned* st) {
    XcdBarrier b; b.bar = bar; b.x = xb_xcc_id(); b.st = st;
    if (threadIdx.x == 0) (void)xb_add(&bar[XB_XCNT(b.x)], 1u);
    return b;
}
__device__ __forceinline__ void xcd_barrier_complete(XB_GAS unsigned* bar, unsigned x, unsigned& nloc, unsigned& nx) {
    const unsigned G = gridDim.x * gridDim.y * gridDim.z;
    unsigned sum, cnt, mine, sp = 0u;
    for (;;) {
        sum = 0u; cnt = 0u; mine = 0u;
#pragma unroll
        for (unsigned j = 0; j < 16; ++j) { const unsigned c = xb_ld(&bar[XB_XCNT(j)]); sum += c; cnt += (c > 0u) ? 1u : 0u; mine = (j == x) ? c : mine; }
        if (sum == G) break;
        __builtin_amdgcn_s_sleep(1);
        if ((++sp & 255u) == 0u) { if (xb_ld(&bar[XB_TMO])) break; if (sp > XB_SPIN_CAP) { (void)xb_add(&bar[XB_TMO], 1u); break; } }
    }
    nloc = mine > 0u ? mine : 1u; nx = cnt > 0u ? cnt : 1u;
}

__device__ __forceinline__ void xcd_barrier(const XcdBarrier& b) {
    asm volatile("s_waitcnt vmcnt(0)" ::: "memory");
    __syncthreads();
    if (threadIdx.x == 0) {
        XB_GAS unsigned* bar = b.bar;
        __builtin_amdgcn_s_waitcnt(0);
        unsigned nloc = b.st[0], nx = b.st[1];
        if (nloc == 0u) { xcd_barrier_complete(bar, b.x, nloc, nx); b.st[0] = nloc; b.st[1] = nx; }
        const unsigned old = xb_add(&bar[XB_XSUB(b.x)], 1u);
        const unsigned gen = old / nloc;
        if (old + 1u == (gen + 1u) * nloc) {
            __builtin_amdgcn_fence(__ATOMIC_RELEASE, "agent");
            asm volatile("s_waitcnt vmcnt(0)" ::: "memory");
            const unsigned og = xb_add(&bar[XB_TOP], 1u);
            const unsigned tg = og / nx;
            if (og + 1u == (tg + 1u) * nx) xb_add(&bar[XB_TOPGEN], 1u);
            else XB_SPIN(xb_ld(&bar[XB_TOPGEN]) == tg, bar);
            __builtin_amdgcn_fence(__ATOMIC_ACQUIRE, "agent");
            xb_add(&bar[XB_XGEN(b.x)], 1u);
            asm volatile("s_waitcnt vmcnt(0)" ::: "memory");
        } else {
            XB_SPIN(xb_ld(&bar[XB_XGEN(b.x)]) == gen, bar);
            __builtin_amdgcn_fence(__ATOMIC_ACQUIRE, "agent");
            asm volatile("s_waitcnt vmcnt(0)" ::: "memory");
        }
    }
    __syncthreads();
}

namespace pg8 {
#define PG8_LAS __attribute__((address_space(3)))
typedef unsigned short bf16_t;
typedef short bf16x8 __attribute__((ext_vector_type(8)));
typedef float f32x4 __attribute__((ext_vector_type(4)));
typedef unsigned u32x4 __attribute__((ext_vector_type(4)));
constexpr int BM = 256, BK = 64, HALF = 128, HTB = HALF * BK * 2  , STAGE_BYTES = 8 * HTB, NXCD = 8, WGM = 8;

__host__ __device__ __forceinline__ int lds_byte(int r, int c) { const int st = (r >> 4) * 2 + (c >> 5), rr = r & 15, cc = c & 31, ob = rr * 64 + cc * 2; return st * 1024 + (ob ^ (((ob >> 9) & 1) << 5)); }
__host__ __device__ __forceinline__ void stage_rc(int b, int& R, int& C) { const int st = b / 1024, sb = b % 1024, swz = sb ^ (((sb >> 9) & 1) << 5); R = (st >> 1) * 16 + swz / 64; C = (st & 1) * 32 + (swz % 64) / 2; }
__host__ __device__ __forceinline__ int perm32(int rho) { const int n = rho >> 4, i = rho & 15; return 8 * (i >> 2) + 4 * n + (i & 3); }

struct Unit { int pm, pn; };
#define PG8_GAS __attribute__((address_space(1)))
struct Gemm { const PG8_GAS bf16_t* A; const PG8_GAS bf16_t* Bt; int M, N, K, lda; };

struct StaticOrder {
    int nM, nN, nwg, G, c;
    __host__ __device__ void init(int M, int N, int G_, int c_) { nM = M / BM; nN = N / BM; nwg = nM * nN; G = G_; c = c_; }
    __host__ __device__ bool next(int i, Unit& u) const {
        const long L = (long)i * G + c; if (L >= nwg) return false;
        int wgid = (int)L; { const int q = nwg / NXCD, r = nwg % NXCD, xcd = wgid % NXCD, off = wgid / NXCD; wgid = (xcd < r ? xcd * (q + 1) : r * (q + 1) + (xcd - r) * q) + off; }
        const int nig = WGM * nN, gid = wgid / nig, fm = gid * WGM, gsz = (nM - fm) < WGM ? (nM - fm) : WGM;
        u.pm = fm + ((wgid % nig) % gsz); u.pn = (wgid % nig) / gsz; return true;
    }
    __device__ __forceinline__ void a_ready(const Unit&) const {}
    __device__ __forceinline__ void done(const Unit&) const {}
};

template <class Epi, class Sched, bool ALIGN_EPI = false, bool SP2 = false>
__device__ __forceinline__ void gemm_phase(PG8_LAS unsigned char* lds, const Gemm g, const Sched& S, const Epi& E) {
    int tid_ = threadIdx.x; asm volatile("" : "+v"(tid_));
    const int tid = tid_, wid = __builtin_amdgcn_readfirstlane(tid >> 6), lane = tid & 63, wr = wid >> 2, wc = wid & 3, fr = lane & 15, fq = lane >> 4;
    const int K = g.K, nt = K / BK;
    unsigned voffA[2], voffB[2];
#pragma unroll
    for (int i = 0; i < 2; ++i) { int R, C; stage_rc(tid * 16 + i * 8192, R, C); const int Rb = Epi::PERM ? ((R & ~31) + perm32(R & 31)) : R;
        voffA[i] = (unsigned)(R * g.lda + C) * 2u; voffB[i] = (unsigned)(Rb * K + C) * 2u; }
    const size_t kstep = (size_t)(BK * 2);
    const size_t hstep = (size_t)HALF * K * 2;
    const size_t tstep = 2 * hstep; const size_t hstepA = (size_t)HALF * g.lda * 2, tstepA = 2 * hstepA;
    const unsigned ldsw = (unsigned)wid * 1024u;
    const int aoff = lds_byte(wr * 64 + fr, fq * 8), boff = lds_byte(wc * 32 + fr, fq * 8);
#define PG8_SA(b, h) (((b) * 2 + (h)) * HTB)
#define PG8_SB(b, h) ((4 + (b) * 2 + (h)) * HTB)
#define PG8_STAGE(bufoff, gbase, voff) do { _Pragma("unroll") for (int _i = 0; _i < 2; ++_i) \
        __builtin_amdgcn_global_load_lds((const PG8_GAS unsigned*)((const PG8_GAS char*)(gbase) + (voff)[_i]), (PG8_LAS unsigned*)(lds + (bufoff) + ldsw + _i * 8192), 16, 0, 0); } while (0)
#define PG8_LDA(dst, b, h) do { _Pragma("unroll") for (int m = 0; m < 4; ++m) _Pragma("unroll") for (int k = 0; k < 2; ++k) dst[m][k] = *(const PG8_LAS bf16x8*)(lds + PG8_SA(b, h) + aoff + m * 2048 + k * 1024); } while (0)
#define PG8_LDB(dst, b, h) do { _Pragma("unroll") for (int n = 0; n < 2; ++n) _Pragma("unroll") for (int k = 0; k < 2; ++k) dst[n][k] = *(const PG8_LAS bf16x8*)(lds + PG8_SB(b, h) + boff + n * 2048 + k * 1024); } while (0)
#define PG8_MMA(ai, bj, At, Bt) do { __builtin_amdgcn_s_setprio(1); _Pragma("unroll") for (int m = 0; m < 4; ++m) _Pragma("unroll") for (int n = 0; n < 2; ++n) _Pragma("unroll") for (int k = 0; k < 2; ++k) \
        acc[ai][bj][m][n] = __builtin_amdgcn_mfma_f32_16x16x32_bf16(Bt[n][k], At[m][k], acc[ai][bj][m][n], 0, 0, 0); __builtin_amdgcn_s_setprio(0); } while (0)
#define PG8_WAIT_V(n) asm volatile("s_waitcnt vmcnt(" #n ")" ::: "memory")
#define PG8_WAIT_L(n) asm volatile("s_waitcnt lgkmcnt(" #n ")" ::: "memory")
#define PG8_BAR __builtin_amdgcn_s_barrier()
#define PG8_SCHED __builtin_amdgcn_sched_barrier(0)
    Unit cur, nxt; int ui = 0;
    if (!S.next(0, cur)) return;
    f32x4 acc[2][2][4][2];
#pragma unroll
    for (int a = 0; a < 2; ++a)
#pragma unroll
        for (int b = 0; b < 2; ++b)
#pragma unroll
            for (int m = 0; m < 4; ++m)
#pragma unroll
                for (int n = 0; n < 2; ++n) acc[a][b][m][n] = (f32x4){0.f, 0.f, 0.f, 0.f};
    bf16x8 At[4][2], B0[2][2], B1[2][2];
    const PG8_GAS char* cA = (const PG8_GAS char*)g.A + (size_t)cur.pm * tstepA; const PG8_GAS char* cB = (const PG8_GAS char*)g.Bt + (size_t)cur.pn * tstep;
    S.a_ready(cur);
    if constexpr (SP2) {
        PG8_STAGE(PG8_SB(0, 0), cB, voffB); PG8_STAGE(PG8_SB(0, 1), cB + hstep, voffB); PG8_STAGE(PG8_SA(0, 0), cA, voffA); PG8_STAGE(PG8_SA(0, 1), cA + hstepA, voffA);
        if (wr == 1) PG8_BAR;
        PG8_WAIT_V(2); PG8_BAR;
        PG8_STAGE(PG8_SB(1, 0), cB + kstep, voffB); PG8_STAGE(PG8_SA(1, 0), cA + kstep, voffA); PG8_STAGE(PG8_SB(1, 1), cB + hstep + kstep, voffB);
        PG8_WAIT_V(6); PG8_BAR;
    } else {
        PG8_STAGE(PG8_SB(0, 0), cB, voffB); PG8_STAGE(PG8_SA(0, 0), cA, voffA); PG8_STAGE(PG8_SB(0, 1), cB + hstep, voffB); PG8_STAGE(PG8_SA(0, 1), cA + hstepA, voffA);
        if (wr == 1) PG8_BAR;
        PG8_WAIT_V(4); PG8_BAR;
        PG8_STAGE(PG8_SB(1, 0), cB + kstep, voffB); PG8_STAGE(PG8_SA(1, 0), cA + kstep, voffA); PG8_STAGE(PG8_SB(1, 1), cB + hstep + kstep, voffB);
        PG8_WAIT_V(6); PG8_BAR;
    }
    for (;;) {
        const bool has_next = S.next(ui + 1, nxt);
        const PG8_GAS char* nA = has_next ? (const PG8_GAS char*)g.A + (size_t)nxt.pm * tstepA : cA; const PG8_GAS char* nB = has_next ? (const PG8_GAS char*)g.Bt + (size_t)nxt.pn * tstep : cB;
        for (int t = 0; t < nt; t += 2) {
            const bool last = (t == nt - 2);
            const PG8_GAS char* a1 = cA + (size_t)(t + 1) * kstep;
            const PG8_GAS char* a2 = last ? nA : cA + (size_t)(t + 2) * kstep; const PG8_GAS char* b2 = last ? nB : cB + (size_t)(t + 2) * kstep;
            const PG8_GAS char* a3 = a2 + kstep; const PG8_GAS char* b3 = b2 + kstep;
            if (last && has_next) S.a_ready(nxt);
            if constexpr (SP2) {
            PG8_LDB(B0, 0, 0); PG8_LDB(B1, 0, 1); PG8_SCHED; PG8_LDA(At, 0, 0); PG8_STAGE(PG8_SA(1, 1), a1 + hstepA, voffA);
            PG8_WAIT_V(8); PG8_WAIT_L(0); PG8_BAR; PG8_MMA(0, 0, At, B0); PG8_MMA(0, 1, At, B1); PG8_BAR; PG8_SCHED;
            PG8_LDA(At, 0, 1); PG8_STAGE(PG8_SB(0, 0), b2, voffB); PG8_STAGE(PG8_SB(0, 1), b2 + hstep, voffB); PG8_STAGE(PG8_SA(0, 0), a2, voffA);
            PG8_WAIT_V(8); PG8_WAIT_L(0); PG8_BAR; PG8_MMA(1, 0, At, B0); PG8_MMA(1, 1, At, B1); PG8_BAR; PG8_SCHED;
            PG8_LDB(B0, 1, 0); PG8_LDB(B1, 1, 1); PG8_SCHED; PG8_LDA(At, 1, 0); PG8_STAGE(PG8_SA(0, 1), a2 + hstepA, voffA);
            PG8_WAIT_V(8); PG8_WAIT_L(0); PG8_BAR; PG8_MMA(0, 0, At, B0); PG8_MMA(0, 1, At, B1); PG8_BAR; PG8_SCHED;
            PG8_LDA(At, 1, 1); PG8_STAGE(PG8_SB(1, 0), b3, voffB); PG8_STAGE(PG8_SB(1, 1), b3 + hstep, voffB); PG8_STAGE(PG8_SA(1, 0), a3, voffA);
            PG8_WAIT_V(8); PG8_WAIT_L(0); PG8_BAR; PG8_MMA(1, 0, At, B0); PG8_MMA(1, 1, At, B1); PG8_BAR; PG8_SCHED;
            } else {
            PG8_LDB(B0, 0, 0); PG8_SCHED; PG8_LDA(At, 0, 0); PG8_STAGE(PG8_SA(1, 1), a1 + hstepA, voffA);
            PG8_WAIT_L(8); PG8_BAR; PG8_WAIT_L(0); PG8_MMA(0, 0, At, B0); PG8_BAR; PG8_SCHED;
            PG8_LDB(B1, 0, 1); PG8_STAGE(PG8_SB(0, 0), b2, voffB);
            PG8_BAR; PG8_WAIT_L(0); PG8_MMA(0, 1, At, B1); PG8_BAR;
            PG8_LDA(At, 0, 1); PG8_STAGE(PG8_SA(0, 0), a2, voffA);
            PG8_BAR; PG8_WAIT_L(0); PG8_MMA(1, 0, At, B0); PG8_BAR; PG8_SCHED;
            PG8_STAGE(PG8_SB(0, 1), b2 + hstep, voffB);
            PG8_WAIT_V(6); PG8_BAR; PG8_MMA(1, 1, At, B1); PG8_BAR;
            PG8_LDB(B0, 1, 0); PG8_SCHED; PG8_LDA(At, 1, 0); PG8_STAGE(PG8_SA(0, 1), a2 + hstepA, voffA);
            PG8_WAIT_L(8); PG8_BAR; PG8_WAIT_L(0); PG8_MMA(0, 0, At, B0); PG8_BAR; PG8_SCHED;
            PG8_LDB(B1, 1, 1); PG8_STAGE(PG8_SB(1, 0), b3, voffB);
            PG8_BAR; PG8_WAIT_L(0); PG8_MMA(0, 1, At, B1); PG8_BAR;
            PG8_LDA(At, 1, 1); PG8_STAGE(PG8_SA(1, 0), a3, voffA);
            PG8_BAR; PG8_WAIT_L(0); PG8_MMA(1, 0, At, B0); PG8_BAR; PG8_SCHED;
            PG8_STAGE(PG8_SB(1, 1), b3 + hstep, voffB);
            PG8_WAIT_V(6); PG8_BAR; PG8_MMA(1, 1, At, B1); PG8_BAR;
            }
        }
        if constexpr (ALIGN_EPI) { if (wr == 0) PG8_BAR; }
        if constexpr (!Epi::AFTER_DRAIN) { E(acc, cur, wr, wc, fr, fq); S.done(cur); }
        if (!has_next) break;
#pragma unroll
        for (int a = 0; a < 2; ++a)
#pragma unroll
            for (int b = 0; b < 2; ++b)
#pragma unroll
                for (int m = 0; m < 4; ++m)
#pragma unroll
                    for (int n = 0; n < 2; ++n) acc[a][b][m][n] = (f32x4){0.f, 0.f, 0.f, 0.f};
        cur = nxt; cA = nA; cB = nB; ++ui;
        if constexpr (ALIGN_EPI) { if (wr == 1) PG8_BAR; }
    }
    PG8_WAIT_V(0);
    if constexpr (!ALIGN_EPI) { if (wr == 0) PG8_BAR; }
    PG8_BAR;
    if constexpr (Epi::AFTER_DRAIN) { E.fused(acc, cur, wr, wc, fr, fq, lds, wid, lane); S.done(cur); }
#undef PG8_SA
#undef PG8_SB
#undef PG8_STAGE
#undef PG8_LDA
#undef PG8_LDB
#undef PG8_MMA
#undef PG8_WAIT_V
#undef PG8_WAIT_L
#undef PG8_BAR
#undef PG8_SCHED
}
}

typedef unsigned short u16;
typedef short bf16x8 __attribute__((ext_vector_type(8)));
typedef short s16x4 __attribute__((ext_vector_type(4)));
typedef float f32x4 __attribute__((ext_vector_type(4)));
typedef float f32x16 __attribute__((ext_vector_type(16)));
typedef unsigned u32x4 __attribute__((ext_vector_type(4)));
typedef unsigned u32x2 __attribute__((ext_vector_type(2)));
typedef __bf16 bf16x2_t __attribute__((ext_vector_type(2)));
typedef float f32x2_t __attribute__((ext_vector_type(2)));
#define DI __device__ __forceinline__

constexpr int NB = 32, SEQ = 2048, NCTX = 256, TT = 2304, DM = 1024, DEPTH = 4;
constexpr int NGRP = 4, BGR = 8, MG = BGR * TT;
constexpr int DIN = 10992, NP = 11008;
constexpr float EPS = 1e-6f;
constexpr int C_CQ = 0, C_KR = 384, C_AF = 448, C_AB = 464, C_IF = 480, C_CKV = 512, C_MZ = 768, C_GQ = 1280, C_GK = 1536, C_GV = 1792, C_GZ = 2304,
              C_MX = 2816, C_MV = 3328, C_MO = 3840, C_MLZ = 4352, C_DQ = 4864, C_DK = 5376, C_DV = 5888, C_DZ = 6400, C_MG = 6912;
constexpr int NSTEP = 1 + DEPTH * NGRP * 7;
constexpr int LDS_BYTES = 147456;
constexpr int LDS_BARW = LDS_BYTES - 16;
constexpr int LDS_MISC = LDS_BYTES - 64;

constexpr size_t al256(size_t x) { return (x + 255) / 256 * 256; }
constexpr size_t WS_CTL = 0;
constexpr size_t CTL_BYTES = 65536;
constexpr size_t WS_MOD  = WS_CTL + CTL_BYTES;
constexpr size_t WS_ROPE = WS_MOD + al256((size_t)DEPTH * 33 * 3072 * 4);
constexpr size_t WS_LAM  = WS_ROPE + 8192;
constexpr size_t WS_WIN  = WS_LAM + 256;
constexpr size_t WS_BR   = WS_WIN + (size_t)DEPTH * NP * 1024 * 2;
constexpr size_t WS_WO   = WS_BR + (size_t)DEPTH * 4 * 1024 * 512 * 2;
constexpr size_t WS_WUQ  = WS_WO + (size_t)DEPTH * 1024 * 1024 * 2;
constexpr size_t WS_WUKV = WS_WUQ + (size_t)DEPTH * 768 * 384 * 2;
constexpr size_t WS_WQK  = WS_WUKV + (size_t)DEPTH * 1024 * 256 * 2;
constexpr size_t WS_CTX  = WS_WQK + (size_t)DEPTH * 512 * 512 * 2;
constexpr size_t WS_H    = WS_CTX + (size_t)NB * NCTX * DM * 4;
constexpr size_t WS_P    = WS_H + (size_t)MG * 1024 * 2;
constexpr size_t WS_Q    = WS_P + (size_t)MG * NP * 2;
constexpr size_t WS_KV   = WS_Q + (size_t)MG * 768 * 2;
constexpr size_t WS_XC   = WS_KV + (size_t)MG * 1024 * 2;
constexpr size_t WS_QKML = WS_XC + (size_t)MG * 512 * 2;
constexpr size_t WS_BG   = WS_QKML + (size_t)MG * 512 * 2;
constexpr size_t WS_SCAL = WS_BG + (size_t)2 * MG * 256 * 4;
constexpr size_t WS_Y    = WS_SCAL + (size_t)2 * MG * 16 * 4;
constexpr size_t WS_OSC  = WS_Y + (size_t)4 * MG * 512 * 2;
constexpr size_t WS_MF   = WS_OSC;
constexpr size_t WS_MB   = WS_OSC + (size_t)4 * MG * 512 * 2;
constexpr size_t WS_END  = WS_MB + (size_t)MG * 1024 * 2;
static_assert((size_t)MG * 1024 * 4 == (size_t)4 * MG * 512 * 2, "merge accumulator aliases the scan scratch");
static_assert(WS_END <= (size_t)1000 * 1024 * 1024, "workspace map must stay below 1000 MiB");
constexpr int CW_QUEUE = 4096;

#define GAS __attribute__((address_space(1)))
typedef GAS float gf32; typedef GAS unsigned short gu16; typedef GAS unsigned char gu8;
#define FIN(k) ((const gf32*)F.in[k])
struct Params { const float* in[29]; float* out; unsigned char* ws; int s_lo, s_hi; };

struct Ctx {
    const float* const* in; gf32* out; gu8* ws; GAS unsigned* ctl;
    int wave, G;
    LAS unsigned char* lds;
};

DI float bf2f(u16 v) { return __uint_as_float((unsigned)v << 16); }
DI float bflo(unsigned w) { return __uint_as_float(w << 16); }
DI float bfhi(unsigned w) { return __uint_as_float(w & 0xffff0000u); }
DI unsigned pk2(float lo, float hi) { f32x2_t v = {lo, hi}; bf16x2_t b = __builtin_convertvector(v, bf16x2_t); return __builtin_bit_cast(unsigned, b); }
DI u16 f2bf(float f) { return (u16)(pk2(f, 0.f) & 0xffffu); }
DI void unpack8(u32x4 w, float* f) { f[0] = bflo(w.x); f[1] = bfhi(w.x); f[2] = bflo(w.y); f[3] = bfhi(w.y); f[4] = bflo(w.z); f[5] = bfhi(w.z); f[6] = bflo(w.w); f[7] = bfhi(w.w); }
DI u32x4 pack8(const float* f) { u32x4 w; w.x = pk2(f[0], f[1]); w.y = pk2(f[2], f[3]); w.z = pk2(f[4], f[5]); w.w = pk2(f[6], f[7]); return w; }
DI float sigmoid_f(float x) { return __builtin_amdgcn_rcpf(1.f + __expf(-x)); }
DI float silu_f(float x) { return x * sigmoid_f(x); }
DI float logsig_f(float x) { return fminf(x, 0.f) - __logf(1.f + __expf(-fabsf(x))); }
DI int crow(int r, int hi) { return (r & 3) + 8 * (r >> 2) + 4 * hi; }
DI int swz64(int row, int colB) { return row * 128 + (colB ^ (((row >> 1) & 7) << 4)); }
DI int kswz(int row, int colB) { return row * 256 + (colB ^ ((row & 7) << 4)); }
DI int v_st(int k, int c) { const int kk = (k & ~0xC) | ((k & 4) << 1) | ((k & 8) >> 1); return ((kk >> 3) * 4 + (c >> 5)) * 512 + ((kk & 7) * 32 + (c & 31)) * 2; }
DI int v_rd_base(int lane) { return ((lane & 3) << 3) | (((lane >> 2) & 3) << 6) | (((lane >> 4) & 1) << 5) | (((lane >> 5) & 1) << 8); }
template <int OFF> DI s16x4 tr_read(int vb) { s16x4 r; asm volatile("ds_read_b64_tr_b16 %0, %1 offset:%2" : "=&v"(r) : "v"(vb), "i"(OFF) : "memory"); return r; }
#define SBAR() __builtin_amdgcn_sched_barrier(0)
#define MFMA32(a, b, c) __builtin_amdgcn_mfma_f32_32x32x16_bf16((a), (b), (c), 0, 0, 0)
DI bf16x8 ldsv(const LAS unsigned char* p) { return *(const LAS bf16x8*)p; }
DI float wave_sum(float v) {
#pragma unroll
    for (int o = 32; o >= 1; o >>= 1) v += __shfl_xor(v, o);
    return v;
}
DI void v_frags(int vb, bf16x8 (&vf)[4]) {
    const s16x4 l0 = tr_read<0>(vb), h0 = tr_read<2048>(vb), l1 = tr_read<4096>(vb), h1 = tr_read<4096 + 2048>(vb);
    const s16x4 l2 = tr_read<8192>(vb), h2 = tr_read<8192 + 2048>(vb), l3 = tr_read<12288>(vb), h3 = tr_read<12288 + 2048>(vb);
    asm volatile("s_waitcnt lgkmcnt(0)" ::: "memory"); SBAR();
#define PKV(L, H) (bf16x8){L[0], L[1], L[2], L[3], H[0], H[1], H[2], H[3]}
    vf[0] = PKV(l0, h0); vf[1] = PKV(l1, h1); vf[2] = PKV(l2, h2); vf[3] = PKV(l3, h3);
#undef PKV
}
DI void p_to_afrag(const f32x16& p0, const f32x16& p1, bf16x8 (&pa)[4]) {
#define PK4(P, BASE, OUT) do { unsigned a0 = pk2(P[BASE + 0], P[BASE + 1]), a1 = pk2(P[BASE + 2], P[BASE + 3]);   \
    unsigned b0 = pk2(P[BASE + 4], P[BASE + 5]), b1 = pk2(P[BASE + 6], P[BASE + 7]);                              \
    auto r0 = __builtin_amdgcn_permlane32_swap(a0, b0, false, false); auto r1 = __builtin_amdgcn_permlane32_swap(a1, b1, false, false); \
    u32x4 w = {r0[0], r1[0], r0[1], r1[1]}; OUT = __builtin_bit_cast(bf16x8, w); } while (0)
    PK4(p0, 0, pa[0]); PK4(p0, 8, pa[1]); PK4(p1, 0, pa[2]); PK4(p1, 8, pa[3]);
#undef PK4
}
DI void p_half_to_afrag(const f32x16& p, bf16x8& pa0, bf16x8& pa1) {
#define PK4(P, BASE, OUT) do { unsigned a0 = pk2(P[BASE + 0], P[BASE + 1]), a1 = pk2(P[BASE + 2], P[BASE + 3]);   \
    unsigned b0 = pk2(P[BASE + 4], P[BASE + 5]), b1 = pk2(P[BASE + 6], P[BASE + 7]);                              \
    auto r0 = __builtin_amdgcn_permlane32_swap(a0, b0, false, false); auto r1 = __builtin_amdgcn_permlane32_swap(a1, b1, false, false); \
    u32x4 w = {r0[0], r1[0], r0[1], r1[1]}; OUT = __builtin_bit_cast(bf16x8, w); } while (0)
    PK4(p, 0, pa0); PK4(p, 8, pa1);
#undef PK4
}
DI float half_swap_sum(float v) { auto rr = __builtin_amdgcn_permlane32_swap(__float_as_uint(v), __float_as_uint(v), false, false); return __uint_as_float(rr[0]) + __uint_as_float(rr[1]); }
DI float half_swap_max(float v) { auto rr = __builtin_amdgcn_permlane32_swap(__float_as_uint(v), __float_as_uint(v), false, false); return fmaxf(__uint_as_float(rr[0]), __uint_as_float(rr[1])); }
using pg8::Unit;
typedef f32x4 AccT[2][2][4][2];

DI int p_act(int pn) {
    if (pn >= 27) return 2;
    if (pn == 15 || pn == 16) return 2;
    if (pn == 3 || pn == 4 || pn == 9 || pn == 10 || pn == 17 || pn == 18 || pn == 25 || pn == 26) return 1;
    return 0;
}
struct EpiBf {
    static constexpr bool PERM = true, AFTER_DRAIN = false;
    gu16* O; int ldc; int actsel;
    DI void operator()(const AccT& acc, const Unit& u, int wr, int wc, int fr, int fq) const {
        const int row0 = u.pm * 256 + wr * 64 + fr, col0 = u.pn * 256 + wc * 32 + 8 * fq;
        const int act = actsel ? p_act(u.pn) : 0;
#pragma unroll
        for (int ai = 0; ai < 2; ++ai)
#pragma unroll
            for (int m = 0; m < 4; ++m) { gu16* rowp = O + (size_t)(row0 + ai * 128 + m * 16) * ldc + col0;
#pragma unroll
                for (int bj = 0; bj < 2; ++bj) { f32x4 v0 = acc[ai][bj][m][0], v1 = acc[ai][bj][m][1];
                    float f[8] = {v0[0], v0[1], v0[2], v0[3], v1[0], v1[1], v1[2], v1[3]};
                    if (act == 1) {
#pragma unroll
                        for (int e = 0; e < 8; ++e) f[e] = silu_f(f[e]);
                    } else if (act == 2) {
#pragma unroll
                        for (int e = 0; e < 8; ++e) f[e] = sigmoid_f(f[e]);
                    }
                    *(GAS u32x4*)(rowp + bj * 128) = pack8(f); } }
    }
};
struct EpiMerge {
    static constexpr bool PERM = true, AFTER_DRAIN = false;
    gf32* MF; gu16* MB; const gu16* gate; int mode;
    DI void operator()(const AccT& acc, const Unit& u, int wr, int wc, int fr, int fq) const {
        const int row0 = u.pm * 256 + wr * 64 + fr, col0 = u.pn * 256 + wc * 32 + 8 * fq;
#pragma unroll
        for (int ai = 0; ai < 2; ++ai)
#pragma unroll
            for (int m = 0; m < 4; ++m) { const size_t r = (size_t)(row0 + ai * 128 + m * 16);
#pragma unroll
                for (int bj = 0; bj < 2; ++bj) { const int c = col0 + bj * 128;
                    f32x4 v0 = acc[ai][bj][m][0], v1 = acc[ai][bj][m][1];
                    float g[8]; unpack8(*(const GAS u32x4*)(gate + r * NP + c), g);
                    float f[8] = {v0[0] * g[0], v0[1] * g[1], v0[2] * g[2], v0[3] * g[3], v1[0] * g[4], v1[1] * g[5], v1[2] * g[6], v1[3] * g[7]};
                    gf32* mp = MF + r * 1024 + c;
                    if (mode != 0) { const f32x4 o0 = *(const GAS f32x4*)mp, o1 = *(const GAS f32x4*)(mp + 4);
                        f[0] += o0[0]; f[1] += o0[1]; f[2] += o0[2]; f[3] += o0[3]; f[4] += o1[0]; f[5] += o1[1]; f[6] += o1[2]; f[7] += o1[3]; }
                    if (mode == 2) *(GAS u32x4*)(MB + r * 1024 + c) = pack8(f);
                    else { *(GAS f32x4*)mp = (f32x4){f[0], f[1], f[2], f[3]}; *(GAS f32x4*)(mp + 4) = (f32x4){f[4], f[5], f[6], f[7]}; } } }
    }
};
struct EpiOut {
    static constexpr bool PERM = false, AFTER_DRAIN = false;
    const gf32* xsrc; gf32* xdst; const gf32* csrc; gf32* cdst; const gf32* mod; int grp; int last;
    DI void operator()(const AccT& acc, const Unit& u, int wr, int wc, int fr, int fq) const {
        const int bl = u.pm / 9, tb = u.pm % 9, b = grp * BGR + bl;
        if (tb == 0 && last) return;
        const gf32* src; gf32* dst; const gf32* gt;
        if (tb == 0) { src = csrc + (size_t)b * NCTX * DM; dst = cdst + (size_t)b * NCTX * DM; gt = mod + 32 * 3072 + 2048; }
        else { src = xsrc + ((size_t)b * SEQ + (size_t)(tb - 1) * 256) * DM; dst = xdst + ((size_t)b * SEQ + (size_t)(tb - 1) * 256) * DM; gt = mod + b * 3072 + 2048; }
        const int row0 = wr * 64 + fr, col0 = u.pn * 256 + wc * 32 + 4 * fq;
        f32x4 gv[2][2];
#pragma unroll
        for (int bj = 0; bj < 2; ++bj)
#pragma unroll
            for (int n = 0; n < 2; ++n) gv[bj][n] = *(const GAS f32x4*)(gt + col0 + bj * 128 + n * 16);
#pragma unroll
        for (int ai = 0; ai < 2; ++ai)
#pragma unroll
            for (int m = 0; m < 4; ++m) { const size_t ro = (size_t)(row0 + ai * 128 + m * 16) * DM + col0;
#pragma unroll
                for (int bj = 0; bj < 2; ++bj)
#pragma unroll
                    for (int n = 0; n < 2; ++n) { const f32x4 xo = *(const GAS f32x4*)(src + ro + bj * 128 + n * 16);
                        *(GAS f32x4*)(dst + ro + bj * 128 + n * 16) = xo + gv[bj][n] * acc[ai][bj][m][n]; } }
    }
};

DI int pmap(int n, float& sc) {
    sc = 1.f;
    if (n < 384) return n;
    if (n < 448) return 640 + (n - 384);
    if (n < 464) return 2240 + (n - 448);
    if (n < 480) return 2256 + (n - 464);
    if (n < 496) return 4320 + (n - 480);
    if (n < 512) return -1;
    if (n < 768) return 384 + (n - 512);
    if (n < 1280) return 704 + (n - 768);
    if (n < 1536) { sc = 0.125f; return 1216 + (n - 1280); }
    if (n < 1792) return 1472 + (n - 1536);
    if (n < 2304) return 1728 + (n - 1792);
    if (n < 2816) return 2272 + (n - 2304);
    if (n < 3328) return 2784 + (n - 2816);
    if (n < 3840) return 3296 + (n - 3328);
    if (n < 4352) return 3808 + (n - 3840);
    if (n < 4864) return 4336 + (n - 4352);
    if (n < 5376) return 4848 + (n - 4864);
    if (n < 5888) return 5360 + (n - 5376);
    if (n < 6400) return 5872 + (n - 5888);
    if (n < 6912) return 6384 + (n - 6400);
    return 6896 + (n - 6912);
}
struct MapWin { DI int operator()(int n, float& sc) const { return pmap(n, sc); } };
struct MapId  { DI int operator()(int n, float& sc) const { sc = 1.f; return n; } };
struct MapQ   { DI int operator()(int n, float& sc) const { sc = 1.f; return n < 512 ? (n >> 7) * 192 + (n & 127) : ((n - 512) >> 6) * 192 + 128 + ((n - 512) & 63); } };
struct MapKV  { DI int operator()(int n, float& sc) const { sc = 1.f; return n < 512 ? (n >> 7) * 256 + (n & 127) : ((n - 512) >> 7) * 256 + 128 + ((n - 512) & 127); } };

template <class Map>
DI void xpose_tile(const gf32* __restrict__ src, int ldsrc, gu16* __restrict__ dst, int K, int n0, int k0, const gf32* __restrict__ kscale, Map map, LAS float* tl) {
    const int tid = threadIdx.x;
    { const int kk = tid >> 3, ng = (tid & 7) * 8; float sc; const int sn = map(n0 + ng, sc);
      f32x4 a = {0.f, 0.f, 0.f, 0.f}, b = {0.f, 0.f, 0.f, 0.f};
      if (sn >= 0) { const gf32* p = src + (size_t)(k0 + kk) * ldsrc + sn; a = *(const GAS f32x4*)p; b = *(const GAS f32x4*)(p + 4); }
      const float ks = (kscale ? kscale[k0 + kk] : 1.f) * sc;
      tl[(ng + 0) * 65 + kk] = a[0] * ks; tl[(ng + 1) * 65 + kk] = a[1] * ks; tl[(ng + 2) * 65 + kk] = a[2] * ks; tl[(ng + 3) * 65 + kk] = a[3] * ks;
      tl[(ng + 4) * 65 + kk] = b[0] * ks; tl[(ng + 5) * 65 + kk] = b[1] * ks; tl[(ng + 6) * 65 + kk] = b[2] * ks; tl[(ng + 7) * 65 + kk] = b[3] * ks; }
    __syncthreads();
    { const int nn = tid >> 3, kg = (tid & 7) * 8; float f[8];
#pragma unroll
      for (int e = 0; e < 8; ++e) f[e] = tl[nn * 65 + kg + e];
      *(GAS u32x4*)(dst + (size_t)(n0 + nn) * K + k0 + kg) = pack8(f); }
    __syncthreads();
}

DI void p0_prologue(const Ctx& F) {
    int tz = (int)threadIdx.x; asm volatile("" : "+v"(tz));
    const int tid = tz;
    LAS float* lf = (LAS float*)F.lds;
    constexpr int U_ADA = 96, U_WIN = DEPTH * (NP / 64) * 16, U_BR = DEPTH * 4 * 16 * 8, U_WO = DEPTH * 16 * 16, U_WUQ = DEPTH * 12 * 6, U_WUKV = DEPTH * 16 * 4, U_WQK = DEPTH * 64, U_MISC = 1;
    constexpr int O_WIN = U_ADA, O_BR = O_WIN + U_WIN, O_WO = O_BR + U_BR, O_WUQ = O_WO + U_WO, O_WUKV = O_WUQ + U_WUQ, O_WQK = O_WUKV + U_WUKV, O_MISC = O_WQK + U_WQK, U_ALL = O_MISC + U_MISC;
    for (int u = blockIdx.x; u < U_ALL; u += F.G) {
        if (u < U_ADA) {
            const int l = u / 24, col0 = (u % 24) * 128, col = tid & 127, kq = tid >> 7;
            const gf32* aw = FIN(4) + (size_t)l * 1024 * 3072;
            float acc[33];
#pragma unroll
            for (int r = 0; r < 33; ++r) acc[r] = 0.f;
            for (int kc = 0; kc < 1024; kc += 256) {
                __syncthreads();
                for (int idx = tid; idx < 33 * 256; idx += 512) { const int r = idx >> 8, k = idx & 255; const float cv = (r < 32) ? FIN(1)[r * 1024 + kc + k] : FIN(3)[kc + k]; lf[idx] = silu_f(cv); }
                __syncthreads();
                for (int k = kq * 64; k < kq * 64 + 64; ++k) { const float w = aw[(size_t)(kc + k) * 3072 + col0 + col];
#pragma unroll
                    for (int r = 0; r < 33; ++r) acc[r] += lf[r * 256 + k] * w; }
            }
            __syncthreads();
#pragma unroll
            for (int r = 0; r < 33; ++r) lf[(kq * 33 + r) * 128 + col] = acc[r];
            __syncthreads();
            gf32* mod = (gf32*)(F.ws + WS_MOD) + (size_t)l * 33 * 3072;
            for (int idx = tid; idx < 33 * 128; idx += 512) { const int r = idx >> 7, c = idx & 127;
                mod[r * 3072 + col0 + c] = lf[(0 * 33 + r) * 128 + c] + lf[(1 * 33 + r) * 128 + c] + lf[(2 * 33 + r) * 128 + c] + lf[(3 * 33 + r) * 128 + c] + FIN(5)[l * 3072 + col0 + c]; }
            __syncthreads();
        } else if (u < O_BR) {
            const int v = u - O_WIN, l = v / ((NP / 64) * 16), t = v % ((NP / 64) * 16), nt = t / 16, kt = t % 16;
            xpose_tile(FIN(7) + (size_t)l * 1024 * DIN, DIN, (gu16*)(F.ws + WS_WIN) + (size_t)l * NP * 1024, 1024, nt * 64, kt * 64, nullptr, MapWin(), lf);
        } else if (u < O_WO) {
            const int v = u - O_BR, li = v / 128, t = v % 128, nt = t / 8, kt = t % 8;
            xpose_tile(FIN(27) + (size_t)li * 512 * 1024, 1024, (gu16*)(F.ws + WS_BR) + (size_t)li * 1024 * 512, 512, nt * 64, kt * 64, nullptr, MapId(), lf);
        } else if (u < O_WUQ) {
            const int v = u - O_WO, l = v / 256, t = v % 256, nt = t / 16, kt = t % 16;
            xpose_tile(FIN(28) + (size_t)l * 1024 * 1024, 1024, (gu16*)(F.ws + WS_WO) + (size_t)l * 1024 * 1024, 1024, nt * 64, kt * 64, nullptr, MapId(), lf);
        } else if (u < O_WUKV) {
            const int v = u - O_WUQ, l = v / 72, t = v % 72, nt = t / 6, kt = t % 6;
            xpose_tile(FIN(10) + (size_t)l * 384 * 768, 768, (gu16*)(F.ws + WS_WUQ) + (size_t)l * 768 * 384, 384, nt * 64, kt * 64, FIN(8) + l * 384, MapQ(), lf);
        } else if (u < O_WQK) {
            const int v = u - O_WUKV, l = v / 64, t = v % 64, nt = t / 4, kt = t % 4;
            xpose_tile(FIN(11) + (size_t)l * 256 * 1024, 1024, (gu16*)(F.ws + WS_WUKV) + (size_t)l * 1024 * 256, 256, nt * 64, kt * 64, FIN(9) + l * 256, MapKV(), lf);
        } else if (u < O_MISC) {
            const int v = u - O_WQK, l = v / 64, t = v % 64;
            gu16* dst = (gu16*)(F.ws + WS_WQK) + (size_t)l * 512 * 512;
            for (int e = tid; e < 4096; e += 512) { const int idx = t * 4096 + e, n = idx >> 9, k = idx & 511;
                const int isk = n >> 8, hn = (n & 255) >> 6, dd = n & 63, hk = k >> 7, c = k & 127;
                float val = 0.f;
                if (hn == hk) { const gf32* w = (isk ? FIN(20) : FIN(19)) + (((size_t)l * 4 + hn) * 128 + c) * 64 + dd; val = isk ? *w * 0.125f : *w; }
                dst[idx] = f2bf(val); }
        } else {
            gf32* rope = (gf32*)(F.ws + WS_ROPE);
            for (int e = tid; e < 1024; e += 512) { const int pos = e >> 4, i = e & 15;
                const float inv = powf(10000.f, -(float)i / 16.f); const float ang = (float)pos * inv;
                rope[e] = cosf(ang); rope[1024 + e] = sinf(ang); }
            if (tid < 4) { const gf32* lp = FIN(25) + tid * 256; float s0 = 0.f, s1 = 0.f;
                for (int d = 0; d < 64; ++d) { s0 += lp[d] * lp[64 + d]; s1 += lp[128 + d] * lp[192 + d]; }
                const float lam_init = 0.8f - 0.6f * expf(-0.3f * (float)tid);
                ((gf32*)(F.ws + WS_LAM))[tid] = expf(s0) - expf(s1) + lam_init; }
        }
    }
}

DI void p1_norm(const Ctx& F, int l, int g) {
    const gf32* mod = (const gf32*)(F.ws + WS_MOD) + (size_t)l * 33 * 3072;
    const gf32* ng = FIN(6) + l * 1024;
    const gf32* xs = (l == 0) ? FIN(0) : F.out;
    const gf32* cs = (l == 0) ? FIN(2) : (const gf32*)(F.ws + WS_CTX);
    gu16* H = (gu16*)(F.ws + WS_H);
    int lz = ((int)threadIdx.x & 63); asm volatile("" : "+v"(lz));
    const int lane = lz;
    int row0 = blockIdx.x * 8 + F.wave; asm volatile("" : "+s"(row0));
    for (int row = row0; row < MG; row += F.G * 8) {
        const int bl = row / TT, t = row % TT, b = g * BGR + bl;
        const gf32* src; const gf32* md;
        if (t < NCTX) { src = cs + ((size_t)b * NCTX + t) * DM; md = mod + 32 * 3072; } else { src = xs + ((size_t)b * SEQ + (t - NCTX)) * DM; md = mod + b * 3072; }
        f32x4 v[4]; float ss = 0.f;
#pragma unroll
        for (int i = 0; i < 4; ++i) { v[i] = *(const GAS f32x4*)(src + i * 256 + lane * 4); ss += v[i][0] * v[i][0] + v[i][1] * v[i][1] + v[i][2] * v[i][2] + v[i][3] * v[i][3]; }
        ss = wave_sum(ss);
        const float rstd = rsqrtf(ss * (1.f / 1024.f) + EPS);
#pragma unroll
        for (int i = 0; i < 4; ++i) { const int c = i * 256 + lane * 4;
            const f32x4 gg = *(const GAS f32x4*)(ng + c), sh = *(const GAS f32x4*)(md + c), sc = *(const GAS f32x4*)(md + 1024 + c);
            const f32x4 y = v[i] * rstd * gg * (sc + 1.f) + sh;
            u32x2 w; w.x = pk2(y[0], y[1]); w.y = pk2(y[2], y[3]);
            *(GAS u32x2*)(H + (size_t)row * 1024 + c) = w; }
    }
}
DI void rope8(float* x, int j8, int t, const gf32* __restrict__ rope) {
    float p[8];
#pragma unroll
    for (int e = 0; e < 8; ++e) p[e] = __shfl_xor(x[e], 2);
    if (t < NCTX) return;
    const int s = t - NCTX, pos = (j8 & 4) ? (s & 63) : (s >> 6), i0 = 8 * (j8 & 1);
    const float sg = (j8 & 2) ? 1.f : -1.f;
#pragma unroll
    for (int e = 0; e < 8; ++e) { const float c = rope[pos * 16 + i0 + e], sn = rope[1024 + pos * 16 + i0 + e]; x[e] = x[e] * c + sg * p[e] * sn; }
}
DI float group_sum(float v, int n) {
    v += __shfl_xor(v, 1); v += __shfl_xor(v, 2); v += __shfl_xor(v, 4); if (n == 16) v += __shfl_xor(v, 8); return v;
}

DI void p3_rows(const Ctx& F, int l) {
    gu16* P = (gu16*)(F.ws + WS_P); gu16* XC = (gu16*)(F.ws + WS_XC);
    const gf32* rope = (const gf32*)(F.ws + WS_ROPE);
    const gf32* cw = FIN(17) + (size_t)l * 3 * 512; const gf32* cb = FIN(18) + l * 512;
    const gf32* qkg = FIN(24) + l * 128; const gf32* kg = FIN(13) + l * 192 + 128;
    int lz = ((int)threadIdx.x & 63); asm volatile("" : "+v"(lz));
    const int lane = lz, c8 = lane * 8;
    int row0 = blockIdx.x * 8 + F.wave; asm volatile("" : "+s"(row0));
    for (int row = row0; row < MG; row += F.G * 8) {
        const int t = row % TT; gu16* pr = P + (size_t)row * NP;
        { const bool hasl = (t != 0 && t != NCTX), hasr = (t != NCTX - 1 && t != TT - 1);
          float x0[8], xm[8], xp[8], o[8];
          unpack8(*(const GAS u32x4*)(pr + C_MX + c8), x0);
          if (hasl) unpack8(*(const GAS u32x4*)(pr - NP + C_MX + c8), xm);
          if (hasr) unpack8(*(const GAS u32x4*)(pr + NP + C_MX + c8), xp);
#pragma unroll
          for (int e = 0; e < 8; ++e) { float a = cb[c8 + e] + cw[512 + c8 + e] * x0[e];
              if (hasl) a += cw[c8 + e] * xm[e];
              if (hasr) a += cw[1024 + c8 + e] * xp[e];
              o[e] = silu_f(a); }
          *(GAS u32x4*)(XC + (size_t)row * 512 + c8) = pack8(o); }
#pragma unroll
        for (int qk = 0; qk < 2; ++qk) { gu16* p = pr + (qk ? C_DK : C_DQ) + c8; float x[8]; unpack8(*(const GAS u32x4*)p, x);
            float ss = 0.f;
#pragma unroll
            for (int e = 0; e < 8; ++e) ss += x[e] * x[e];
            ss = group_sum(ss, 8); const float rstd = rsqrtf(ss * (1.f / 64.f) + EPS); const int j8 = lane & 7;
#pragma unroll
            for (int e = 0; e < 8; ++e) x[e] = x[e] * rstd * qkg[qk * 64 + j8 * 8 + e];
            rope8(x, j8, t, rope);
            *(GAS u32x4*)p = pack8(x); }
        { const int j8 = lane & 7; gu16* p = pr + C_KR + j8 * 8; float x[8]; unpack8(*(const GAS u32x4*)p, x);
          float ss = 0.f;
#pragma unroll
          for (int e = 0; e < 8; ++e) ss += x[e] * x[e];
          ss = group_sum(ss, 8); const float rstd = rsqrtf(ss * (1.f / 64.f) + EPS);
#pragma unroll
          for (int e = 0; e < 8; ++e) x[e] = x[e] * rstd * kg[j8 * 8 + e];
          rope8(x, j8, t, rope);
          if (lane < 8) *(GAS u32x4*)p = pack8(x); }
    }
}

DI void p3_gates(const Ctx& F, int l) {
    const gu16* P = (const gu16*)(F.ws + WS_P);
    gf32* BGp = (gf32*)(F.ws + WS_BG); gf32* SC = (gf32*)(F.ws + WS_SCAL);
    LAS float* af = (LAS float*)F.lds;
    LAS float* gi = af + 64 * 32;
    int tz = (int)threadIdx.x; asm volatile("" : "+v"(tz));
    const int tid = tz;
    const int dir = tid >> 8, col = tid & 255;
    float aw[16];
#pragma unroll
    for (int r = 0; r < 16; ++r) aw[r] = FIN(14)[(((size_t)l * 2 + dir) * 16 + r) * 256 + col];
    const float ab = FIN(15)[((size_t)l * 2 + dir) * 256 + col];
    for (int ch = blockIdx.x; ch < MG / 64; ch += F.G) {
        const size_t r0 = (size_t)ch * 64;
        __syncthreads();
        if (tid < 256) { const int r = tid >> 2, q = tid & 3; float f[8]; unpack8(*(const GAS u32x4*)(P + (r0 + r) * NP + C_AF + q * 8), f);
#pragma unroll
            for (int e = 0; e < 8; ++e) af[r * 32 + q * 8 + e] = f[e]; }
        else if (tid < 384) { const int r = (tid - 256) >> 1, q = tid & 1; float f[8]; unpack8(*(const GAS u32x4*)(P + (r0 + r) * NP + C_IF + q * 8), f);
#pragma unroll
            for (int e = 0; e < 8; ++e) gi[r * 16 + q * 8 + e] = f[e]; }
        __syncthreads();
        { float run = 0.f; gf32* bo = BGp + ((size_t)dir * MG + r0) * 256 + col;
          for (int i = 0; i < 64; ++i) { const int tk = dir ? 63 - i : i; float x = ab;
#pragma unroll
              for (int r = 0; r < 16; ++r) x += af[tk * 32 + dir * 16 + r] * aw[r];
              run += logsig_f(x) * (1.f / 16.f); bo[(size_t)tk * 256] = run; } }
        if (tid < 8) { const int d2 = tid >> 2, h = tid & 3, g0 = d2 * 2;
            const float bi = FIN(21)[l * 16 + g0 * 4 + h], bf = FIN(21)[l * 16 + (g0 + 1) * 4 + h];
            float b = 0.f, pm = -3.0e38f;
            for (int i = 0; i < 64; ++i) { const int tk = d2 ? 63 - i : i;
                const float li = gi[tk * 16 + g0 * 4 + h] + bi, lfv = logsig_f(gi[tk * 16 + (g0 + 1) * 4 + h] + bf);
                b += lfv; const float a = li - b; pm = fmaxf(pm, a);
                *(GAS f32x4*)(SC + (((size_t)d2 * MG + r0 + tk) * 4 + h) * 4) = (f32x4){b, a, pm, 0.f}; } }
    }
}

DI void p3b_rows(const Ctx& F, int l) {
    const gu16* P = (const gu16*)(F.ws + WS_P); gu16* Q = (gu16*)(F.ws + WS_Q); gu16* KV = (gu16*)(F.ws + WS_KV);
    const gf32* rope = (const gf32*)(F.ws + WS_ROPE);
    const gf32* qg = FIN(12) + l * 192; const gf32* kg = FIN(13) + l * 192;
    int lz = ((int)threadIdx.x & 63); asm volatile("" : "+v"(lz));
    const int lane = lz, c8 = lane * 8;
    int row0 = blockIdx.x * 8 + F.wave; asm volatile("" : "+s"(row0));
    for (int row = row0; row < MG; row += F.G * 8) {
        const int t = row % TT; const gu16* pr = P + (size_t)row * NP;
        float ss = 0.f;
        if (lane < 48) { float x[8]; unpack8(*(const GAS u32x4*)(pr + C_CQ + c8), x);
#pragma unroll
            for (int e = 0; e < 8; ++e) ss += x[e] * x[e]; }
        const float rq = rsqrtf(wave_sum(ss) * (1.f / 384.f) + EPS);
        ss = 0.f;
        if (lane < 32) { float x[8]; unpack8(*(const GAS u32x4*)(pr + C_CKV + c8), x);
#pragma unroll
            for (int e = 0; e < 8; ++e) ss += x[e] * x[e]; }
        const float rk = rsqrtf(wave_sum(ss) * (1.f / 256.f) + EPS);
        { gu16* p = Q + (size_t)row * 768 + c8; float x[8]; unpack8(*(const GAS u32x4*)p, x); float s2 = 0.f;
#pragma unroll
          for (int e = 0; e < 8; ++e) { x[e] *= rq; s2 += x[e] * x[e]; }
          s2 = group_sum(s2, 16); const float rs = rsqrtf(s2 * (1.f / 128.f) + EPS); const int d0 = (lane & 15) * 8;
#pragma unroll
          for (int e = 0; e < 8; ++e) x[e] = x[e] * rs * qg[d0 + e];
          *(GAS u32x4*)p = pack8(x); }
        { const int l32 = lane & 31; gu16* p = Q + (size_t)row * 768 + 512 + l32 * 8; float x[8]; unpack8(*(const GAS u32x4*)p, x); float s2 = 0.f;
#pragma unroll
          for (int e = 0; e < 8; ++e) { x[e] *= rq; s2 += x[e] * x[e]; }
          s2 = group_sum(s2, 8); const float rs = rsqrtf(s2 * (1.f / 64.f) + EPS); const int j8 = lane & 7;
#pragma unroll
          for (int e = 0; e < 8; ++e) x[e] = x[e] * rs * qg[128 + j8 * 8 + e];
          rope8(x, j8, t, rope);
          if (lane < 32) *(GAS u32x4*)p = pack8(x); }
        { gu16* p = KV + (size_t)row * 1024 + c8; float x[8]; unpack8(*(const GAS u32x4*)p, x); float s2 = 0.f;
#pragma unroll
          for (int e = 0; e < 8; ++e) { x[e] *= rk; s2 += x[e] * x[e]; }
          s2 = group_sum(s2, 16); const float rs = rsqrtf(s2 * (1.f / 128.f) + EPS); const int d0 = (lane & 15) * 8;
#pragma unroll
          for (int e = 0; e < 8; ++e) x[e] = x[e] * rs * kg[d0 + e];
          *(GAS u32x4*)p = pack8(x); }
        { gu16* p = KV + (size_t)row * 1024 + 512 + c8; float x[8]; unpack8(*(const GAS u32x4*)p, x);
#pragma unroll
          for (int e = 0; e < 8; ++e) x[e] *= rk;
          *(GAS u32x4*)p = pack8(x); }
    }
}
constexpr int AT_KN = 16384, AT_KR = 8192, AT_V = 16384;
constexpr int AT_BUF = AT_V + AT_KN + AT_KR;
constexpr int AT_WS = 2 * AT_BUF;
template <int MODE>
DI void attn_unit(const Ctx& F, int l, int bl, int h, int q0, int nkeys) {
    int tz = (int)threadIdx.x; asm volatile("" : "+v"(tz));
    const int tid = tz, wid = F.wave, lane = tz & 63;
    LAS unsigned char* lds = F.lds;
    const gu16* P = (const gu16*)(F.ws + WS_P); const gu16* Qb = (const gu16*)(F.ws + WS_Q); const gu16* KVb = (const gu16*)(F.ws + WS_KV);
    const size_t rb = (size_t)bl * TT;
    constexpr int NDQ = MODE == 0 ? 12 : 4;
    const float SC = MODE == 0 ? 0.07216878364870322f : 0.125f;
    const float C = SC * 1.4426950408889634f;
    LAS float* wsf = (LAS float*)(lds + AT_WS) + wid * 64;
    const int r32 = lane & 31, hi = lane >> 5;
    const int qrow = q0 + (MODE == 0 ? wid * 32 : (wid & 3) * 32) + r32;
    bf16x8 qr[NDQ];
    if constexpr (MODE == 0) { const gu16* qp = Qb + (rb + qrow) * 768;
#pragma unroll
        for (int d0 = 0; d0 < 8; ++d0) qr[d0] = *(const GAS bf16x8*)(qp + h * 128 + d0 * 16 + hi * 8);
#pragma unroll
        for (int d0 = 0; d0 < 4; ++d0) qr[8 + d0] = *(const GAS bf16x8*)(qp + 512 + h * 64 + d0 * 16 + hi * 8);
    } else { const gu16* qp = P + (rb + qrow) * NP + C_DQ + h * 128 + (wid >> 2) * 64;
#pragma unroll
        for (int d0 = 0; d0 < 4; ++d0) qr[d0] = *(const GAS bf16x8*)(qp + d0 * 16 + hi * 8); }
    const int sr = tid >> 4, sc = (tid & 15) * 8, vst0 = v_st(sr, sc), vst1 = v_st(32 + sr, sc);
    const int kr_r = tid >> 3, kr_c = (tid & 7) * 8;
    const gu16* kbase; const gu16* vbase; size_t kld;
    if (MODE == 0) { kbase = KVb + rb * 1024 + h * 128; vbase = KVb + rb * 1024 + 512 + h * 128; kld = 1024; }
    else { kbase = P + rb * NP + C_DK + h * 128; vbase = P + rb * NP + C_DV + h * 128; kld = NP; }
    const gu16* krbase = P + rb * NP + C_KR;
    u32x4 sv0, sv1, sk0, sk1, skr;
#define SLOAD(k0) do { sv0 = *(const GAS u32x4*)(vbase + (size_t)((k0) + sr) * kld + sc); sv1 = *(const GAS u32x4*)(vbase + (size_t)((k0) + 32 + sr) * kld + sc); \
        sk0 = *(const GAS u32x4*)(kbase + (size_t)((k0) + sr) * kld + sc); sk1 = *(const GAS u32x4*)(kbase + (size_t)((k0) + 32 + sr) * kld + sc); \
        if (MODE == 0) skr = *(const GAS u32x4*)(krbase + (size_t)((k0) + kr_r) * NP + kr_c); } while (0)
#define SWRITE(b) do { LAS unsigned char* bb = lds + (b) * AT_BUF; *(LAS u32x4*)(bb + vst0) = sv0; *(LAS u32x4*)(bb + vst1) = sv1; \
        *(LAS u32x4*)(bb + AT_V + kswz(sr, sc * 2)) = sk0; *(LAS u32x4*)(bb + AT_V + kswz(32 + sr, sc * 2)) = sk1; \
        if (MODE == 0) *(LAS u32x4*)(bb + AT_V + AT_KN + swz64(kr_r, kr_c * 2)) = skr; } while (0)
    float m_reg = -1e30f, l_reg = 0.f; f32x16 o[4];
#pragma unroll
    for (int d = 0; d < 4; ++d)
#pragma unroll
        for (int r = 0; r < 16; ++r) o[d][r] = 0.f;
    const int NT = nkeys / 64;
    const int vrb = (int)(uintptr_t)lds + v_rd_base(lane);
    const int kcol0 = (MODE == 1) ? (wid >> 2) * 128 : 0;
    SLOAD(0); SWRITE(0); if (NT > 1) SLOAD(64); __syncthreads();
    for (int j = 0; j < NT; ++j) {
        const int cur = j & 1;
        f32x16 p0, p1;
#pragma unroll
        for (int r = 0; r < 16; ++r) { p0[r] = 0.f; p1[r] = 0.f; }
        { const LAS unsigned char* kb = lds + cur * AT_BUF + AT_V;
#pragma unroll
          for (int d0 = 0; d0 < (MODE == 0 ? 8 : 4); ++d0) { const int cb = kcol0 + (d0 * 16 + hi * 8) * 2;
              const bf16x8 b0 = ldsv(kb + kswz(r32, cb)), b1 = ldsv(kb + kswz(32 + r32, cb));
              p0 = MFMA32(b0, qr[d0], p0); p1 = MFMA32(b1, qr[d0], p1); }
          if constexpr (MODE == 0) {
#pragma unroll
              for (int d0 = 0; d0 < 4; ++d0) { const int cb = (d0 * 16 + hi * 8) * 2;
                  const bf16x8 b0 = ldsv(kb + AT_KN + swz64(r32, cb)), b1 = ldsv(kb + AT_KN + swz64(32 + r32, cb));
                  p0 = MFMA32(b0, qr[8 + d0], p0); p1 = MFMA32(b1, qr[8 + d0], p1); } } }
        if (j + 1 < NT) SWRITE(cur ^ 1);
        SBAR();
        float pmax = p0[0];
#pragma unroll
        for (int r = 1; r < 16; ++r) pmax = fmaxf(pmax, p0[r]);
#pragma unroll
        for (int r = 0; r < 16; ++r) pmax = fmaxf(pmax, p1[r]);
        pmax = half_swap_max(pmax);
        const float mn = fmaxf(m_reg, pmax), alpha = __builtin_amdgcn_exp2f((m_reg - mn) * C); m_reg = mn;
        const float mnC = -mn * C; float ps = 0.f;
#pragma unroll
        for (int r = 0; r < 16; ++r) { p0[r] = __builtin_amdgcn_exp2f(fmaf(p0[r], C, mnC)); ps += p0[r]; }
#pragma unroll
        for (int r = 0; r < 16; ++r) { p1[r] = __builtin_amdgcn_exp2f(fmaf(p1[r], C, mnC)); ps += p1[r]; }
        ps = half_swap_sum(ps);
        l_reg = l_reg * alpha + ps;
        bf16x8 pa[4]; p_to_afrag(p0, p1, pa);
        SBAR();
        if (j + 2 < NT) SLOAD((j + 2) * 64);
        if (__any(alpha < 1.f)) { if (hi == 0) wsf[r32] = alpha; asm volatile("s_waitcnt lgkmcnt(0)" ::: "memory");
#pragma unroll
            for (int r = 0; r < 16; ++r) { const float a = wsf[crow(r, hi)];
#pragma unroll
                for (int d = 0; d < 4; ++d) o[d][r] *= a; } }
#pragma unroll
        for (int d0 = 0; d0 < 4; ++d0) { bf16x8 vf[4]; v_frags(vrb + cur * AT_BUF + d0 * 512, vf);
#pragma unroll
            for (int ks = 0; ks < 4; ++ks) o[d0] = MFMA32(pa[ks], vf[ks], o[d0]); }
        __syncthreads();
    }
#undef SLOAD
#undef SWRITE
    int lz = lane; asm volatile("" : "+v"(lz));
    const int er = lz & 31, eh = lz >> 5;
    if (eh == 0) wsf[er] = l_reg; asm volatile("s_waitcnt lgkmcnt(0)" ::: "memory");
    float rli[16];
#pragma unroll
    for (int r = 0; r < 16; ++r) rli[r] = __builtin_amdgcn_rcpf(wsf[crow(r, eh)]);
    if constexpr (MODE == 0) {
        gu16* Y = (gu16*)(F.ws + WS_Y);
        const size_t row0 = rb + q0 + wid * 32;
#pragma unroll
        for (int r = 0; r < 16; ++r) { const size_t row = row0 + crow(r, eh);
#pragma unroll
            for (int d0 = 0; d0 < 4; ++d0) { const int col = h * 128 + d0 * 32 + er;
                const float z = bf2f(P[row * NP + C_MZ + col]);
                Y[row * 512 + col] = f2bf(o[d0][r] * rli[r] * z); } }
    } else {
        LAS float* ex = (LAS float*)lds;
        const int lr0 = (wid & 3) * 32;
        if (wid >= 4) {
#pragma unroll
            for (int r = 0; r < 16; ++r)
#pragma unroll
                for (int d0 = 0; d0 < 4; ++d0) ex[(lr0 + crow(r, eh)) * 128 + d0 * 32 + er] = o[d0][r] * rli[r];
        }
        __syncthreads();
        if (wid < 4) {
            const float lam = ((const gf32*)(F.ws + WS_LAM))[l];
            const float lam_init = 0.8f - 0.6f * __expf(-0.3f * (float)l);
            const gf32* og = FIN(26) + l * 128;
            gu16* Y = (gu16*)(F.ws + WS_Y) + (size_t)3 * MG * 512;
            const size_t row0 = rb + q0 + lr0;
            float gg[4];
#pragma unroll
            for (int d0 = 0; d0 < 4; ++d0) gg[d0] = og[d0 * 32 + er] * (1.f - lam_init);
#pragma unroll
            for (int r = 0; r < 16; ++r) { const int lr = lr0 + crow(r, eh); float v[4]; float ss = 0.f;
#pragma unroll
                for (int d0 = 0; d0 < 4; ++d0) { v[d0] = o[d0][r] * rli[r] - lam * ex[lr * 128 + d0 * 32 + er]; ss += v[d0] * v[d0]; }
                ss += __shfl_xor(ss, 1); ss += __shfl_xor(ss, 2); ss += __shfl_xor(ss, 4); ss += __shfl_xor(ss, 8); ss += __shfl_xor(ss, 16);
                const float rs = rsqrtf(ss * (1.f / 128.f) + EPS); const size_t row = row0 + crow(r, eh);
#pragma unroll
                for (int d0 = 0; d0 < 4; ++d0) { const int col = h * 128 + d0 * 32 + er;
                    const float z = bf2f(P[row * NP + C_DZ + col]);
                    Y[row * 512 + col] = f2bf(v[d0] * rs * gg[d0] * z); } }
        }
        __syncthreads();
    }
}
constexpr int SC_DIR = 40960;
constexpr int SC_QB = 0, SC_KA = 8192, SC_KT = 16384, SC_VI = 24576;
constexpr int SC_ST = 2 * SC_DIR;
constexpr int SC_SCL = SC_ST + 8 * 4096;
template <int MIX>
DI void scan_unit(const Ctx& F, int l, int bl, int h) {
    int tz = (int)threadIdx.x; asm volatile("" : "+v"(tz));
    const int tid = tz, wid = F.wave, lane = tz & 63;
    const int dir = wid >> 2, w4 = wid & 3, tl = tid & 255;
    LAS unsigned char* lds = F.lds;
    LAS unsigned char* db = lds + dir * SC_DIR;
    LAS unsigned char* stp = lds + SC_ST + wid * 4096;
    LAS float* scl = (LAS float*)(lds + SC_SCL + dir * 2048);
    LAS float* xch = scl + 256 + w4 * 32;
    const gu16* P = (const gu16*)(F.ws + WS_P);
    const size_t rb = (size_t)bl * TT;
    gu16* osc = (gu16*)(F.ws + WS_OSC) + ((size_t)(MIX * 2 + dir) * MG) * 512;
    for (int e = lane; e < 1024; e += 64) ((LAS unsigned*)stp)[e] = 0u;
    if (tid < 128) { const int d2 = tid >> 6; ((LAS float*)(lds + SC_SCL + d2 * 2048))[192 + (tid & 63)] = 0.f; }
    f32x16 S[2];
#pragma unroll
    for (int k = 0; k < 2; ++k)
#pragma unroll
        for (int r = 0; r < 16; ++r) S[k][r] = 0.f;
    float m_run = 0.f;
    const int pi = tl >> 2, pd0 = (tl & 3) * 16;
    const int vr = tl >> 4, vc = (tl & 15) * 8;
    const int vrb = (int)(uintptr_t)db + SC_VI + v_rd_base(lane) + w4 * 512;
    u32x4 rq[2], rk[2]; f32x4 rb4[4], rl4[1];
#define TOK(c, i) (dir == 0 ? (c) * 64 + (i) : ((c) < 4 ? (3 - (c)) : (39 - (c))) * 64 + 63 - (i))
#define CLOAD(c) do { const size_t g = rb + TOK(c, pi), gl = rb + TOK(c, 63); \
        if (MIX == 0) { const gu16* qp = P + g * NP + C_GQ + h * 64 + pd0; rq[0] = *(const GAS u32x4*)qp; rq[1] = *(const GAS u32x4*)(qp + 8); \
            const gu16* kp = P + g * NP + C_GK + h * 64 + pd0; rk[0] = *(const GAS u32x4*)kp; rk[1] = *(const GAS u32x4*)(kp + 8); \
            const gf32* bp = (const gf32*)(F.ws + WS_BG) + ((size_t)dir * MG + g) * 256 + h * 64 + pd0; \
            _Pragma("unroll") for (int z = 0; z < 4; ++z) rb4[z] = *(const GAS f32x4*)(bp + 4 * z); \
        } else { const gu16* qp = (const gu16*)(F.ws + WS_QKML) + g * 512 + h * 64 + pd0; rq[0] = *(const GAS u32x4*)qp; rq[1] = *(const GAS u32x4*)(qp + 8); \
            rk[0] = *(const GAS u32x4*)(qp + 256); rk[1] = *(const GAS u32x4*)(qp + 264); \
            rb4[0] = *(const GAS f32x4*)((const gf32*)(F.ws + WS_SCAL) + (((size_t)dir * MG + g) * 4 + h) * 4); rl4[0] = *(const GAS f32x4*)((const gf32*)(F.ws + WS_SCAL) + (((size_t)dir * MG + gl) * 4 + h) * 4); } } while (0)
    CLOAD(0);
    __syncthreads();
    for (int c = 0; c < 36; ++c) {
        float m_new = 0.f, decay = 1.f, M63 = 0.f;
#ifndef REP_SPREP
#define REP_SPREP 1
#endif
#ifndef REP_SQB
#define REP_SQB 1
#endif
        _Pragma("nounroll") for (int rep = 0; rep < REP_SPREP; ++rep) {
        u32x4 rv[4];
#pragma unroll
        for (int z = 0; z < 4; ++z) rv[z] = *(const GAS u32x4*)(P + (rb + TOK(c, vr + 16 * z)) * NP + (MIX == 0 ? C_GV : C_MV) + h * 128 + vc);
        { float q[16], k[16]; unpack8(rq[0], q); unpack8(rq[1], q + 8); unpack8(rk[0], k); unpack8(rk[1], k + 8);
          float qe[16], ke[16], kt[16];
          if (MIX == 0) {
#pragma unroll
              for (int e = 0; e < 16; ++e) { const float bb = rb4[e >> 2][e & 3];
                  qe[e] = q[e] * __expf(bb); ke[e] = k[e] * __expf(-bb); kt[e] = ke[e]; }
              if (pi == 63) {
#pragma unroll
                  for (int e = 0; e < 16; ++e) scl[pd0 + e] = __expf(rb4[e >> 2][e & 3]); }
          } else {
              const float b_i = rb4[0][0], a_i = rb4[0][1], pm_i = rb4[0][2], bL = rl4[0][0], pmL = rl4[0][2];
              M63 = fmaxf(m_run, pmL); m_new = bL + M63; decay = __expf(m_run - M63);
              const float wu = __expf(a_i - M63);
#pragma unroll
              for (int e = 0; e < 16; ++e) { qe[e] = q[e]; ke[e] = k[e]; kt[e] = k[e] * wu; }
              float qn = 0.f;
#pragma unroll
              for (int e = 0; e < 16; ++e) qn += q[e] * scl[192 + pd0 + e];
              qn += __shfl_xor(qn, 1); qn += __shfl_xor(qn, 2);
              if ((tl & 3) == 0) { scl[pi] = b_i; scl[64 + pi] = a_i; scl[128 + pi] = pm_i; scl[384 + pi] = qn; }
          }
          *(LAS u32x4*)(db + SC_QB + swz64(pi, pd0 * 2)) = pack8(qe); *(LAS u32x4*)(db + SC_QB + swz64(pi, pd0 * 2 + 16)) = pack8(qe + 8);
          *(LAS u32x4*)(db + SC_KA + swz64(pi, pd0 * 2)) = pack8(ke); *(LAS u32x4*)(db + SC_KA + swz64(pi, pd0 * 2 + 16)) = pack8(ke + 8);
#pragma unroll
          for (int e = 0; e < 16; ++e) *(LAS u16*)(db + SC_KT + swz64(pd0 + e, pi * 2)) = f2bf(kt[e]);
        }
#pragma unroll
        for (int z = 0; z < 4; ++z) *(LAS u32x4*)(db + SC_VI + v_st(vr + 16 * z, vc)) = rv[z];
        }
        if (c + 1 < 36) CLOAD(c + 1);
        __syncthreads();
        int lz = lane; asm volatile("" : "+v"(lz));
        const int r32 = lz & 31, hi = lz >> 5;
        bf16x8 bs[4];
#pragma unroll
        for (int ks = 0; ks < 4; ++ks) bs[ks] = ldsv(stp + swz64(r32, (ks * 16 + hi * 8) * 2));
        bf16x8 vf[4]; v_frags(vrb, vf);
#pragma nounroll
        for (int qb2 = 0; qb2 < 2 * REP_SQB; ++qb2) { const int qb = qb2 & 1;
            bf16x8 qf[4];
#pragma unroll
            for (int ks = 0; ks < 4; ++ks) qf[ks] = ldsv(db + SC_QB + qb * 4096 + swz64(r32, (ks * 16 + hi * 8) * 2));
            f32x16 o;
#pragma unroll
            for (int r = 0; r < 16; ++r) o[r] = 0.f;
#pragma unroll
            for (int ks = 0; ks < 4; ++ks) o = MFMA32(qf[ks], bs[ks], o);
            const int qi = 32 * qb + r32;
            float scale_q = 1.f, rs = 0.f;
            const float Mq = (MIX == 1) ? fmaxf(m_run, scl[128 + qi]) : 0.f;
            bf16x8 pa[4];
#pragma unroll
            for (int kh = 0; kh < 2; ++kh) {
                f32x16 p;
#pragma unroll
                for (int r = 0; r < 16; ++r) p[r] = 0.f;
#pragma unroll
                for (int ks = 0; ks < 4; ++ks) p = MFMA32(ldsv(db + SC_KA + kh * 4096 + swz64(r32, (ks * 16 + hi * 8) * 2)), qf[ks], p);
                if (MIX == 0) {
#pragma unroll
                    for (int r = 0; r < 16; ++r) p[r] = (crow(r, hi) + 32 * kh <= qi) ? p[r] : 0.f;
                } else {
#pragma unroll
                    for (int r = 0; r < 16; ++r) { const int kk = crow(r, hi) + 32 * kh; p[r] = (kk <= qi) ? p[r] * __expf(scl[64 + kk] - Mq) : 0.f; rs += p[r]; }
                }
                if (kh == 0) p_half_to_afrag(p, pa[0], pa[1]); else p_half_to_afrag(p, pa[2], pa[3]);
            }
            if (MIX == 1) {
                rs = half_swap_sum(rs);
                const float iw = __expf(m_run - Mq), den = iw * scl[384 + qi] + rs, mi = scl[qi] + Mq;
                scale_q = 1.f / fmaxf(fabsf(den), __expf(-mi));
#pragma unroll
                for (int r = 0; r < 16; ++r) o[r] *= __expf(m_run - fmaxf(m_run, scl[128 + 32 * qb + crow(r, hi)]));
            }
#pragma unroll
            for (int ks = 0; ks < 4; ++ks) o = MFMA32(pa[ks], vf[ks], o);
            if (MIX == 1) {
                if (hi == 0) xch[r32] = scale_q;
                asm volatile("s_waitcnt lgkmcnt(0)" ::: "memory");
#pragma unroll
                for (int r = 0; r < 16; ++r) o[r] *= xch[crow(r, hi)];
            }
#pragma unroll
            for (int r = 0; r < 16; ++r) { const int qq = 32 * qb + crow(r, hi); osc[(rb + TOK(c, qq)) * 512 + h * 128 + w4 * 32 + r32] = f2bf(o[r]); }
        }
        float nnew = 0.f;
#pragma unroll
        for (int dk = 0; dk < 2; ++dk) {
            if (MIX == 1) {
#pragma unroll
                for (int r = 0; r < 16; ++r) S[dk][r] *= decay;
            }
#pragma unroll
            for (int ks = 0; ks < 4; ++ks) { const bf16x8 a = ldsv(db + SC_KT + swz64(32 * dk + r32, (ks * 16 + hi * 8) * 2)); S[dk] = MFMA32(a, vf[ks], S[dk]); }
            if (MIX == 0) {
#pragma unroll
                for (int r = 0; r < 16; ++r) S[dk][r] *= scl[32 * dk + crow(r, hi)];
            }
        }
        if (MIX == 1 && w4 == 0) {
            float sum = 0.f;
#pragma unroll
            for (int j = 0; j < 8; ++j) { float kv[8]; unpack8(__builtin_bit_cast(u32x4, ldsv(db + SC_KT + swz64(lane, j * 16))), kv);
#pragma unroll
                for (int e = 0; e < 8; ++e) sum += kv[e]; }
            nnew = decay * scl[192 + lane] + sum;
            scl[192 + lane] = nnew;
        }
#pragma unroll
        for (int dk = 0; dk < 2; ++dk)
#pragma unroll
            for (int g4 = 0; g4 < 4; ++g4) { u32x2 w; w.x = pk2(S[dk][4 * g4], S[dk][4 * g4 + 1]); w.y = pk2(S[dk][4 * g4 + 2], S[dk][4 * g4 + 3]);
                *(LAS u32x2*)(stp + swz64(r32, (32 * dk + 8 * g4 + 4 * hi) * 2)) = w; }
        if (MIX == 1) m_run = m_new;
        __syncthreads();
    }
#undef CLOAD
    asm volatile("s_waitcnt vmcnt(0)" ::: "memory");
    __syncthreads();
    {
        const gu16* of = (const gu16*)(F.ws + WS_OSC) + ((size_t)(MIX * 2 + 0) * MG) * 512;
        const gu16* ob = (const gu16*)(F.ws + WS_OSC) + ((size_t)(MIX * 2 + 1) * MG) * 512;
        gu16* Y = (gu16*)(F.ws + WS_Y) + (size_t)(MIX == 0 ? 1 : 2) * MG * 512;
        const gf32* og = (MIX == 0 ? FIN(16) : FIN(22)) + l * 512 + h * 128;
        const gf32* skp = FIN(23) + l * 512 + h * 128;
        const gu16* XC = (const gu16*)(F.ws + WS_XC);
        int tq = (int)threadIdx.x; asm volatile("" : "+v"(tq));
        const int c8 = (tq & 15) * 8;
        float g8[8], s8[8];
#pragma unroll
        for (int e = 0; e < 8; ++e) { g8[e] = og[c8 + e]; s8[e] = (MIX == 1) ? skp[c8 + e] : 0.f; }
        for (int t = tq >> 4; t < TT; t += 32) {
            const size_t row = rb + t; const int col = h * 128 + c8;
            float a[8], b[8], v[8]; unpack8(*(const GAS u32x4*)(of + row * 512 + col), a); unpack8(*(const GAS u32x4*)(ob + row * 512 + col), b);
            float ss = 0.f;
            if (MIX == 1) { float og8[8]; unpack8(*(const GAS u32x4*)(P + row * NP + C_MO + col), og8);
#pragma unroll
                for (int e = 0; e < 8; ++e) { v[e] = (a[e] + b[e]) * og8[e]; ss += v[e] * v[e]; }
            } else {
#pragma unroll
                for (int e = 0; e < 8; ++e) { v[e] = a[e] + b[e]; ss += v[e] * v[e]; } }
            ss = group_sum(ss, 16);
            const float rs = rsqrtf(ss * (1.f / 128.f) + EPS);
            float z[8]; unpack8(*(const GAS u32x4*)(P + row * NP + (MIX == 0 ? C_GZ : C_MLZ) + col), z);
            if (MIX == 1) { float xc[8]; unpack8(*(const GAS u32x4*)(XC + row * 512 + col), xc);
#pragma unroll
                for (int e = 0; e < 8; ++e) v[e] = (v[e] * rs * g8[e] + s8[e] * xc[e]) * z[e];
            } else {
#pragma unroll
                for (int e = 0; e < 8; ++e) v[e] = v[e] * rs * g8[e] * z[e]; }
            *(GAS u32x4*)(Y + row * 512 + col) = pack8(v);
        }
    }
    __syncthreads();
#undef TOK
}
DI void p4_mixers(const Ctx& F, int l, int it) {
    const bool last = (l == DEPTH - 1);
    constexpr int N_SCAN = 2 * BGR * 4, N_MLA = BGR * 4 * 8, N_DF = BGR * 4 * 16, N_MLAC = BGR * 4, N_DFC = BGR * 4 * 2;
    constexpr int O_MLA = N_SCAN, O_DF = O_MLA + N_MLA, O_MLAC = O_DF + N_DF, O_DFC = O_MLAC + N_MLAC, N_ALL = O_DFC + N_DFC;
    const int total = last ? O_MLAC : N_ALL;
    GAS unsigned* head = F.ctl + CW_QUEUE + 64 * it;
    volatile LAS unsigned* misc = (volatile LAS unsigned*)(F.lds + LDS_MISC);
    for (;;) {
        __syncthreads();
        if ((int)threadIdx.x == 0) misc[0] = __hip_atomic_fetch_add(head, 1u, __ATOMIC_RELAXED, __HIP_MEMORY_SCOPE_AGENT);
        __syncthreads();
        const int u = (int)misc[0];
        if (u >= total) break;
#ifndef P4_MASK
#define P4_MASK 0xf
#endif
#ifndef REP_SCAN
#define REP_SCAN 1
#endif
#ifndef REP_MLA
#define REP_MLA 1
#endif
#ifndef REP_DF
#define REP_DF 1
#endif
        if (u < O_MLA) { const int mix = u >> 5, rem = u & 31, bl = rem >> 2, h = rem & 3;
            _Pragma("nounroll") for (int rep = 0; rep < REP_SCAN; ++rep) { if (mix == 0) { if (P4_MASK & 1) scan_unit<0>(F, l, bl, h); } else { if (P4_MASK & 2) scan_unit<1>(F, l, bl, h); } __syncthreads(); } }
        else if (u < O_DF) { const int v = u - O_MLA, bl = v >> 5, h = (v >> 3) & 3, qb = v & 7; _Pragma("nounroll") for (int rep = 0; rep < REP_MLA; ++rep) { if (P4_MASK & 4) attn_unit<0>(F, l, bl, h, NCTX + qb * 256, TT); __syncthreads(); } }
        else if (u < O_MLAC) { const int v = u - O_DF, bl = v >> 6, h = (v >> 4) & 3, qb = v & 15; _Pragma("nounroll") for (int rep = 0; rep < REP_DF; ++rep) { if (P4_MASK & 8) attn_unit<1>(F, l, bl, h, NCTX + qb * 128, TT); __syncthreads(); } }
        else if (u < O_DFC) { const int v = u - O_MLAC, bl = v >> 2, h = v & 3; if (P4_MASK & 4) attn_unit<0>(F, l, bl, h, 0, NCTX); }
        else { const int v = u - O_DFC, bl = v >> 3, h = (v >> 1) & 3, qb = v & 1; if (P4_MASK & 8) attn_unit<1>(F, l, bl, h, qb * 128, NCTX); }
    }
}

__global__ void __launch_bounds__(512, 2) fwd_kernel(Params prm) {
    extern __shared__ __attribute__((aligned(16))) unsigned char lds_raw[];
    Ctx F;
    F.in = prm.in;
    F.out = (gf32*)prm.out; F.ws = (gu8*)prm.ws; F.ctl = (GAS unsigned*)prm.ws;
    F.wave = __builtin_amdgcn_readfirstlane((int)threadIdx.x >> 6); F.G = gridDim.x;
    F.lds = (LAS unsigned char*)lds_raw;
    if ((int)threadIdx.x < 16) ((LAS unsigned*)(F.lds + LDS_MISC))[(int)threadIdx.x] = 0u;
    __syncthreads();
    XcdBarrier bar = xcd_barrier_post(F.ctl, (volatile LAS unsigned*)(F.lds + LDS_BARW));
    const int s_lo = prm.s_lo, s_hi = prm.s_hi;
#ifndef PH_MASK
#define PH_MASK 0xff
#endif
#define IN(s) (s_lo <= (s) && (s) < s_hi)
#define PHON(k) ((PH_MASK >> (k)) & 1)
#ifndef REP_P1
#define REP_P1 1
#endif
#ifndef REP_P2
#define REP_P2 1
#endif
#ifndef REP_P3G
#define REP_P3G 1
#endif
#ifndef REP_P3BG
#define REP_P3BG 1
#endif
#ifndef REP_P5
#define REP_P5 1
#endif
#ifndef REP_GATES
#define REP_GATES 1
#endif
#define FRESH() do { unsigned char* w_ = prm.ws; float* o_ = prm.out; asm volatile("" : "+s"(w_), "+s"(o_)); F.ws = (gu8*)w_; F.ctl = (GAS unsigned*)w_; F.out = (gf32*)o_; } while (0)
#define SEAM(s) do { if ((s) + 1 < s_hi) { XcdBarrier b_ = bar; asm volatile("" : "+s"(b_.bar)); xcd_barrier(b_); } } while (0)
    if (PHON(0) && IN(0)) { FRESH(); p0_prologue(F); SEAM(0); }
    for (int it = 0; it < DEPTH * NGRP; ++it) {
        const int l = it / NGRP, g = it % NGRP, sb = 1 + it * 7;
        if (sb + 7 <= s_lo || sb >= s_hi) continue;
        if (PHON(1) && IN(sb + 0)) { FRESH(); _Pragma("nounroll") for (int rep = 0; rep < REP_P1; ++rep) p1_norm(F, l, g); SEAM(sb + 0); }
        if (PHON(2) && IN(sb + 1)) {
            FRESH(); gu16* Pb = (gu16*)(F.ws + WS_P);
            pg8::Gemm gm{(const gu16*)(F.ws + WS_H), (const gu16*)(F.ws + WS_WIN) + (size_t)l * NP * 1024, MG, NP, 1024, 1024};
            pg8::StaticOrder S; S.init(MG, NP, F.G, (int)blockIdx.x);
            EpiBf E{Pb, NP, 1};
            _Pragma("nounroll") for (int rep = 0; rep < REP_P2; ++rep) pg8::gemm_phase<EpiBf, pg8::StaticOrder, true, true>(F.lds, gm, S, E);
            SEAM(sb + 1);
        }
        if (PHON(3) && IN(sb + 2)) {
            FRESH(); gu16* Pb = (gu16*)(F.ws + WS_P);
            _Pragma("nounroll") for (int rep = 0; rep < REP_P3G; ++rep) {
            { pg8::Gemm gm{Pb + C_CQ, (const gu16*)(F.ws + WS_WUQ) + (size_t)l * 768 * 384, MG, 768, 384, NP};
              pg8::StaticOrder S; S.init(MG, 768, F.G, (int)blockIdx.x);
              EpiBf E{(gu16*)(F.ws + WS_Q), 768, 0};
              pg8::gemm_phase<EpiBf, pg8::StaticOrder, true, true>(F.lds, gm, S, E); }
            { pg8::Gemm gm{Pb + C_CKV, (const gu16*)(F.ws + WS_WUKV) + (size_t)l * 1024 * 256, MG, 1024, 256, NP};
              int c2 = (int)blockIdx.x + 40; if (c2 >= F.G) c2 -= F.G;
              pg8::StaticOrder S; S.init(MG, 1024, F.G, c2);
              EpiBf E{(gu16*)(F.ws + WS_KV), 1024, 0};
              pg8::gemm_phase<EpiBf, pg8::StaticOrder, true, true>(F.lds, gm, S, E); }
            }
            __syncthreads();
            p3_rows(F, l);
            _Pragma("nounroll") for (int rep = 0; rep < REP_GATES; ++rep) p3_gates(F, l);
            SEAM(sb + 2);
        }
        if (PHON(4) && IN(sb + 3)) {
            FRESH();
            p3b_rows(F, l);
            _Pragma("nounroll") for (int rep = 0; rep < REP_P3BG; ++rep)
            { pg8::Gemm gm{(const gu16*)(F.ws + WS_XC), (const gu16*)(F.ws + WS_WQK) + (size_t)l * 512 * 512, MG, 512, 512, 512};
              pg8::StaticOrder S; S.init(MG, 512, F.G, (int)blockIdx.x);
              EpiBf E{(gu16*)(F.ws + WS_QKML), 512, 0};
              pg8::gemm_phase<EpiBf, pg8::StaticOrder, true, true>(F.lds, gm, S, E); }
            SEAM(sb + 3);
        }
        if (PHON(5) && IN(sb + 4)) { FRESH(); p4_mixers(F, l, it); SEAM(sb + 4); }
        if (PHON(6) && IN(sb + 5)) {
            FRESH(); gu16* Pb = (gu16*)(F.ws + WS_P);
#pragma nounroll
            for (int i4 = 0; i4 < 4 * REP_P5; ++i4) { const int i = i4 & 3;
                pg8::Gemm gm{(const gu16*)(F.ws + WS_Y) + (size_t)i * MG * 512, (const gu16*)(F.ws + WS_BR) + ((size_t)l * 4 + i) * 1024 * 512, MG, 1024, 512, 512};
                pg8::StaticOrder S; S.init(MG, 1024, F.G, (int)blockIdx.x);
                EpiMerge E{(gf32*)(F.ws + WS_MF), (gu16*)(F.ws + WS_MB), Pb + C_MG + i * 1024, i == 0 ? 0 : (i == 3 ? 2 : 1)};
                pg8::gemm_phase<EpiMerge, pg8::StaticOrder, true, true>(F.lds, gm, S, E);
            }
            SEAM(sb + 5);
        }
        if (PHON(7) && IN(sb + 6)) {
            FRESH();
            pg8::Gemm gm{(const gu16*)(F.ws + WS_MB), (const gu16*)(F.ws + WS_WO) + (size_t)l * 1024 * 1024, MG, 1024, 1024, 1024};
            pg8::StaticOrder S; S.init(MG, 1024, F.G, (int)blockIdx.x);
            EpiOut E{l == 0 ? FIN(0) : F.out, F.out, l == 0 ? FIN(2) : (const gf32*)(F.ws + WS_CTX), (gf32*)(F.ws + WS_CTX),
                     (const gf32*)(F.ws + WS_MOD) + (size_t)l * 33 * 3072, g, l == DEPTH - 1 ? 1 : 0};
            pg8::gemm_phase<EpiOut, pg8::StaticOrder, true, true>(F.lds, gm, S, E);
            SEAM(sb + 6);
        }
    }
#undef IN
#undef SEAM
}

extern "C" void kernel_launch(void* const* d_in, const int* in_sizes, int n_in, void* d_out, int out_size, void* d_ws, size_t ws_size, hipStream_t stream) {
    static int grid = 0;
    if (grid == 0) {
        if (n_in != 29 || out_size != NB * SEQ * DM || ws_size < WS_END) { fprintf(stderr, "kernel_launch: unexpected shapes (n_in %d, out %d, ws %zu < %zu)\n", n_in, out_size, ws_size, (size_t)WS_END); grid = -1; return; }
        int dev = 0, cus = 0, per_cu = 0;
        if (hipGetDevice(&dev) != hipSuccess || hipDeviceGetAttribute(&cus, hipDeviceAttributeMultiprocessorCount, dev) != hipSuccess) { grid = -1; return; }
        if (hipFuncSetAttribute((const void*)fwd_kernel, hipFuncAttributeMaxDynamicSharedMemorySize, LDS_BYTES) != hipSuccess) { fprintf(stderr, "kernel_launch: hipFuncSetAttribute failed\n"); grid = -1; return; }
        if (hipOccupancyMaxActiveBlocksPerMultiprocessor(&per_cu, (const void*)fwd_kernel, 512, LDS_BYTES) != hipSuccess || per_cu < 1) { fprintf(stderr, "kernel_launch: occupancy query reports %d blocks per CU\n", per_cu); }
        (void)hipGetLastError();
        grid = cus;
    }
    if (grid < 0) return;
    (void)hipMemsetAsync((char*)d_ws + WS_CTL, 0, CTL_BYTES, stream);
    Params p{};
    for (int i = 0; i < 29; ++i) p.in[i] = (const float*)d_in[i];
    p.out = (float*)d_out; p.ws = (unsigned char*)d_ws;
#if MK_MULTI
    for (int s = 0; s < NSTEP; ++s) { p.s_lo = s; p.s_hi = s + 1; hipLaunchKernelGGL(fwd_kernel, dim3(grid), dim3(512), LDS_BYTES, stream, p); }
#else
    p.s_lo = 0; p.s_hi = NSTEP;
    hipLaunchKernelGGL(fwd_kernel, dim3(grid), dim3(512), LDS_BYTES, stream, p);
#endif
    const hipError_t le = hipPeekAtLastError();
    if (le != hipSuccess) fprintf(stderr, "kernel_launch: launch failed: %s\n", hipGetErrorName(le));
}
```

```cpp
#include <hip/hip_runtime.h>
#include <cstdio>
#include <cstdint>
#include <cstddef>

#ifndef MK_MULTI
#define MK_MULTI 0
#endif

#define XB_TMO      128
#define XB_XCNT(j)  (256  + 64 * (j))
#define XB_XSUB(j)  (1280 + 64 * (j))
#define XB_XGEN(j)  (2304 + 64 * (j))
#define XB_TOP      3328
#define XB_TOPGEN   3392
#define XCD_BAR_WORDS 3456
#define XB_SPIN_CAP (1u << 18)
#define LAS __attribute__((address_space(3)))
#define XB_GAS __attribute__((address_space(1)))

__device__ __forceinline__ unsigned xb_ld(XB_GAS unsigned* p)              { return __hip_atomic_load(p, __ATOMIC_RELAXED, __HIP_MEMORY_SCOPE_AGENT); }
__device__ __forceinline__ unsigned xb_add(XB_GAS unsigned* p, unsigned v) { return __hip_atomic_fetch_add(p, v, __ATOMIC_RELAXED, __HIP_MEMORY_SCOPE_AGENT); }
__device__ __forceinline__ unsigned xb_xcc_id() { return (unsigned)__builtin_amdgcn_s_getreg((3 << 11) | 20) & 0xFu; }
#define XB_SPIN(cond, bar) do { unsigned _sp = 0; while (cond) { __builtin_amdgcn_s_sleep(1); \
    if ((++_sp & 255u) == 0u) { if (xb_ld(&(bar)[XB_TMO])) break; if (_sp > XB_SPIN_CAP) { (void)xb_add(&(bar)[XB_TMO], 1u); break; } } } } while (0)

struct XcdBarrier {
    XB_GAS unsigned* bar; unsigned x;
    volatile LAS unsigned* st;
};

__device__ __forceinline__ XcdBarrier xcd_barrier_post(XB_GAS unsigned* bar, volatile LAS unsigned* st) {
    XcdBarrier b; b.bar = bar; b.x = xb_xcc_id(); b.st = st;
    if (threadIdx.x == 0) (void)xb_add(&bar[XB_XCNT(b.x)], 1u);
    return b;
}
__device__ __forceinline__ void xcd_barrier_complete(XB_GAS unsigned* bar, unsigned x, unsigned& nloc, unsigned& nx) {
    const unsigned G = gridDim.x * gridDim.y * gridDim.z;
    unsigned sum, cnt, mine, sp = 0u;
    for (;;) {
        sum = 0u; cnt = 0u; mine = 0u;
#pragma unroll
        for (unsigned j = 0; j < 16; ++j) { const unsigned c = xb_ld(&bar[XB_XCNT(j)]); sum += c; cnt += (c > 0u) ? 1u : 0u; mine = (j == x) ? c : mine; }
        if (sum == G) break;
        __builtin_amdgcn_s_sleep(1);
        if ((++sp & 255u) == 0u) { if (xb_ld(&bar[XB_TMO])) break; if (sp > XB_SPIN_CAP) { (void)xb_add(&bar[XB_TMO], 1u); break; } }
    }
    nloc = mine > 0u ? mine : 1u; nx = cnt > 0u ? cnt : 1u;
}

__device__ __forceinline__ void xcd_barrier(const XcdBarrier& b) {
    asm volatile("s_waitcnt vmcnt(0)" ::: "memory");
    __syncthreads();
    if (threadIdx.x == 0) {
        XB_GAS unsigned* bar = b.bar;
        __builtin_amdgcn_s_waitcnt(0);
        unsigned nloc = b.st[0], nx = b.st[1];
        if (nloc == 0u) { xcd_barrier_complete(bar, b.x, nloc, nx); b.st[0] = nloc; b.st[1] = nx; }
        const unsigned old = xb_add(&bar[XB_XSUB(b.x)], 1u);
        const unsigned gen = old / nloc;
        if (old + 1u == (gen + 1u) * nloc) {
            __builtin_amdgcn_fence(__ATOMIC_RELEASE, "agent");
            asm volatile("s_waitcnt vmcnt(0)" ::: "memory");
            const unsigned og = xb_add(&bar[XB_TOP], 1u);
            const unsigned tg = og / nx;
            if (og + 1u == (tg + 1u) * nx) xb_add(&bar[XB_TOPGEN], 1u);
            else XB_SPIN(xb_ld(&bar[XB_TOPGEN]) == tg, bar);
            __builtin_amdgcn_fence(__ATOMIC_ACQUIRE, "agent");
            xb_add(&bar[XB_XGEN(b.x)], 1u);
            asm volatile("s_waitcnt vmcnt(0)" ::: "memory");
        } else {
            XB_SPIN(xb_ld(&bar[XB_XGEN(b.x)]) == gen, bar);
            __builtin_amdgcn_fence(__ATOMIC_ACQUIRE, "agent");
            asm volatile("s_waitcnt vmcnt(0)" ::: "memory");
        }
    }
    __syncthreads();
}

namespace pg8 {
#define PG8_LAS __attribute__((address_space(3)))
typedef unsigned short bf16_t;
typedef short bf16x8 __attribute__((ext_vector_type(8)));
typedef float f32x4 __attribute__((ext_vector_type(4)));
typedef unsigned u32x4 __attribute__((ext_vector_type(4)));
constexpr int BM = 256, BK = 64, HALF = 128, HTB = HALF * BK * 2  , STAGE_BYTES = 8 * HTB, NXCD = 8, WGM = 8;

__host__ __device__ __forceinline__ int lds_byte(int r, int c) { const int st = (r >> 4) * 2 + (c >> 5), rr = r & 15, cc = c & 31, ob = rr * 64 + cc * 2; return st * 1024 + (ob ^ (((ob >> 9) & 1) << 5)); }
__host__ __device__ __forceinline__ void stage_rc(int b, int& R, int& C) { const int st = b / 1024, sb = b % 1024, swz = sb ^ (((sb >> 9) & 1) << 5); R = (st >> 1) * 16 + swz / 64; C = (st & 1) * 32 + (swz % 64) / 2; }
__host__ __device__ __forceinline__ int perm32(int rho) { const int n = rho >> 4, i = rho & 15; return 8 * (i >> 2) + 4 * n + (i & 3); }

struct Unit { int pm, pn; };
#define PG8_GAS __attribute__((address_space(1)))
struct Gemm { const PG8_GAS bf16_t* A; const PG8_GAS bf16_t* Bt; int M, N, K, lda; };

struct StaticOrder {
    int nM, nN, nwg, G, c;
    __host__ __device__ void init(int M, int N, int G_, int c_) { nM = M / BM; nN = N / BM; nwg = nM * nN; G = G_; c = c_; }
    __host__ __device__ bool next(int i, Unit& u) const {
        const long L = (long)i * G + c; if (L >= nwg) return false;
        int wgid = (int)L; { const int q = nwg / NXCD, r = nwg % NXCD, xcd = wgid % NXCD, off = wgid / NXCD; wgid = (xcd < r ? xcd * (q + 1) : r * (q + 1) + (xcd - r) * q) + off; }
        const int nig = WGM * nN, gid = wgid / nig, fm = gid * WGM, gsz = (nM - fm) < WGM ? (nM - fm) : WGM;
        u.pm = fm + ((wgid % nig) % gsz); u.pn = (wgid % nig) / gsz; return true;
    }
    __device__ __forceinline__ void a_ready(const Unit&) const {}
    __device__ __forceinline__ void done(const Unit&) const {}
};

template <class Epi, class Sched, bool ALIGN_EPI = false, bool SP2 = false>
__device__ __forceinline__ void gemm_phase(PG8_LAS unsigned char* lds, const Gemm g, const Sched& S, const Epi& E) {
    int tid_ = threadIdx.x; asm volatile("" : "+v"(tid_));
    const int tid = tid_, wid = __builtin_amdgcn_readfirstlane(tid >> 6), lane = tid & 63, wr = wid >> 2, wc = wid & 3, fr = lane & 15, fq = lane >> 4;
    const int K = g.K, nt = K / BK;
    unsigned voffA[2], voffB[2];
#pragma unroll
    for (int i = 0; i < 2; ++i) { int R, C; stage_rc(tid * 16 + i * 8192, R, C); const int Rb = Epi::PERM ? ((R & ~31) + perm32(R & 31)) : R;
        voffA[i] = (unsigned)(R * g.lda + C) * 2u; voffB[i] = (unsigned)(Rb * K + C) * 2u; }
    const size_t kstep = (size_t)(BK * 2);
    const size_t hstep = (size_t)HALF * K * 2;
    const size_t tstep = 2 * hstep; const size_t hstepA = (size_t)HALF * g.lda * 2, tstepA = 2 * hstepA;
    const unsigned ldsw = (unsigned)wid * 1024u;
    const int aoff = lds_byte(wr * 64 + fr, fq * 8), boff = lds_byte(wc * 32 + fr, fq * 8);
#define PG8_SA(b, h) (((b) * 2 + (h)) * HTB)
#define PG8_SB(b, h) ((4 + (b) * 2 + (h)) * HTB)
#define PG8_STAGE(bufoff, gbase, voff) do { _Pragma("unroll") for (int _i = 0; _i < 2; ++_i) \
        __builtin_amdgcn_global_load_lds((const PG8_GAS unsigned*)((const PG8_GAS char*)(gbase) + (voff)[_i]), (PG8_LAS unsigned*)(lds + (bufoff) + ldsw + _i * 8192), 16, 0, 0); } while (0)
#define PG8_LDA(dst, b, h) do { _Pragma("unroll") for (int m = 0; m < 4; ++m) _Pragma("unroll") for (int k = 0; k < 2; ++k) dst[m][k] = *(const PG8_LAS bf16x8*)(lds + PG8_SA(b, h) + aoff + m * 2048 + k * 1024); } while (0)
#define PG8_LDB(dst, b, h) do { _Pragma("unroll") for (int n = 0; n < 2; ++n) _Pragma("unroll") for (int k = 0; k < 2; ++k) dst[n][k] = *(const PG8_LAS bf16x8*)(lds + PG8_SB(b, h) + boff + n * 2048 + k * 1024); } while (0)
#define PG8_MMA(ai, bj, At, Bt) do { __builtin_amdgcn_s_setprio(1); _Pragma("unroll") for (int m = 0; m < 4; ++m) _Pragma("unroll") for (int n = 0; n < 2; ++n) _Pragma("unroll") for (int k = 0; k < 2; ++k) \
        acc[ai][bj][m][n] = __builtin_amdgcn_mfma_f32_16x16x32_bf16(Bt[n][k], At[m][k], acc[ai][bj][m][n], 0, 0, 0); __builtin_amdgcn_s_setprio(0); } while (0)
#define PG8_WAIT_V(n) asm volatile("s_waitcnt vmcnt(" #n ")" ::: "memory")
#define PG8_WAIT_L(n) asm volatile("s_waitcnt lgkmcnt(" #n ")" ::: "memory")
#define PG8_BAR __builtin_amdgcn_s_barrier()
#define PG8_SCHED __builtin_amdgcn_sched_barrier(0)
    Unit cur, nxt; int ui = 0;
    if (!S.next(0, cur)) return;
    f32x4 acc[2][2][4][2];
#pragma unroll
    for (int a = 0; a < 2; ++a)
#pragma unroll
        for (int b = 0; b < 2; ++b)
#pragma unroll
            for (int m = 0; m < 4; ++m)
#pragma unroll
                for (int n = 0; n < 2; ++n) acc[a][b][m][n] = (f32x4){0.f, 0.f, 0.f, 0.f};
    bf16x8 At[4][2], B0[2][2], B1[2][2];
    const PG8_GAS char* cA = (const PG8_GAS char*)g.A + (size_t)cur.pm * tstepA; const PG8_GAS char* cB = (const PG8_GAS char*)g.Bt + (size_t)cur.pn * tstep;
    S.a_ready(cur);
    if constexpr (SP2) {
        PG8_STAGE(PG8_SB(0, 0), cB, voffB); PG8_STAGE(PG8_SB(0, 1), cB + hstep, voffB); PG8_STAGE(PG8_SA(0, 0), cA, voffA); PG8_STAGE(PG8_SA(0, 1), cA + hstepA, voffA);
        if (wr == 1) PG8_BAR;
        PG8_WAIT_V(2); PG8_BAR;
        PG8_STAGE(PG8_SB(1, 0), cB + kstep, voffB); PG8_STAGE(PG8_SA(1, 0), cA + kstep, voffA); PG8_STAGE(PG8_SB(1, 1), cB + hstep + kstep, voffB);
        PG8_WAIT_V(6); PG8_BAR;
    } else {
        PG8_STAGE(PG8_SB(0, 0), cB, voffB); PG8_STAGE(PG8_SA(0, 0), cA, voffA); PG8_STAGE(PG8_SB(0, 1), cB + hstep, voffB); PG8_STAGE(PG8_SA(0, 1), cA + hstepA, voffA);
        if (wr == 1) PG8_BAR;
        PG8_WAIT_V(4); PG8_BAR;
        PG8_STAGE(PG8_SB(1, 0), cB + kstep, voffB); PG8_STAGE(PG8_SA(1, 0), cA + kstep, voffA); PG8_STAGE(PG8_SB(1, 1), cB + hstep + kstep, voffB);
        PG8_WAIT_V(6); PG8_BAR;
    }
    for (;;) {
        const bool has_next = S.next(ui + 1, nxt);
        const PG8_GAS char* nA = has_next ? (const PG8_GAS char*)g.A + (size_t)nxt.pm * tstepA : cA; const PG8_GAS char* nB = has_next ? (const PG8_GAS char*)g.Bt + (size_t)nxt.pn * tstep : cB;
        for (int t = 0; t < nt; t += 2) {
            const bool last = (t == nt - 2);
            const PG8_GAS char* a1 = cA + (size_t)(t + 1) * kstep;
            const PG8_GAS char* a2 = last ? nA : cA + (size_t)(t + 2) * kstep; const PG8_GAS char* b2 = last ? nB : cB + (size_t)(t + 2) * kstep;
            const PG8_GAS char* a3 = a2 + kstep; const PG8_GAS char* b3 = b2 + kstep;
            if (last && has_next) S.a_ready(nxt);
            if constexpr (SP2) {
            PG8_LDB(B0, 0, 0); PG8_LDB(B1, 0, 1); PG8_SCHED; PG8_LDA(At, 0, 0); PG8_STAGE(PG8_SA(1, 1), a1 + hstepA, voffA);
            PG8_WAIT_V(8); PG8_WAIT_L(0); PG8_BAR; PG8_MMA(0, 0, At, B0); PG8_MMA(0, 1, At, B1); PG8_BAR; PG8_SCHED;
            PG8_LDA(At, 0, 1); PG8_STAGE(PG8_SB(0, 0), b2, voffB); PG8_STAGE(PG8_SB(0, 1), b2 + hstep, voffB); PG8_STAGE(PG8_SA(0, 0), a2, voffA);
            PG8_WAIT_V(8); PG8_WAIT_L(0); PG8_BAR; PG8_MMA(1, 0, At, B0); PG8_MMA(1, 1, At, B1); PG8_BAR; PG8_SCHED;
            PG8_LDB(B0, 1, 0); PG8_LDB(B1, 1, 1); PG8_SCHED; PG8_LDA(At, 1, 0); PG8_STAGE(PG8_SA(0, 1), a2 + hstepA, voffA);
            PG8_WAIT_V(8); PG8_WAIT_L(0); PG8_BAR; PG8_MMA(0, 0, At, B0); PG8_MMA(0, 1, At, B1); PG8_BAR; PG8_SCHED;
            PG8_LDA(At, 1, 1); PG8_STAGE(PG8_SB(1, 0), b3, voffB); PG8_STAGE(PG8_SB(1, 1), b3 + hstep, voffB); PG8_STAGE(PG8_SA(1, 0), a3, voffA);
            PG8_WAIT_V(8); PG8_WAIT_L(0); PG8_BAR; PG8_MMA(1, 0, At, B0); PG8_MMA(1, 1, At, B1); PG8_BAR; PG8_SCHED;
            } else {
            PG8_LDB(B0, 0, 0); PG8_SCHED; PG8_LDA(At, 0, 0); PG8_STAGE(PG8_SA(1, 1), a1 + hstepA, voffA);
            PG8_WAIT_L(8); PG8_BAR; PG8_WAIT_L(0); PG8_MMA(0, 0, At, B0); PG8_BAR; PG8_SCHED;
            PG8_LDB(B1, 0, 1); PG8_STAGE(PG8_SB(0, 0), b2, voffB);
            PG8_BAR; PG8_WAIT_L(0); PG8_MMA(0, 1, At, B1); PG8_BAR;
            PG8_LDA(At, 0, 1); PG8_STAGE(PG8_SA(0, 0), a2, voffA);
            PG8_BAR; PG8_WAIT_L(0); PG8_MMA(1, 0, At, B0); PG8_BAR; PG8_SCHED;
            PG8_STAGE(PG8_SB(0, 1), b2 + hstep, voffB);
            PG8_WAIT_V(6); PG8_BAR; PG8_MMA(1, 1, At, B1); PG8_BAR;
            PG8_LDB(B0, 1, 0); PG8_SCHED; PG8_LDA(At, 1, 0); PG8_STAGE(PG8_SA(0, 1), a2 + hstepA, voffA);
            PG8_WAIT_L(8); PG8_BAR; PG8_WAIT_L(0); PG8_MMA(0, 0, At, B0); PG8_BAR; PG8_SCHED;
            PG8_LDB(B1, 1, 1); PG8_STAGE(PG8_SB(1, 0), b3, voffB);
            PG8_BAR; PG8_WAIT_L(0); PG8_MMA(0, 1, At, B1); PG8_BAR;
            PG8_LDA(At, 1, 1); PG8_STAGE(PG8_SA(1, 0), a3, voffA);
            PG8_BAR; PG8_WAIT_L(0); PG8_MMA(1, 0, At, B0); PG8_BAR; PG8_SCHED;
            PG8_STAGE(PG8_SB(1, 1), b3 + hstep, voffB);
            PG8_WAIT_V(6); PG8_BAR; PG8_MMA(1, 1, At, B1); PG8_BAR;
            }
        }
        if constexpr (ALIGN_EPI) { if (wr == 0) PG8_BAR; }
        if constexpr (!Epi::AFTER_DRAIN) { E(acc, cur, wr, wc, fr, fq); S.done(cur); }
        if (!has_next) break;
#pragma unroll
        for (int a = 0; a < 2; ++a)
#pragma unroll
            for (int b = 0; b < 2; ++b)
#pragma unroll
                for (int m = 0; m < 4; ++m)
#pragma unroll
                    for (int n = 0; n < 2; ++n) acc[a][b][m][n] = (f32x4){0.f, 0.f, 0.f, 0.f};
        cur = nxt; cA = nA; cB = nB; ++ui;
        if constexpr (ALIGN_EPI) { if (wr == 1) PG8_BAR; }
    }
    PG8_WAIT_V(0);
    if constexpr (!ALIGN_EPI) { if (wr == 0) PG8_BAR; }
    PG8_BAR;
    if constexpr (Epi::AFTER_DRAIN) { E.fused(acc, cur, wr, wc, fr, fq, lds, wid, lane); S.done(cur); }
#undef PG8_SA
#undef PG8_SB
#undef PG8_STAGE
#undef PG8_LDA
#undef PG8_LDB
#undef PG8_MMA
#undef PG8_WAIT_V
#undef PG8_WAIT_L
#undef PG8_BAR
#undef PG8_SCHED
}
}

typedef unsigned short u16;
typedef short bf16x8 __attribute__((ext_vector_type(8)));
typedef short s16x4 __attribute__((ext_vector_type(4)));
typedef float f32x4 __attribute__((ext_vector_type(4)));
typedef float f32x16 __attribute__((ext_vector_type(16)));
typedef unsigned u32x4 __attribute__((ext_vector_type(4)));
typedef unsigned u32x2 __attribute__((ext_vector_type(2)));
typedef __bf16 bf16x2_t __attribute__((ext_vector_type(2)));
typedef float f32x2_t __attribute__((ext_vector_type(2)));
#define DI __device__ __forceinline__

constexpr int NB = 32, SEQ = 2048, NCTX = 256, TT = 2304, DM = 1024, DEPTH = 4;
constexpr int NGRP = 4, BGR = 8, MG = BGR * TT;
constexpr int DIN = 10992, NP = 11008;
constexpr float EPS = 1e-6f;
constexpr int C_CQ = 0, C_KR = 384, C_AF = 448, C_AB = 464, C_IF = 480, C_CKV = 512, C_MZ = 768, C_GQ = 1280, C_GK = 1536, C_GV = 1792, C_GZ = 2304,
              C_MX = 2816, C_MV = 3328, C_MO = 3840, C_MLZ = 4352, C_DQ = 4864, C_DK = 5376, C_DV = 5888, C_DZ = 6400, C_MG = 6912;
constexpr int NSTEP = 1 + DEPTH * NGRP * 7;
constexpr int LDS_BYTES = 163840;
constexpr int LDS_BARW = LDS_BYTES - 16;
constexpr int LDS_MISC = LDS_BYTES - 64;

constexpr size_t al256(size_t x) { return (x + 255) / 256 * 256; }
constexpr size_t WS_CTL = 0;
constexpr size_t CTL_BYTES = 65536;
constexpr size_t WS_MOD  = WS_CTL + CTL_BYTES;
constexpr size_t WS_ROPE = WS_MOD + al256((size_t)DEPTH * 33 * 3072 * 4);
constexpr size_t WS_LAM  = WS_ROPE + 8192;
constexpr size_t WS_WIN  = WS_LAM + 256;
constexpr size_t WS_BR   = WS_WIN + (size_t)DEPTH * NP * 1024 * 2;
constexpr size_t WS_WO   = WS_BR + (size_t)DEPTH * 4 * 1024 * 512 * 2;
constexpr size_t WS_WUQ  = WS_WO + (size_t)DEPTH * 1024 * 1024 * 2;
constexpr size_t WS_WUKV = WS_WUQ + (size_t)DEPTH * 768 * 384 * 2;
constexpr size_t WS_WQK  = WS_WUKV + (size_t)DEPTH * 1024 * 256 * 2;
constexpr size_t WS_CTX  = WS_WQK + (size_t)DEPTH * 512 * 512 * 2;
constexpr size_t WS_H    = WS_CTX + (size_t)NB * NCTX * DM * 4;
constexpr size_t WS_P    = WS_H + (size_t)MG * 1024 * 2;
constexpr size_t WS_Q    = WS_P + (size_t)MG * NP * 2;
constexpr size_t WS_KV   = WS_Q + (size_t)MG * 768 * 2;
constexpr size_t WS_XC   = WS_KV + (size_t)MG * 1024 * 2;
constexpr size_t WS_QKML = WS_XC + (size_t)MG * 512 * 2;
constexpr size_t WS_BG   = WS_QKML + (size_t)MG * 512 * 2;
constexpr size_t WS_SCAL = WS_BG + (size_t)2 * MG * 256 * 4;
constexpr size_t WS_Y    = WS_SCAL + (size_t)2 * MG * 16 * 4;
constexpr size_t WS_OSC  = WS_Y + (size_t)4 * MG * 512 * 2;
constexpr size_t WS_MF   = WS_OSC;
constexpr size_t WS_MB   = WS_OSC + (size_t)4 * MG * 512 * 2;
constexpr size_t WS_END  = WS_MB + (size_t)MG * 1024 * 2;
static_assert((size_t)MG * 1024 * 4 == (size_t)4 * MG * 512 * 2, "merge accumulator aliases the scan scratch");
static_assert(WS_END <= (size_t)1000 * 1024 * 1024, "workspace map must stay below 1000 MiB");
constexpr int CW_QUEUE = 4096;

#define GAS __attribute__((address_space(1)))
typedef GAS float gf32; typedef GAS unsigned short gu16; typedef GAS unsigned char gu8;
#define FIN(k) ((const gf32*)F.in[k])
struct Params { const float* in[29]; float* out; unsigned char* ws; int s_lo, s_hi; };

struct Ctx {
    const float* const* in; gf32* out; gu8* ws; GAS unsigned* ctl;
    int wave, G;
    LAS unsigned char* lds;
};

DI float bf2f(u16 v) { return __uint_as_float((unsigned)v << 16); }
DI float bflo(unsigned w) { return __uint_as_float(w << 16); }
DI float bfhi(unsigned w) { return __uint_as_float(w & 0xffff0000u); }
DI unsigned pk2(float lo, float hi) { f32x2_t v = {lo, hi}; bf16x2_t b = __builtin_convertvector(v, bf16x2_t); return __builtin_bit_cast(unsigned, b); }
DI u16 f2bf(float f) { return (u16)(pk2(f, 0.f) & 0xffffu); }
DI void unpack8(u32x4 w, float* f) { f[0] = bflo(w.x); f[1] = bfhi(w.x); f[2] = bflo(w.y); f[3] = bfhi(w.y); f[4] = bflo(w.z); f[5] = bfhi(w.z); f[6] = bflo(w.w); f[7] = bfhi(w.w); }
DI u32x4 pack8(const float* f) { u32x4 w; w.x = pk2(f[0], f[1]); w.y = pk2(f[2], f[3]); w.z = pk2(f[4], f[5]); w.w = pk2(f[6], f[7]); return w; }
DI float sigmoid_f(float x) { return __builtin_amdgcn_rcpf(1.f + __expf(-x)); }
DI float silu_f(float x) { return x * sigmoid_f(x); }
DI float logsig_f(float x) { return fminf(x, 0.f) - __logf(1.f + __expf(-fabsf(x))); }
DI int crow(int r, int hi) { return (r & 3) + 8 * (r >> 2) + 4 * hi; }
DI int swz64(int row, int colB) { return row * 128 + (colB ^ (((row >> 1) & 7) << 4)); }
DI int kswz(int row, int colB) { return row * 256 + (colB ^ ((row & 7) << 4)); }
DI int v_st(int k, int c) { const int kk = (k & ~0xC) | ((k & 4) << 1) | ((k & 8) >> 1); return ((kk >> 3) * 4 + (c >> 5)) * 512 + ((kk & 7) * 32 + (c & 31)) * 2; }
DI int v_rd_base(int lane) { return ((lane & 3) << 3) | (((lane >> 2) & 3) << 6) | (((lane >> 4) & 1) << 5) | (((lane >> 5) & 1) << 8); }
template <int OFF> DI s16x4 tr_read(int vb) { s16x4 r; asm volatile("ds_read_b64_tr_b16 %0, %1 offset:%2" : "=&v"(r) : "v"(vb), "i"(OFF) : "memory"); return r; }
#define SBAR() __builtin_amdgcn_sched_barrier(0)
#define MFMA32(a, b, c) __builtin_amdgcn_mfma_f32_32x32x16_bf16((a), (b), (c), 0, 0, 0)
DI bf16x8 ldsv(const LAS unsigned char* p) { return *(const LAS bf16x8*)p; }
DI float wave_sum(float v) {
#pragma unroll
    for (int o = 32; o >= 1; o >>= 1) v += __shfl_xor(v, o);
    return v;
}
DI void v_frags(int vb, bf16x8 (&vf)[4]) {
    const s16x4 l0 = tr_read<0>(vb), h0 = tr_read<2048>(vb), l1 = tr_read<4096>(vb), h1 = tr_read<4096 + 2048>(vb);
    const s16x4 l2 = tr_read<8192>(vb), h2 = tr_read<8192 + 2048>(vb), l3 = tr_read<12288>(vb), h3 = tr_read<12288 + 2048>(vb);
    asm volatile("s_waitcnt lgkmcnt(0)" ::: "memory"); SBAR();
#define PKV(L, H) (bf16x8){L[0], L[1], L[2], L[3], H[0], H[1], H[2], H[3]}
    vf[0] = PKV(l0, h0); vf[1] = PKV(l1, h1); vf[2] = PKV(l2, h2); vf[3] = PKV(l3, h3);
#undef PKV
}
DI void p_to_afrag(const f32x16& p0, const f32x16& p1, bf16x8 (&pa)[4]) {
#define PK4(P, BASE, OUT) do { unsigned a0 = pk2(P[BASE + 0], P[BASE + 1]), a1 = pk2(P[BASE + 2], P[BASE + 3]);   \
    unsigned b0 = pk2(P[BASE + 4], P[BASE + 5]), b1 = pk2(P[BASE + 6], P[BASE + 7]);                              \
    auto r0 = __builtin_amdgcn_permlane32_swap(a0, b0, false, false); auto r1 = __builtin_amdgcn_permlane32_swap(a1, b1, false, false); \
    u32x4 w = {r0[0], r1[0], r0[1], r1[1]}; OUT = __builtin_bit_cast(bf16x8, w); } while (0)
    PK4(p0, 0, pa[0]); PK4(p0, 8, pa[1]); PK4(p1, 0, pa[2]); PK4(p1, 8, pa[3]);
#undef PK4
}
DI void p_half_to_afrag(const f32x16& p, bf16x8& pa0, bf16x8& pa1) {
#define PK4(P, BASE, OUT) do { unsigned a0 = pk2(P[BASE + 0], P[BASE + 1]), a1 = pk2(P[BASE + 2], P[BASE + 3]);   \
    unsigned b0 = pk2(P[BASE + 4], P[BASE + 5]), b1 = pk2(P[BASE + 6], P[BASE + 7]);                              \
    auto r0 = __builtin_amdgcn_permlane32_swap(a0, b0, false, false); auto r1 = __builtin_amdgcn_permlane32_swap(a1, b1, false, false); \
    u32x4 w = {r0[0], r1[0], r0[1], r1[1]}; OUT = __builtin_bit_cast(bf16x8, w); } while (0)
    PK4(p, 0, pa0); PK4(p, 8, pa1);
#undef PK4
}
DI float half_swap_sum(float v) { auto rr = __builtin_amdgcn_permlane32_swap(__float_as_uint(v), __float_as_uint(v), false, false); return __uint_as_float(rr[0]) + __uint_as_float(rr[1]); }
DI float half_swap_max(float v) { auto rr = __builtin_amdgcn_permlane32_swap(__float_as_uint(v), __float_as_uint(v), false, false); return fmaxf(__uint_as_float(rr[0]), __uint_as_float(rr[1])); }
using pg8::Unit;
typedef f32x4 AccT[2][2][4][2];

DI int p_act(int pn) {
    if (pn >= 27) return 2;
    if (pn == 15 || pn == 16) return 2;
    if (pn == 3 || pn == 4 || pn == 9 || pn == 10 || pn == 17 || pn == 18 || pn == 25 || pn == 26) return 1;
    return 0;
}
struct EpiBf {
    static constexpr bool PERM = true, AFTER_DRAIN = false;
    gu16* O; int ldc; int actsel;
    DI void operator()(const AccT& acc, const Unit& u, int wr, int wc, int fr, int fq) const {
        const int row0 = u.pm * 256 + wr * 64 + fr, col0 = u.pn * 256 + wc * 32 + 8 * fq;
        const int act = actsel == 1 ? p_act(u.pn) : actsel;
#pragma unroll
        for (int ai = 0; ai < 2; ++ai)
#pragma unroll
            for (int m = 0; m < 4; ++m) { gu16* rowp = O + (size_t)(row0 + ai * 128 + m * 16) * ldc + col0;
#pragma unroll
                for (int bj = 0; bj < 2; ++bj) { f32x4 v0 = acc[ai][bj][m][0], v1 = acc[ai][bj][m][1];
                    float f[8] = {v0[0], v0[1], v0[2], v0[3], v1[0], v1[1], v1[2], v1[3]};
                    if (act == 1) {
#pragma unroll
                        for (int e = 0; e < 8; ++e) f[e] = silu_f(f[e]);
                    } else if (act == 2) {
#pragma unroll
                        for (int e = 0; e < 8; ++e) f[e] = sigmoid_f(f[e]);
                    }
                    *(GAS u32x4*)(rowp + bj * 128) = pack8(f); } }
    }
};
struct EpiMerge {
    static constexpr bool PERM = true, AFTER_DRAIN = false;
    gu16* MB; const gu16* gate; int mode;
    DI void operator()(const AccT& acc, const Unit& u, int wr, int wc, int fr, int fq) const {
        const int row0 = u.pm * 256 + wr * 64 + fr, col0 = u.pn * 256 + wc * 32 + 8 * fq;
#pragma unroll
        for (int ai = 0; ai < 2; ++ai) {
            u32x4 gv[4][2], ov[4][2];
#pragma unroll
            for (int m = 0; m < 4; ++m) { const size_t r = (size_t)(row0 + ai * 128 + m * 16);
#pragma unroll
                for (int bj = 0; bj < 2; ++bj) { const int c = col0 + bj * 128; gv[m][bj] = *(const GAS u32x4*)(gate + r * NP + c); if (mode != 0) ov[m][bj] = *(const GAS u32x4*)(MB + r * 1024 + c); } }
#pragma unroll
            for (int m = 0; m < 4; ++m) { const size_t r = (size_t)(row0 + ai * 128 + m * 16);
#pragma unroll
                for (int bj = 0; bj < 2; ++bj) { const int c = col0 + bj * 128;
                    f32x4 v0 = acc[ai][bj][m][0], v1 = acc[ai][bj][m][1];
                    float g[8]; unpack8(gv[m][bj], g);
#pragma unroll
                    for (int e = 0; e < 8; ++e) g[e] = sigmoid_f(g[e]);
                    float f[8] = {v0[0] * g[0], v0[1] * g[1], v0[2] * g[2], v0[3] * g[3], v1[0] * g[4], v1[1] * g[5], v1[2] * g[6], v1[3] * g[7]};
                    if (mode != 0) { float o[8]; unpack8(ov[m][bj], o);
#pragma unroll
                        for (int e = 0; e < 8; ++e) f[e] += o[e]; }
                    *(GAS u32x4*)(MB + r * 1024 + c) = pack8(f); } }
        }
    }
};
struct EpiOut {
    static constexpr bool PERM = false, AFTER_DRAIN = false;
    const gf32* xsrc; gf32* xdst; const gf32* csrc; gf32* cdst; const gf32* mod; int grp; int last;
    DI void operator()(const AccT& acc, const Unit& u, int wr, int wc, int fr, int fq) const {
        const int bl = u.pm / 9, tb = u.pm % 9, b = grp * BGR + bl;
        if (tb == 0 && last) return;
        const gf32* src; gf32* dst; const gf32* gt;
        if (tb == 0) { src = csrc + (size_t)b * NCTX * DM; dst = cdst + (size_t)b * NCTX * DM; gt = mod + 32 * 3072 + 2048; }
        else { src = xsrc + ((size_t)b * SEQ + (size_t)(tb - 1) * 256) * DM; dst = xdst + ((size_t)b * SEQ + (size_t)(tb - 1) * 256) * DM; gt = mod + b * 3072 + 2048; }
        const int row0 = wr * 64 + fr, col0 = u.pn * 256 + wc * 32 + 4 * fq;
        f32x4 gv[2][2];
#pragma unroll
        for (int bj = 0; bj < 2; ++bj)
#pragma unroll
            for (int n = 0; n < 2; ++n) gv[bj][n] = *(const GAS f32x4*)(gt + col0 + bj * 128 + n * 16);
#pragma unroll
        for (int ai = 0; ai < 2; ++ai)
#pragma unroll
            for (int mh = 0; mh < 2; ++mh) {
                f32x4 xo[2][2][2];
#pragma unroll
                for (int m2 = 0; m2 < 2; ++m2) { const size_t ro = (size_t)(row0 + ai * 128 + (mh * 2 + m2) * 16) * DM + col0;
#pragma unroll
                    for (int bj = 0; bj < 2; ++bj)
#pragma unroll
                        for (int n = 0; n < 2; ++n) xo[m2][bj][n] = *(const GAS f32x4*)(src + ro + bj * 128 + n * 16); }
#pragma unroll
                for (int m2 = 0; m2 < 2; ++m2) { const int m = mh * 2 + m2; const size_t ro = (size_t)(row0 + ai * 128 + m * 16) * DM + col0;
#pragma unroll
                    for (int bj = 0; bj < 2; ++bj)
#pragma unroll
                        for (int n = 0; n < 2; ++n) *(GAS f32x4*)(dst + ro + bj * 128 + n * 16) = xo[m2][bj][n] + gv[bj][n] * acc[ai][bj][m][n]; } }
    }
};

DI int pmap(int n, float& sc) {
    sc = 1.f;
    if (n < 384) return n;
    if (n < 448) return 640 + (n - 384);
    if (n < 464) return 2240 + (n - 448);
    if (n < 480) return 2256 + (n - 464);
    if (n < 496) return 4320 + (n - 480);
    if (n < 512) return -1;
    if (n < 768) return 384 + (n - 512);
    if (n < 1280) return 704 + (n - 768);
    if (n < 1536) { sc = 0.125f; return 1216 + (n - 1280); }
    if (n < 1792) return 1472 + (n - 1536);
    if (n < 2304) return 1728 + (n - 1792);
    if (n < 2816) return 2272 + (n - 2304);
    if (n < 3328) return 2784 + (n - 2816);
    if (n < 3840) return 3296 + (n - 3328);
    if (n < 4352) return 3808 + (n - 3840);
    if (n < 4864) return 4336 + (n - 4352);
    if (n < 5376) return 4848 + (n - 4864);
    if (n < 5888) return 5360 + (n - 5376);
    if (n < 6400) return 5872 + (n - 5888);
    if (n < 6912) return 6384 + (n - 6400);
    return 6896 + (n - 6912);
}
struct MapWin { DI int operator()(int n, float& sc) const { return pmap(n, sc); } };
struct MapId  { DI int operator()(int n, float& sc) const { sc = 1.f; return n; } };
struct MapQ   { DI int operator()(int n, float& sc) const { sc = 1.f; return n < 512 ? (n >> 7) * 192 + (n & 127) : ((n - 512) >> 6) * 192 + 128 + ((n - 512) & 63); } };
struct MapKV  { DI int operator()(int n, float& sc) const { sc = 1.f; return n < 512 ? (n >> 7) * 256 + (n & 127) : ((n - 512) >> 7) * 256 + 128 + ((n - 512) & 127); } };

template <class Map>
DI void xpose_tile(const gf32* __restrict__ src, int ldsrc, gu16* __restrict__ dst, int K, int n0, int k0, const gf32* __restrict__ kscale, Map map, LAS float* tl) {
    const int tid = threadIdx.x;
    { const int kk = tid >> 3, ng = (tid & 7) * 8; float sc; const int sn = map(n0 + ng, sc);
      f32x4 a = {0.f, 0.f, 0.f, 0.f}, b = {0.f, 0.f, 0.f, 0.f};
      if (sn >= 0) { const gf32* p = src + (size_t)(k0 + kk) * ldsrc + sn; a = *(const GAS f32x4*)p; b = *(const GAS f32x4*)(p + 4); }
      const float ks = (kscale ? kscale[k0 + kk] : 1.f) * sc;
      tl[(ng + 0) * 65 + kk] = a[0] * ks; tl[(ng + 1) * 65 + kk] = a[1] * ks; tl[(ng + 2) * 65 + kk] = a[2] * ks; tl[(ng + 3) * 65 + kk] = a[3] * ks;
      tl[(ng + 4) * 65 + kk] = b[0] * ks; tl[(ng + 5) * 65 + kk] = b[1] * ks; tl[(ng + 6) * 65 + kk] = b[2] * ks; tl[(ng + 7) * 65 + kk] = b[3] * ks; }
    __syncthreads();
    { const int nn = tid >> 3, kg = (tid & 7) * 8; float f[8];
#pragma unroll
      for (int e = 0; e < 8; ++e) f[e] = tl[nn * 65 + kg + e];
      *(GAS u32x4*)(dst + (size_t)(n0 + nn) * K + k0 + kg) = pack8(f); }
    __syncthreads();
}

DI void p0_prologue(const Ctx& F) {
    int tz = (int)threadIdx.x; asm volatile("" : "+v"(tz));
    const int tid = tz;
    LAS float* lf = (LAS float*)F.lds;
    constexpr int U_ADA = 96, U_WIN = DEPTH * (NP / 64) * 16, U_BR = DEPTH * 4 * 16 * 8, U_WO = DEPTH * 16 * 16, U_WUQ = DEPTH * 12 * 6, U_WUKV = DEPTH * 16 * 4, U_WQK = DEPTH * 64, U_MISC = 1;
    constexpr int O_WIN = U_ADA, O_BR = O_WIN + U_WIN, O_WO = O_BR + U_BR, O_WUQ = O_WO + U_WO, O_WUKV = O_WUQ + U_WUQ, O_WQK = O_WUKV + U_WUKV, O_MISC = O_WQK + U_WQK, U_ALL = O_MISC + U_MISC;
    for (int u = blockIdx.x; u < U_ALL; u += F.G) {
        if (u < U_ADA) {
            const int l = u / 24, col0 = (u % 24) * 128, col = tid & 127, kq = tid >> 7;
            const gf32* aw = FIN(4) + (size_t)l * 1024 * 3072;
            float acc[33];
#pragma unroll
            for (int r = 0; r < 33; ++r) acc[r] = 0.f;
            for (int kc = 0; kc < 1024; kc += 256) {
                __syncthreads();
                for (int idx = tid; idx < 33 * 256; idx += 512) { const int r = idx >> 8, k = idx & 255; const float cv = (r < 32) ? FIN(1)[r * 1024 + kc + k] : FIN(3)[kc + k]; lf[idx] = silu_f(cv); }
                __syncthreads();
                for (int k = kq * 64; k < kq * 64 + 64; ++k) { const float w = aw[(size_t)(kc + k) * 3072 + col0 + col];
#pragma unroll
                    for (int r = 0; r < 33; ++r) acc[r] += lf[r * 256 + k] * w; }
            }
            __syncthreads();
#pragma unroll
            for (int r = 0; r < 33; ++r) lf[(kq * 33 + r) * 128 + col] = acc[r];
            __syncthreads();
            gf32* mod = (gf32*)(F.ws + WS_MOD) + (size_t)l * 33 * 3072;
            for (int idx = tid; idx < 33 * 128; idx += 512) { const int r = idx >> 7, c = idx & 127;
                mod[r * 3072 + col0 + c] = lf[(0 * 33 + r) * 128 + c] + lf[(1 * 33 + r) * 128 + c] + lf[(2 * 33 + r) * 128 + c] + lf[(3 * 33 + r) * 128 + c] + FIN(5)[l * 3072 + col0 + c]; }
            __syncthreads();
        } else if (u < O_BR) {
            const int v = u - O_WIN, l = v / ((NP / 64) * 16), t = v % ((NP / 64) * 16), nt = t / 16, kt = t % 16;
            xpose_tile(FIN(7) + (size_t)l * 1024 * DIN, DIN, (gu16*)(F.ws + WS_WIN) + (size_t)l * NP * 1024, 1024, nt * 64, kt * 64, nullptr, MapWin(), lf);
        } else if (u < O_WO) {
            const int v = u - O_BR, li = v / 128, t = v % 128, nt = t / 8, kt = t % 8;
            xpose_tile(FIN(27) + (size_t)li * 512 * 1024, 1024, (gu16*)(F.ws + WS_BR) + (size_t)li * 1024 * 512, 512, nt * 64, kt * 64, nullptr, MapId(), lf);
        } else if (u < O_WUQ) {
            const int v = u - O_WO, l = v / 256, t = v % 256, nt = t / 16, kt = t % 16;
            xpose_tile(FIN(28) + (size_t)l * 1024 * 1024, 1024, (gu16*)(F.ws + WS_WO) + (size_t)l * 1024 * 1024, 1024, nt * 64, kt * 64, nullptr, MapId(), lf);
        } else if (u < O_WUKV) {
            const int v = u - O_WUQ, l = v / 72, t = v % 72, nt = t / 6, kt = t % 6;
            xpose_tile(FIN(10) + (size_t)l * 384 * 768, 768, (gu16*)(F.ws + WS_WUQ) + (size_t)l * 768 * 384, 384, nt * 64, kt * 64, FIN(8) + l * 384, MapQ(), lf);
        } else if (u < O_WQK) {
            const int v = u - O_WUKV, l = v / 64, t = v % 64, nt = t / 4, kt = t % 4;
            xpose_tile(FIN(11) + (size_t)l * 256 * 1024, 1024, (gu16*)(F.ws + WS_WUKV) + (size_t)l * 1024 * 256, 256, nt * 64, kt * 64, FIN(9) + l * 256, MapKV(), lf);
        } else if (u < O_MISC) {
            const int v = u - O_WQK, l = v / 64, t = v % 64;
            gu16* dst = (gu16*)(F.ws + WS_WQK) + (size_t)l * 512 * 512;
            for (int e = tid; e < 4096; e += 512) { const int idx = t * 4096 + e, n = idx >> 9, k = idx & 511;
                const int isk = n >> 8, hn = (n & 255) >> 6, dd = n & 63, hk = k >> 7, c = k & 127;
                float val = 0.f;
                if (hn == hk) { const gf32* w = (isk ? FIN(20) : FIN(19)) + (((size_t)l * 4 + hn) * 128 + c) * 64 + dd; val = isk ? *w * 0.125f : *w; }
                dst[idx] = f2bf(val); }
        } else {
            gf32* rope = (gf32*)(F.ws + WS_ROPE);
            for (int e = tid; e < 1024; e += 512) { const int pos = e >> 4, i = e & 15;
                const float inv = powf(10000.f, -(float)i / 16.f); const float ang = (float)pos * inv;
                rope[e] = cosf(ang); rope[1024 + e] = sinf(ang); }
            if (tid < 4) { const gf32* lp = FIN(25) + tid * 256; float s0 = 0.f, s1 = 0.f;
                for (int d = 0; d < 64; ++d) { s0 += lp[d] * lp[64 + d]; s1 += lp[128 + d] * lp[192 + d]; }
                const float lam_init = 0.8f - 0.6f * expf(-0.3f * (float)tid);
                ((gf32*)(F.ws + WS_LAM))[tid] = expf(s0) - expf(s1) + lam_init; }
        }
    }
}

DI void p1_norm(const Ctx& F, int l, int g) {
    const gf32* mod = (const gf32*)(F.ws + WS_MOD) + (size_t)l * 33 * 3072;
    const gf32* ng = FIN(6) + l * 1024;
    const gf32* xs = (l == 0) ? FIN(0) : F.out;
    const gf32* cs = (l == 0) ? FIN(2) : (const gf32*)(F.ws + WS_CTX);
    gu16* H = (gu16*)(F.ws + WS_H);
    int lz = ((int)threadIdx.x & 63); asm volatile("" : "+v"(lz));
    const int lane = lz;
    int row0 = blockIdx.x * 8 + F.wave; asm volatile("" : "+s"(row0));
    for (int row = row0; row < MG; row += F.G * 8) {
        const int bl = row / TT, t = row % TT, b = g * BGR + bl;
        const gf32* src; const gf32* md;
        if (t < NCTX) { src = cs + ((size_t)b * NCTX + t) * DM; md = mod + 32 * 3072; } else { src = xs + ((size_t)b * SEQ + (t - NCTX)) * DM; md = mod + b * 3072; }
        f32x4 v[4]; float ss = 0.f;
#pragma unroll
        for (int i = 0; i < 4; ++i) { v[i] = *(const GAS f32x4*)(src + i * 256 + lane * 4); ss += v[i][0] * v[i][0] + v[i][1] * v[i][1] + v[i][2] * v[i][2] + v[i][3] * v[i][3]; }
        ss = wave_sum(ss);
        const float rstd = rsqrtf(ss * (1.f / 1024.f) + EPS);
#pragma unroll
        for (int i = 0; i < 4; ++i) { const int c = i * 256 + lane * 4;
            const f32x4 gg = *(const GAS f32x4*)(ng + c), sh = *(const GAS f32x4*)(md + c), sc = *(const GAS f32x4*)(md + 1024 + c);
            const f32x4 y = v[i] * rstd * gg * (sc + 1.f) + sh;
            u32x2 w; w.x = pk2(y[0], y[1]); w.y = pk2(y[2], y[3]);
            *(GAS u32x2*)(H + (size_t)row * 1024 + c) = w; }
    }
}
DI void rope8(float* x, int j8, int t, const gf32* __restrict__ rope) {
    float p[8];
#pragma unroll
    for (int e = 0; e < 8; ++e) p[e] = __shfl_xor(x[e], 2);
    if (t < NCTX) return;
    const int s = t - NCTX, pos = (j8 & 4) ? (s & 63) : (s >> 6), i0 = 8 * (j8 & 1);
    const float sg = (j8 & 2) ? 1.f : -1.f;
#pragma unroll
    for (int e = 0; e < 8; ++e) { const float c = rope[pos * 16 + i0 + e], sn = rope[1024 + pos * 16 + i0 + e]; x[e] = x[e] * c + sg * p[e] * sn; }
}
DI float group_sum(float v, int n) {
    v += __shfl_xor(v, 1); v += __shfl_xor(v, 2); v += __shfl_xor(v, 4); if (n == 16) v += __shfl_xor(v, 8); return v;
}

DI void p3_rows(const Ctx& F, int l) {
    gu16* P = (gu16*)(F.ws + WS_P); gu16* XC = (gu16*)(F.ws + WS_XC);
    const gf32* rope = (const gf32*)(F.ws + WS_ROPE);
    const gf32* cw = FIN(17) + (size_t)l * 3 * 512; const gf32* cb = FIN(18) + l * 512;
    const gf32* qkg = FIN(24) + l * 128; const gf32* kg = FIN(13) + l * 192 + 128;
    int lz = ((int)threadIdx.x & 63); asm volatile("" : "+v"(lz));
    const int lane = lz, c8 = lane * 8, j8 = lane & 7;
    float w0[8], w1[8], w2[8], bb[8], gq[8], gk[8], gr[8];
#pragma unroll
    for (int e = 0; e < 8; ++e) { w0[e] = cw[c8 + e]; w1[e] = cw[512 + c8 + e]; w2[e] = cw[1024 + c8 + e]; bb[e] = cb[c8 + e];
        gq[e] = qkg[j8 * 8 + e]; gk[e] = qkg[64 + j8 * 8 + e]; gr[e] = kg[j8 * 8 + e]; }
    int row0 = blockIdx.x * 8 + F.wave; asm volatile("" : "+s"(row0));
    for (int row = row0; row < MG; row += F.G * 8) {
        const int t = row % TT; gu16* pr = P + (size_t)row * NP;
        const bool hasl = (t != 0 && t != NCTX), hasr = (t != NCTX - 1 && t != TT - 1);
        const u32x4 lx0 = *(const GAS u32x4*)(pr + C_MX + c8);
        const u32x4 lxm = *(const GAS u32x4*)(pr + (hasl ? -NP : 0) + C_MX + c8);
        const u32x4 lxp = *(const GAS u32x4*)(pr + (hasr ? NP : 0) + C_MX + c8);
        const u32x4 ldq = *(const GAS u32x4*)(pr + C_DQ + c8), ldk = *(const GAS u32x4*)(pr + C_DK + c8), lkr = *(const GAS u32x4*)(pr + C_KR + j8 * 8);
        float rc[8], rs_[8];
        { const int s = t < NCTX ? 0 : t - NCTX, pos = (j8 & 4) ? (s & 63) : (s >> 6), i0 = 8 * (j8 & 1);
#pragma unroll
          for (int e = 0; e < 8; ++e) { rc[e] = rope[pos * 16 + i0 + e]; rs_[e] = rope[1024 + pos * 16 + i0 + e]; }
          if (t < NCTX) {
#pragma unroll
              for (int e = 0; e < 8; ++e) { rc[e] = 1.f; rs_[e] = 0.f; } } }
        const float sg = (j8 & 2) ? 1.f : -1.f;
        { float x0[8], xm[8], xp[8], o[8]; unpack8(lx0, x0); unpack8(lxm, xm); unpack8(lxp, xp);
#pragma unroll
          for (int e = 0; e < 8; ++e) { float a = bb[e] + w1[e] * x0[e]; a += hasl ? w0[e] * xm[e] : 0.f; a += hasr ? w2[e] * xp[e] : 0.f; o[e] = silu_f(a); }
          *(GAS u32x4*)(XC + (size_t)row * 512 + c8) = pack8(o); }
#pragma unroll
        for (int which = 0; which < 3; ++which) {
            float x[8]; unpack8(which == 0 ? ldq : (which == 1 ? ldk : lkr), x);
            float ss = 0.f;
#pragma unroll
            for (int e = 0; e < 8; ++e) ss += x[e] * x[e];
            ss = group_sum(ss, 8); const float rstd = rsqrtf(ss * (1.f / 64.f) + EPS);
#pragma unroll
            for (int e = 0; e < 8; ++e) x[e] = x[e] * rstd * (which == 0 ? gq[e] : (which == 1 ? gk[e] : gr[e]));
            float pp[8];
#pragma unroll
            for (int e = 0; e < 8; ++e) pp[e] = __shfl_xor(x[e], 2);
#pragma unroll
            for (int e = 0; e < 8; ++e) x[e] = x[e] * rc[e] + sg * pp[e] * rs_[e];
            if (which == 0) *(GAS u32x4*)(pr + C_DQ + c8) = pack8(x);
            else if (which == 1) *(GAS u32x4*)(pr + C_DK + c8) = pack8(x);
            else if (lane < 8) *(GAS u32x4*)(pr + C_KR + j8 * 8) = pack8(x);
        }
    }
}

DI float wave_incl_sum(float v, int lane) {
#pragma unroll
    for (int o = 1; o < 64; o <<= 1) { const float t = __shfl_up(v, o); if (lane >= o) v += t; }
    return v;
}
DI float wave_incl_max(float v, int lane) {
#pragma unroll
    for (int o = 1; o < 64; o <<= 1) { const float t = __shfl_up(v, o); if (lane >= o) v = fmaxf(v, t); }
    return v;
}
DI void p3_gates(const Ctx& F, int l) {
    const gu16* P = (const gu16*)(F.ws + WS_P);
    gf32* BGp = (gf32*)(F.ws + WS_BG); gf32* SC = (gf32*)(F.ws + WS_SCAL);
    LAS float* af = (LAS float*)F.lds;
    LAS float* gi = af + 64 * 32;
    int tz = (int)threadIdx.x; asm volatile("" : "+v"(tz));
    const int tid = tz, lane = tid & 63, wv = tid >> 6;
    const int dir = tid >> 8, col = tid & 255;
    float aw[16];
#pragma unroll
    for (int r = 0; r < 16; ++r) aw[r] = FIN(14)[(((size_t)l * 2 + dir) * 16 + r) * 256 + col];
    const float ab = FIN(15)[((size_t)l * 2 + dir) * 256 + col];
    const int md = wv >> 2, mh = wv & 3, mg0 = md * 2, mtk = md ? 63 - lane : lane;
    const float mbi = FIN(21)[l * 16 + mg0 * 4 + mh], mbf = FIN(21)[l * 16 + (mg0 + 1) * 4 + mh];
    for (int ch = blockIdx.x; ch < MG / 64; ch += F.G) {
        const size_t r0 = (size_t)ch * 64;
        __syncthreads();
        if (tid < 256) { const int r = tid >> 2, q = tid & 3; float f[8]; unpack8(*(const GAS u32x4*)(P + (r0 + r) * NP + C_AF + q * 8), f);
            *(LAS f32x4*)(af + r * 32 + q * 8) = (f32x4){f[0], f[1], f[2], f[3]}; *(LAS f32x4*)(af + r * 32 + q * 8 + 4) = (f32x4){f[4], f[5], f[6], f[7]}; }
        else if (tid < 384) { const int r = (tid - 256) >> 1, q = tid & 1; float f[8]; unpack8(*(const GAS u32x4*)(P + (r0 + r) * NP + C_IF + q * 8), f);
            *(LAS f32x4*)(gi + r * 16 + q * 8) = (f32x4){f[0], f[1], f[2], f[3]}; *(LAS f32x4*)(gi + r * 16 + q * 8 + 4) = (f32x4){f[4], f[5], f[6], f[7]}; }
        __syncthreads();
        { float run = 0.f; gf32* bo = BGp + ((size_t)dir * MG + r0) * 256 + col;
          for (int i = 0; i < 64; ++i) { const int tk = dir ? 63 - i : i;
              const LAS f32x4* ar = (const LAS f32x4*)(af + tk * 32 + dir * 16);
              const f32x4 a0 = ar[0], a1 = ar[1], a2 = ar[2], a3 = ar[3];
              float x = ab + a0[0] * aw[0] + a0[1] * aw[1] + a0[2] * aw[2] + a0[3] * aw[3] + a1[0] * aw[4] + a1[1] * aw[5] + a1[2] * aw[6] + a1[3] * aw[7]
                           + a2[0] * aw[8] + a2[1] * aw[9] + a2[2] * aw[10] + a2[3] * aw[11] + a3[0] * aw[12] + a3[1] * aw[13] + a3[2] * aw[14] + a3[3] * aw[15];
              run += logsig_f(x) * (1.f / 16.f); bo[(size_t)tk * 256] = run; } }
        { const float li = gi[mtk * 16 + mg0 * 4 + mh] + mbi, lfv = logsig_f(gi[mtk * 16 + (mg0 + 1) * 4 + mh] + mbf);
          const float b = wave_incl_sum(lfv, lane), a = li - b, pm = wave_incl_max(a, lane);
          *(GAS f32x4*)(SC + (((size_t)md * MG + r0 + mtk) * 4 + mh) * 4) = (f32x4){b, a, pm, 0.f}; }
    }
}

DI void p3b_rows(const Ctx& F, int l) {
    const gu16* P = (const gu16*)(F.ws + WS_P); gu16* Q = (gu16*)(F.ws + WS_Q); gu16* KV = (gu16*)(F.ws + WS_KV);
    const gf32* rope = (const gf32*)(F.ws + WS_ROPE);
    const gf32* qg = FIN(12) + l * 192; const gf32* kg = FIN(13) + l * 192;
    int lz = ((int)threadIdx.x & 63); asm volatile("" : "+v"(lz));
    const int lane = lz, c8 = lane * 8, j8 = lane & 7, l32 = lane & 31, d0 = (lane & 15) * 8;
    float gqn[8], gqr[8], gkn[8];
#pragma unroll
    for (int e = 0; e < 8; ++e) { gqn[e] = qg[d0 + e]; gqr[e] = qg[128 + j8 * 8 + e]; gkn[e] = kg[d0 + e]; }
    int row0 = blockIdx.x * 8 + F.wave; asm volatile("" : "+s"(row0));
    for (int row = row0; row < MG; row += F.G * 8) {
        const int t = row % TT; const gu16* pr = P + (size_t)row * NP;
        const u32x4 lcq = *(const GAS u32x4*)(pr + C_CQ + (lane < 48 ? c8 : 0)), lck = *(const GAS u32x4*)(pr + C_CKV + (lane < 32 ? c8 : 0));
        const u32x4 lqn = *(const GAS u32x4*)(Q + (size_t)row * 768 + c8), lqr = *(const GAS u32x4*)(Q + (size_t)row * 768 + 512 + l32 * 8);
        const u32x4 lkn = *(const GAS u32x4*)(KV + (size_t)row * 1024 + c8), lvv = *(const GAS u32x4*)(KV + (size_t)row * 1024 + 512 + c8);
        float rc[8], rs_[8];
        { const int s = t < NCTX ? 0 : t - NCTX, pos = (j8 & 4) ? (s & 63) : (s >> 6), i0 = 8 * (j8 & 1);
#pragma unroll
          for (int e = 0; e < 8; ++e) { rc[e] = rope[pos * 16 + i0 + e]; rs_[e] = rope[1024 + pos * 16 + i0 + e]; }
          if (t < NCTX) {
#pragma unroll
              for (int e = 0; e < 8; ++e) { rc[e] = 1.f; rs_[e] = 0.f; } } }
        const float sg = (j8 & 2) ? 1.f : -1.f;
        float ss = 0.f;
        { float x[8]; unpack8(lcq, x);
#pragma unroll
          for (int e = 0; e < 8; ++e) ss += x[e] * x[e]; }
        const float rq = rsqrtf(wave_sum(lane < 48 ? ss : 0.f) * (1.f / 384.f) + EPS);
        ss = 0.f;
        { float x[8]; unpack8(lck, x);
#pragma unroll
          for (int e = 0; e < 8; ++e) ss += x[e] * x[e]; }
        const float rk = rsqrtf(wave_sum(lane < 32 ? ss : 0.f) * (1.f / 256.f) + EPS);
        { float x[8]; unpack8(lqn, x); float s2 = 0.f;
#pragma unroll
          for (int e = 0; e < 8; ++e) { x[e] *= rq; s2 += x[e] * x[e]; }
          s2 = group_sum(s2, 16); const float rs = rsqrtf(s2 * (1.f / 128.f) + EPS);
#pragma unroll
          for (int e = 0; e < 8; ++e) x[e] = x[e] * rs * gqn[e];
          *(GAS u32x4*)(Q + (size_t)row * 768 + c8) = pack8(x); }
        { float x[8]; unpack8(lqr, x); float s2 = 0.f;
#pragma unroll
          for (int e = 0; e < 8; ++e) { x[e] *= rq; s2 += x[e] * x[e]; }
          s2 = group_sum(s2, 8); const float rs = rsqrtf(s2 * (1.f / 64.f) + EPS);
#pragma unroll
          for (int e = 0; e < 8; ++e) x[e] = x[e] * rs * gqr[e];
          float pp[8];
#pragma unroll
          for (int e = 0; e < 8; ++e) pp[e] = __shfl_xor(x[e], 2);
#pragma unroll
          for (int e = 0; e < 8; ++e) x[e] = x[e] * rc[e] + sg * pp[e] * rs_[e];
          if (lane < 32) *(GAS u32x4*)(Q + (size_t)row * 768 + 512 + l32 * 8) = pack8(x); }
        { float x[8]; unpack8(lkn, x); float s2 = 0.f;
#pragma unroll
          for (int e = 0; e < 8; ++e) { x[e] *= rk; s2 += x[e] * x[e]; }
          s2 = group_sum(s2, 16); const float rs = rsqrtf(s2 * (1.f / 128.f) + EPS);
#pragma unroll
          for (int e = 0; e < 8; ++e) x[e] = x[e] * rs * gkn[e];
          *(GAS u32x4*)(KV + (size_t)row * 1024 + c8) = pack8(x); }
        { float x[8]; unpack8(lvv, x);
#pragma unroll
          for (int e = 0; e < 8; ++e) x[e] *= rk;
          *(GAS u32x4*)(KV + (size_t)row * 1024 + 512 + c8) = pack8(x); }
    }
}
constexpr int AT_KN = 16384, AT_KR = 8192, AT_V = 16384;
constexpr int AT_BUF = AT_V + AT_KN + AT_KR;
constexpr int AT_WS = 147456;
constexpr int AT_EST = 132;
template <int MODE>
DI void attn_unit(const Ctx& F, int l, int bl, int h, int q0, int nkeys) {
#ifdef TPROBE
    const unsigned long long tatt0 = __builtin_amdgcn_s_memrealtime();
#endif
    int tz = (int)threadIdx.x; asm volatile("" : "+v"(tz));
    const int tid = tz, wid = F.wave, lane = tz & 63;
    LAS unsigned char* lds = F.lds;
    const gu16* P = (const gu16*)(F.ws + WS_P); const gu16* Qb = (const gu16*)(F.ws + WS_Q); const gu16* KVb = (const gu16*)(F.ws + WS_KV);
    const size_t rb = (size_t)bl * TT;
    constexpr int NDQ = MODE == 0 ? 12 : 4;
    const float SC = MODE == 0 ? 0.07216878364870322f : 0.125f;
    const float C = SC * 1.4426950408889634f;
    LAS float* wsf = (LAS float*)(lds + AT_WS) + wid * 64;
    const int r32 = lane & 31, hi = lane >> 5;
    const int qrow = q0 + (MODE == 0 ? wid * 32 : (wid & 3) * 32) + r32;
    bf16x8 qr[NDQ];
    if constexpr (MODE == 0) { const gu16* qp = Qb + (rb + qrow) * 768;
#pragma unroll
        for (int d0 = 0; d0 < 8; ++d0) qr[d0] = *(const GAS bf16x8*)(qp + h * 128 + d0 * 16 + hi * 8);
#pragma unroll
        for (int d0 = 0; d0 < 4; ++d0) qr[8 + d0] = *(const GAS bf16x8*)(qp + 512 + h * 64 + d0 * 16 + hi * 8);
    } else { const gu16* qp = P + (rb + qrow) * NP + C_DQ + h * 128 + (wid >> 2) * 64;
#pragma unroll
        for (int d0 = 0; d0 < 4; ++d0) qr[d0] = *(const GAS bf16x8*)(qp + d0 * 16 + hi * 8); }
    const int sr = tid >> 4, sc = (tid & 15) * 8, vst0 = v_st(sr, sc), vst1 = v_st(32 + sr, sc);
    const int kr_r = tid >> 3, kr_c = (tid & 7) * 8;
    const gu16* kbase; const gu16* vbase; size_t kld;
    if (MODE == 0) { kbase = KVb + rb * 1024 + h * 128; vbase = KVb + rb * 1024 + 512 + h * 128; kld = 1024; }
    else { kbase = P + rb * NP + C_DK + h * 128; vbase = P + rb * NP + C_DV + h * 128; kld = NP; }
    const gu16* krbase = P + rb * NP + C_KR;
    u32x4 sv0, sv1, sk0, sk1, skr;
#define SLOAD(k0) do { sv0 = *(const GAS u32x4*)(vbase + (size_t)((k0) + sr) * kld + sc); sv1 = *(const GAS u32x4*)(vbase + (size_t)((k0) + 32 + sr) * kld + sc); \
        sk0 = *(const GAS u32x4*)(kbase + (size_t)((k0) + sr) * kld + sc); sk1 = *(const GAS u32x4*)(kbase + (size_t)((k0) + 32 + sr) * kld + sc); \
        if (MODE == 0) skr = *(const GAS u32x4*)(krbase + (size_t)((k0) + kr_r) * NP + kr_c); } while (0)
#define SWRITE(b) do { LAS unsigned char* bb = lds + (b) * AT_BUF; *(LAS u32x4*)(bb + vst0) = sv0; *(LAS u32x4*)(bb + vst1) = sv1; \
        *(LAS u32x4*)(bb + AT_V + kswz(sr, sc * 2)) = sk0; *(LAS u32x4*)(bb + AT_V + kswz(32 + sr, sc * 2)) = sk1; \
        if (MODE == 0) *(LAS u32x4*)(bb + AT_V + AT_KN + swz64(kr_r, kr_c * 2)) = skr; } while (0)
    float m_reg = -1e30f, l_reg = 0.f; f32x16 o[4];
#pragma unroll
    for (int d = 0; d < 4; ++d)
#pragma unroll
        for (int r = 0; r < 16; ++r) o[d][r] = 0.f;
    const int NT = nkeys / 64;
    const int vrb = (int)(uintptr_t)lds + v_rd_base(lane);
    const int kcol0 = (MODE == 1) ? (wid >> 2) * 128 : 0;
    SLOAD(0); SWRITE(0); if (NT > 1) SLOAD(64); __syncthreads();
    for (int j = 0; j < NT; ++j) {
        const int cur = j & 1;
        f32x16 p0, p1;
#pragma unroll
        for (int r = 0; r < 16; ++r) { p0[r] = 0.f; p1[r] = 0.f; }
        { const LAS unsigned char* kb = lds + cur * AT_BUF + AT_V;
#pragma unroll
          for (int d0 = 0; d0 < (MODE == 0 ? 8 : 4); ++d0) { const int cb = kcol0 + (d0 * 16 + hi * 8) * 2;
              const bf16x8 b0 = ldsv(kb + kswz(r32, cb)), b1 = ldsv(kb + kswz(32 + r32, cb));
              p0 = MFMA32(b0, qr[d0], p0); p1 = MFMA32(b1, qr[d0], p1); }
          if constexpr (MODE == 0) {
#pragma unroll
              for (int d0 = 0; d0 < 4; ++d0) { const int cb = (d0 * 16 + hi * 8) * 2;
                  const bf16x8 b0 = ldsv(kb + AT_KN + swz64(r32, cb)), b1 = ldsv(kb + AT_KN + swz64(32 + r32, cb));
                  p0 = MFMA32(b0, qr[8 + d0], p0); p1 = MFMA32(b1, qr[8 + d0], p1); } } }
        if (j + 1 < NT) SWRITE(cur ^ 1);
        SBAR();
        float pmax = p0[0];
#pragma unroll
        for (int r = 1; r < 16; ++r) pmax = fmaxf(pmax, p0[r]);
#pragma unroll
        for (int r = 0; r < 16; ++r) pmax = fmaxf(pmax, p1[r]);
        pmax = half_swap_max(pmax);
        float mn, alpha;
        if (__all((pmax - m_reg) * SC <= 8.f)) { mn = m_reg; alpha = 1.f; }
        else { mn = fmaxf(m_reg, pmax); alpha = __builtin_amdgcn_exp2f((m_reg - mn) * C); m_reg = mn; }
        const float mnC = -mn * C; float ps = 0.f;
#pragma unroll
        for (int r = 0; r < 16; ++r) { p0[r] = __builtin_amdgcn_exp2f(fmaf(p0[r], C, mnC)); ps += p0[r]; }
#pragma unroll
        for (int r = 0; r < 16; ++r) { p1[r] = __builtin_amdgcn_exp2f(fmaf(p1[r], C, mnC)); ps += p1[r]; }
        ps = half_swap_sum(ps);
        l_reg = l_reg * alpha + ps;
        bf16x8 pa[4]; p_to_afrag(p0, p1, pa);
        SBAR();
        if (j + 2 < NT) SLOAD((j + 2) * 64);
        if (__any(alpha < 1.f)) { if (hi == 0) wsf[r32] = alpha; asm volatile("s_waitcnt lgkmcnt(0)" ::: "memory");
#pragma unroll
            for (int r = 0; r < 16; ++r) { const float a = wsf[crow(r, hi)];
#pragma unroll
                for (int d = 0; d < 4; ++d) o[d][r] *= a; } }
#pragma unroll
        for (int d0 = 0; d0 < 4; ++d0) { bf16x8 vf[4]; v_frags(vrb + cur * AT_BUF + d0 * 512, vf);
#pragma unroll
            for (int ks = 0; ks < 4; ++ks) o[d0] = MFMA32(pa[ks], vf[ks], o[d0]); }
        __syncthreads();
    }
#undef SLOAD
#undef SWRITE
    int lz = lane; asm volatile("" : "+v"(lz));
    const int er = lz & 31, eh = lz >> 5;
    if (eh == 0) wsf[er] = l_reg; asm volatile("s_waitcnt lgkmcnt(0)" ::: "memory");
    float rli[16];
#pragma unroll
    for (int r = 0; r < 16; ++r) rli[r] = __builtin_amdgcn_rcpf(wsf[crow(r, eh)]);
    if constexpr (MODE == 0) {
        gu16* Y = (gu16*)(F.ws + WS_Y);
        const size_t row0 = rb + q0 + wid * 32;
        LAS float* et = (LAS float*)(lds + wid * (32 * AT_EST * 4));
#pragma unroll
        for (int r = 0; r < 16; ++r)
#pragma unroll
            for (int d0 = 0; d0 < 4; ++d0) et[crow(r, eh) * AT_EST + d0 * 32 + er] = o[d0][r] * rli[r];
        asm volatile("s_waitcnt lgkmcnt(0)" ::: "memory");
        u32x4 zz[8];
#pragma unroll
        for (int ps = 0; ps < 8; ++ps) { const int idx = ps * 64 + lz, row = idx >> 4, ch = idx & 15; zz[ps] = *(const GAS u32x4*)(P + (row0 + row) * NP + C_MZ + h * 128 + ch * 8); }
#pragma unroll
        for (int ps = 0; ps < 8; ++ps) { const int idx = ps * 64 + lz, row = idx >> 4, ch = idx & 15;
            const f32x4 a = *(const LAS f32x4*)(et + row * AT_EST + ch * 8), b = *(const LAS f32x4*)(et + row * AT_EST + ch * 8 + 4);
            float z[8]; unpack8(zz[ps], z);
#pragma unroll
            for (int e = 0; e < 8; ++e) z[e] = silu_f(z[e]);
            float f[8] = {a[0] * z[0], a[1] * z[1], a[2] * z[2], a[3] * z[3], b[0] * z[4], b[1] * z[5], b[2] * z[6], b[3] * z[7]};
            *(GAS u32x4*)(Y + (row0 + row) * 512 + h * 128 + ch * 8) = pack8(f); }
    } else {
        LAS float* ex = (LAS float*)lds;
        const int lr0 = (wid & 3) * 32;
        if (wid >= 4) {
#pragma unroll
            for (int r = 0; r < 16; ++r)
#pragma unroll
                for (int d0 = 0; d0 < 4; ++d0) ex[(lr0 + crow(r, eh)) * AT_EST + d0 * 32 + er] = o[d0][r] * rli[r];
        }
        __syncthreads();
        if (wid < 4) {
            const float lam = ((const gf32*)(F.ws + WS_LAM))[l];
            const float lam_init = 0.8f - 0.6f * __expf(-0.3f * (float)l);
            const gf32* og = FIN(26) + l * 128;
            gu16* Y = (gu16*)(F.ws + WS_Y) + (size_t)3 * MG * 512;
            const size_t row0 = rb + q0 + lr0;
            u32x4 zz[8];
#pragma unroll
            for (int ps = 0; ps < 8; ++ps) { const int idx = ps * 64 + lz, row = idx >> 4, ch = idx & 15; zz[ps] = *(const GAS u32x4*)(P + (row0 + row) * NP + C_DZ + h * 128 + ch * 8); }
            float gg[4];
#pragma unroll
            for (int d0 = 0; d0 < 4; ++d0) gg[d0] = og[d0 * 32 + er] * (1.f - lam_init);
#pragma unroll
            for (int r = 0; r < 16; ++r) { const int lr = lr0 + crow(r, eh); float v[4]; float ss = 0.f;
#pragma unroll
                for (int d0 = 0; d0 < 4; ++d0) { v[d0] = o[d0][r] * rli[r] - lam * ex[lr * AT_EST + d0 * 32 + er]; ss += v[d0] * v[d0]; }
                ss += __shfl_xor(ss, 1); ss += __shfl_xor(ss, 2); ss += __shfl_xor(ss, 4); ss += __shfl_xor(ss, 8); ss += __shfl_xor(ss, 16);
                const float rs = rsqrtf(ss * (1.f / 128.f) + EPS);
#pragma unroll
                for (int d0 = 0; d0 < 4; ++d0) ex[lr * AT_EST + d0 * 32 + er] = v[d0] * rs * gg[d0]; }
            asm volatile("s_waitcnt lgkmcnt(0)" ::: "memory");
#pragma unroll
            for (int ps = 0; ps < 8; ++ps) { const int idx = ps * 64 + lz, row = idx >> 4, ch = idx & 15;
                const f32x4 a = *(const LAS f32x4*)(ex + (lr0 + row) * AT_EST + ch * 8), b = *(const LAS f32x4*)(ex + (lr0 + row) * AT_EST + ch * 8 + 4);
                float z[8]; unpack8(zz[ps], z);
#pragma unroll
                for (int e = 0; e < 8; ++e) z[e] = silu_f(z[e]);
                float f[8] = {a[0] * z[0], a[1] * z[1], a[2] * z[2], a[3] * z[3], b[0] * z[4], b[1] * z[5], b[2] * z[6], b[3] * z[7]};
                *(GAS u32x4*)(Y + (row0 + row) * 512 + h * 128 + ch * 8) = pack8(f); }
        }
        __syncthreads();
    }
#ifdef TPROBE
    if (threadIdx.x == 0 && nkeys == TT) __hip_atomic_fetch_add((GAS unsigned long long*)(F.ctl + 8192) + 24 + MODE, __builtin_amdgcn_s_memrealtime() - tatt0, __ATOMIC_RELAXED, __HIP_MEMORY_SCOPE_AGENT);
#endif
}
constexpr int SC_DIR = 40960;
constexpr int SC_QB = 0, SC_KA = 8192, SC_KT = 16384, SC_VI = 24576;
constexpr int SC_ST = 2 * SC_DIR;
constexpr int SC_SCL = SC_ST + 8 * 4096;
constexpr int SC_OST = SC_SCL + 8192;
constexpr int SC_PA = SC_OST + 8 * 2560;
static_assert(SC_PA + 2 * 8192 <= LDS_MISC, "scan LDS map");
template <int MIX>
DI void scan_unit(const Ctx& F, int l, int bl, int h) {
    int tz = (int)threadIdx.x; asm volatile("" : "+v"(tz));
    const int tid = tz, wid = F.wave, lane = tz & 63;
    const int dir = wid >> 2, w4 = wid & 3, tl = tid & 255;
    LAS unsigned char* lds = F.lds;
    LAS unsigned char* db = lds + dir * SC_DIR;
    LAS unsigned char* stp = lds + SC_ST + wid * 4096;
    LAS float* scl = (LAS float*)(lds + SC_SCL + dir * 4096);
    LAS float* xch = scl + 256 + w4 * 32;
    const gu16* P = (const gu16*)(F.ws + WS_P);
    const size_t rb = (size_t)bl * TT;
    gu16* osc = (gu16*)(F.ws + WS_OSC) + ((size_t)(MIX * 2 + dir) * MG) * 512;
    for (int e = lane; e < 1024; e += 64) ((LAS unsigned*)stp)[e] = 0u;
    if (tid < 128) { const int d2 = tid >> 6; ((LAS float*)(lds + SC_SCL + d2 * 4096))[192 + (tid & 63)] = 0.f; }
    f32x16 S[2];
#pragma unroll
    for (int k = 0; k < 2; ++k)
#pragma unroll
        for (int r = 0; r < 16; ++r) S[k][r] = 0.f;
    float m_run = 0.f;
    const int pi = tl >> 2, pd0 = (tl & 3) * 16;
    const int vr = tl >> 4, vc = (tl & 15) * 8;
    const int vrb = (int)(uintptr_t)db + SC_VI + v_rd_base(lane) + w4 * 512;
    u32x4 rq[2], rk[2], rv[4]; f32x4 rb4[4], rl4[1];
#define TOK(c, i) (dir == 0 ? (c) * 64 + (i) : ((c) < 4 ? (3 - (c)) : (39 - (c))) * 64 + 63 - (i))
#define CLOAD(c) do { const size_t g = rb + TOK(c, pi), gl = rb + TOK(c, 63); \
        if (MIX == 0) { const gu16* qp = P + g * NP + C_GQ + h * 64 + pd0; rq[0] = *(const GAS u32x4*)qp; rq[1] = *(const GAS u32x4*)(qp + 8); \
            const gu16* kp = P + g * NP + C_GK + h * 64 + pd0; rk[0] = *(const GAS u32x4*)kp; rk[1] = *(const GAS u32x4*)(kp + 8); \
            const gf32* bp = (const gf32*)(F.ws + WS_BG) + ((size_t)dir * MG + g) * 256 + h * 64 + pd0; \
            _Pragma("unroll") for (int z = 0; z < 4; ++z) rb4[z] = *(const GAS f32x4*)(bp + 4 * z); \
        } else { const gu16* qp = (const gu16*)(F.ws + WS_QKML) + g * 512 + h * 64 + pd0; rq[0] = *(const GAS u32x4*)qp; rq[1] = *(const GAS u32x4*)(qp + 8); \
            rk[0] = *(const GAS u32x4*)(qp + 256); rk[1] = *(const GAS u32x4*)(qp + 264); \
            rb4[0] = *(const GAS f32x4*)((const gf32*)(F.ws + WS_SCAL) + (((size_t)dir * MG + g) * 4 + h) * 4); rl4[0] = *(const GAS f32x4*)((const gf32*)(F.ws + WS_SCAL) + (((size_t)dir * MG + gl) * 4 + h) * 4); } } while (0)
#define VLOAD(c) do { _Pragma("unroll") for (int z = 0; z < 4; ++z) rv[z] = *(const GAS u32x4*)(P + (rb + TOK(c, vr + 16 * z)) * NP + (MIX == 0 ? C_GV : C_MV) + h * 128 + vc); } while (0)
    CLOAD(0); VLOAD(0);
    __syncthreads();
#ifdef TPROBE
    unsigned long long tacc0 = 0, tacc1 = 0, tacc2 = 0, tacc3 = 0, tacc4 = 0, tacc5 = 0, tacc6 = 0; const unsigned long long tunit0 = __builtin_amdgcn_s_memrealtime(); unsigned long long tprev = tunit0;
#define TSTAMP(acc) do { const unsigned long long tn_ = __builtin_amdgcn_s_memrealtime(); acc += tn_ - tprev; tprev = tn_; } while (0)
#else
#define TSTAMP(acc) do { } while (0)
#endif
    for (int c = 0; c < 36; ++c) {
        float m_new = 0.f, decay = 1.f, M63 = 0.f;
#ifndef REP_SPREP
#define REP_SPREP 1
#endif
#ifndef REP_SQB
#define REP_SQB 1
#endif
        _Pragma("nounroll") for (int rep = 0; rep < REP_SPREP; ++rep) {
        { float q[16], k[16]; unpack8(rq[0], q); unpack8(rq[1], q + 8); unpack8(rk[0], k); unpack8(rk[1], k + 8);
          float qe[16], ke[16], kt[16];
          if (MIX == 0) {
#pragma unroll
              for (int e = 0; e < 16; ++e) { const float bb = rb4[e >> 2][e & 3];
                  qe[e] = q[e] * __expf(bb); ke[e] = k[e] * __expf(-bb); kt[e] = ke[e]; }
              if (pi == 63) {
#pragma unroll
                  for (int e = 0; e < 16; ++e) scl[pd0 + e] = __expf(rb4[e >> 2][e & 3]); }
          } else {
              const float b_i = rb4[0][0], a_i = rb4[0][1], pm_i = rb4[0][2], bL = rl4[0][0], pmL = rl4[0][2];
              M63 = fmaxf(m_run, pmL); m_new = bL + M63; decay = __expf(m_run - M63);
              const float wu = __expf(a_i - M63);
#pragma unroll
              for (int e = 0; e < 16; ++e) { qe[e] = q[e]; ke[e] = k[e]; kt[e] = k[e] * wu; }
              float qn = 0.f;
#pragma unroll
              for (int e = 0; e < 16; ++e) qn += q[e] * scl[192 + pd0 + e];
              qn += __shfl_xor(qn, 1); qn += __shfl_xor(qn, 2);
              if ((tl & 3) == 0) { scl[pi] = b_i; scl[64 + pi] = a_i; scl[128 + pi] = pm_i; scl[384 + pi] = qn; }
          }
          *(LAS u32x4*)(db + SC_QB + swz64(pi, pd0 * 2)) = pack8(qe); *(LAS u32x4*)(db + SC_QB + swz64(pi, pd0 * 2 + 16)) = pack8(qe + 8);
          *(LAS u32x4*)(db + SC_KA + swz64(pi, pd0 * 2)) = pack8(ke); *(LAS u32x4*)(db + SC_KA + swz64(pi, pd0 * 2 + 16)) = pack8(ke + 8);
#pragma unroll
          for (int e = 0; e < 16; ++e) *(LAS u16*)(db + SC_KT + swz64(pd0 + e, pi * 2)) = f2bf(kt[e]);
        }
#pragma unroll
        for (int z = 0; z < 4; ++z) *(LAS u32x4*)(db + SC_VI + v_st(vr + 16 * z, vc)) = rv[z];
        }
        if (c + 1 < 36) { CLOAD(c + 1); VLOAD(c + 1); }
        TSTAMP(tacc0);
        __syncthreads();
        TSTAMP(tacc1);
        int lz = lane; asm volatile("" : "+v"(lz));
        const int r32 = lz & 31, hi = lz >> 5;
        LAS unsigned char* pab = lds + SC_PA + dir * 8192;
        { const int sqb = w4 & 1, skh = w4 >> 1;
          bf16x8 qf[4];
#pragma unroll
          for (int ks = 0; ks < 4; ++ks) qf[ks] = ldsv(db + SC_QB + sqb * 4096 + swz64(r32, (ks * 16 + hi * 8) * 2));
          f32x16 p;
#pragma unroll
          for (int r = 0; r < 16; ++r) p[r] = 0.f;
#pragma unroll
          for (int ks = 0; ks < 4; ++ks) p = MFMA32(ldsv(db + SC_KA + skh * 4096 + swz64(r32, (ks * 16 + hi * 8) * 2)), qf[ks], p);
          const int qi = 32 * sqb + r32;
          if (MIX == 0) {
#pragma unroll
              for (int r = 0; r < 16; ++r) p[r] = (crow(r, hi) + 32 * skh <= qi) ? p[r] : 0.f;
          } else {
              const float Mq = fmaxf(m_run, scl[128 + qi]); float rs = 0.f;
              float av[16];
#pragma unroll
              for (int r = 0; r < 16; ++r) av[r] = scl[64 + 32 * skh + crow(r, hi)];
#pragma unroll
              for (int r = 0; r < 16; ++r) { const int kk = crow(r, hi) + 32 * skh; const float e = __expf(fminf(av[r] - Mq, 0.f));
                  p[r] = p[r] * ((kk <= qi) ? e : 0.f); rs += p[r]; }
              rs = half_swap_sum(rs);
              if (hi == 0) scl[448 + skh * 64 + qi] = rs;
          }
#pragma unroll
          for (int g4 = 0; g4 < 4; ++g4) { u32x2 w; w.x = pk2(p[4 * g4], p[4 * g4 + 1]); w.y = pk2(p[4 * g4 + 2], p[4 * g4 + 3]);
              *(LAS u32x2*)(pab + swz64(qi, (32 * skh + 8 * g4 + 4 * hi) * 2)) = w; }
        }
        TSTAMP(tacc2);
        __syncthreads();
        TSTAMP(tacc3);
        bf16x8 bs[4];
#pragma unroll
        for (int ks = 0; ks < 4; ++ks) bs[ks] = ldsv(stp + swz64(r32, (ks * 16 + hi * 8) * 2));
        bf16x8 vf[4]; v_frags(vrb, vf);
#pragma nounroll
        for (int qb2 = 0; qb2 < 2 * REP_SQB; ++qb2) { const int qb = qb2 & 1;
            f32x16 o;
#pragma unroll
            for (int r = 0; r < 16; ++r) o[r] = 0.f;
#pragma unroll
            for (int ks = 0; ks < 4; ++ks) o = MFMA32(ldsv(db + SC_QB + qb * 4096 + swz64(r32, (ks * 16 + hi * 8) * 2)), bs[ks], o);
            const int qi = 32 * qb + r32;
            float scale_q = 1.f;
            if (MIX == 1) {
                const float Mq = fmaxf(m_run, scl[128 + qi]);
                const float iw = __expf(m_run - Mq), den = iw * scl[384 + qi] + scl[448 + qi] + scl[512 + qi], mi = scl[qi] + Mq;
                scale_q = 1.f / fmaxf(fabsf(den), __expf(-mi));
#pragma unroll
                for (int r = 0; r < 16; ++r) o[r] *= __expf(m_run - fmaxf(m_run, scl[128 + 32 * qb + crow(r, hi)]));
            }
#pragma unroll
            for (int ks = 0; ks < 4; ++ks) o = MFMA32(ldsv(pab + qb * 4096 + swz64(r32, (ks * 16 + hi * 8) * 2)), vf[ks], o);
            if (MIX == 1) {
                if (hi == 0) xch[r32] = scale_q;
                asm volatile("s_waitcnt lgkmcnt(0)" ::: "memory");
#pragma unroll
                for (int r = 0; r < 16; ++r) o[r] *= xch[crow(r, hi)];
            }
            { LAS u16* ost = (LAS u16*)(lds + SC_OST + wid * 2560);
#pragma unroll
              for (int r = 0; r < 16; ++r) ost[crow(r, hi) * 40 + r32] = f2bf(o[r]);
              asm volatile("s_waitcnt lgkmcnt(0)" ::: "memory");
#pragma unroll
              for (int ps = 0; ps < 2; ++ps) { const int row = ps * 16 + (lz >> 2), ch = lz & 3;
                  const u32x4 v = *(const LAS u32x4*)(ost + row * 40 + ch * 8);
                  *(GAS u32x4*)(osc + (rb + TOK(c, 32 * qb + row)) * 512 + h * 128 + w4 * 32 + ch * 8) = v; } }
        }
        TSTAMP(tacc4);
        float nnew = 0.f;
#pragma unroll
        for (int dk = 0; dk < 2; ++dk) {
            if (MIX == 1) {
#pragma unroll
                for (int r = 0; r < 16; ++r) S[dk][r] *= decay;
            }
#pragma unroll
            for (int ks = 0; ks < 4; ++ks) { const bf16x8 a = ldsv(db + SC_KT + swz64(32 * dk + r32, (ks * 16 + hi * 8) * 2)); S[dk] = MFMA32(a, vf[ks], S[dk]); }
            if (MIX == 0) {
#pragma unroll
                for (int r = 0; r < 16; ++r) S[dk][r] *= scl[32 * dk + crow(r, hi)];
            }
        }
        if (MIX == 1 && w4 == 0) {
            float sum = 0.f;
#pragma unroll
            for (int j = 0; j < 8; ++j) { float kv[8]; unpack8(__builtin_bit_cast(u32x4, ldsv(db + SC_KT + swz64(lane, j * 16))), kv);
#pragma unroll
                for (int e = 0; e < 8; ++e) sum += kv[e]; }
            nnew = decay * scl[192 + lane] + sum;
            scl[192 + lane] = nnew;
        }
#pragma unroll
        for (int dk = 0; dk < 2; ++dk)
#pragma unroll
            for (int g4 = 0; g4 < 4; ++g4) { u32x2 w; w.x = pk2(S[dk][4 * g4], S[dk][4 * g4 + 1]); w.y = pk2(S[dk][4 * g4 + 2], S[dk][4 * g4 + 3]);
                *(LAS u32x2*)(stp + swz64(r32, (32 * dk + 8 * g4 + 4 * hi) * 2)) = w; }
        if (MIX == 1) m_run = m_new;
        TSTAMP(tacc5);
        __syncthreads();
        TSTAMP(tacc6);
    }
#undef CLOAD
    asm volatile("s_waitcnt vmcnt(0)" ::: "memory");
    __syncthreads();
    {
        const gu16* of = (const gu16*)(F.ws + WS_OSC) + ((size_t)(MIX * 2 + 0) * MG) * 512;
        const gu16* ob = (const gu16*)(F.ws + WS_OSC) + ((size_t)(MIX * 2 + 1) * MG) * 512;
        gu16* Y = (gu16*)(F.ws + WS_Y) + (size_t)(MIX == 0 ? 1 : 2) * MG * 512;
        const gf32* og = (MIX == 0 ? FIN(16) : FIN(22)) + l * 512 + h * 128;
        const gf32* skp = FIN(23) + l * 512 + h * 128;
        const gu16* XC = (const gu16*)(F.ws + WS_XC);
        int tq = (int)threadIdx.x; asm volatile("" : "+v"(tq));
        const int c8 = (tq & 15) * 8;
        float g8[8], s8[8];
#pragma unroll
        for (int e = 0; e < 8; ++e) { g8[e] = og[c8 + e]; s8[e] = (MIX == 1) ? skp[c8 + e] : 0.f; }
        for (int t0 = tq >> 4; t0 < TT; t0 += 128) {
            u32x4 la[4], lb[4], lz4[4], lo[4], lx[4];
#pragma unroll
            for (int u = 0; u < 4; ++u) { const size_t row = rb + t0 + 32 * u; const int col = h * 128 + c8;
                la[u] = *(const GAS u32x4*)(of + row * 512 + col); lb[u] = *(const GAS u32x4*)(ob + row * 512 + col);
                lz4[u] = *(const GAS u32x4*)(P + row * NP + (MIX == 0 ? C_GZ : C_MLZ) + col);
                if (MIX == 1) { lo[u] = *(const GAS u32x4*)(P + row * NP + C_MO + col); lx[u] = *(const GAS u32x4*)(XC + row * 512 + col); } }
#pragma unroll
            for (int u = 0; u < 4; ++u) { const size_t row = rb + t0 + 32 * u; const int col = h * 128 + c8;
                float a[8], b[8], v[8]; unpack8(la[u], a); unpack8(lb[u], b);
                float ss = 0.f;
                if (MIX == 1) { float og8[8]; unpack8(lo[u], og8);
#pragma unroll
                    for (int e = 0; e < 8; ++e) og8[e] = sigmoid_f(og8[e]);
#pragma unroll
                    for (int e = 0; e < 8; ++e) { v[e] = (a[e] + b[e]) * og8[e]; ss += v[e] * v[e]; }
                } else {
#pragma unroll
                    for (int e = 0; e < 8; ++e) { v[e] = a[e] + b[e]; ss += v[e] * v[e]; } }
                ss = group_sum(ss, 16);
                const float rs = rsqrtf(ss * (1.f / 128.f) + EPS);
                float z[8]; unpack8(lz4[u], z);
#pragma unroll
                for (int e = 0; e < 8; ++e) z[e] = silu_f(z[e]);
                if (MIX == 1) { float xc[8]; unpack8(lx[u], xc);
#pragma unroll
                    for (int e = 0; e < 8; ++e) v[e] = (v[e] * rs * g8[e] + s8[e] * xc[e]) * z[e];
                } else {
#pragma unroll
                    for (int e = 0; e < 8; ++e) v[e] = v[e] * rs * g8[e] * z[e]; }
                *(GAS u32x4*)(Y + row * 512 + col) = pack8(v); }
        }
    }
    __syncthreads();
#ifdef TPROBE
    if (threadIdx.x == 0) { GAS unsigned long long* tm = (GAS unsigned long long*)(F.ctl + 8192) + MIX * 8;
        const unsigned long long tall = __builtin_amdgcn_s_memrealtime() - tunit0;
        __hip_atomic_fetch_add(tm + 0, tacc0, __ATOMIC_RELAXED, __HIP_MEMORY_SCOPE_AGENT); __hip_atomic_fetch_add(tm + 1, tacc1, __ATOMIC_RELAXED, __HIP_MEMORY_SCOPE_AGENT);
        __hip_atomic_fetch_add(tm + 2, tacc2, __ATOMIC_RELAXED, __HIP_MEMORY_SCOPE_AGENT); __hip_atomic_fetch_add(tm + 3, tacc3, __ATOMIC_RELAXED, __HIP_MEMORY_SCOPE_AGENT);
        __hip_atomic_fetch_add(tm + 4, tacc4, __ATOMIC_RELAXED, __HIP_MEMORY_SCOPE_AGENT); __hip_atomic_fetch_add(tm + 5, tacc5, __ATOMIC_RELAXED, __HIP_MEMORY_SCOPE_AGENT);
        __hip_atomic_fetch_add(tm + 6, tacc6, __ATOMIC_RELAXED, __HIP_MEMORY_SCOPE_AGENT); __hip_atomic_fetch_add(tm + 7, tall, __ATOMIC_RELAXED, __HIP_MEMORY_SCOPE_AGENT); }
#endif
#undef TSTAMP
#undef TOK
}
struct BatchOrder {
    int base, cnt;
    DI bool next(int i, Unit& u) const { if (i >= cnt) return false; u.pm = base % (MG / 256); u.pn = (base / (MG / 256)) * cnt + i; return true; }
    DI void a_ready(const Unit&) const {}
    DI void done(const Unit&) const {}
};
constexpr int MG_BATCH = 4;
DI void p4_mixers(const Ctx& F, int l, int it) {
    const bool last = (l == DEPTH - 1);
    constexpr int N_SCAN = 2 * BGR * 4, N_MLA = BGR * 4 * 8, N_DF = BGR * 4 * 16, N_MLAC = BGR * 4, N_DFC = BGR * 4 * 2;
    constexpr int O_MLA = N_SCAN, O_DF = O_MLA + N_MLA, O_MLAC = O_DF + N_DF, O_DFC = O_MLAC + N_MLAC, N_ALL = O_DFC + N_DFC;
    constexpr int N_GEMM = 0;
    const int n_attn = last ? O_MLAC : N_ALL;
    const int total = n_attn + N_GEMM;
    GAS unsigned* head = F.ctl + CW_QUEUE + 64 * it;
    volatile LAS unsigned* misc = (volatile LAS unsigned*)(F.lds + LDS_MISC);
    for (;;) {
        __syncthreads();
        if ((int)threadIdx.x == 0) misc[0] = __hip_atomic_fetch_add(head, 1u, __ATOMIC_RELAXED, __HIP_MEMORY_SCOPE_AGENT);
        __syncthreads();
        int u = (int)misc[0];
        if (u >= total) break;
        if (u >= N_SCAN && u < N_SCAN + N_GEMM) {
            pg8::Gemm gm{(const gu16*)(F.ws + WS_H), (const gu16*)(F.ws + WS_WIN) + ((size_t)l * NP + C_MG) * 1024, MG, 4096, 1024, 1024};
            BatchOrder S{u - N_SCAN, MG_BATCH};
            EpiBf E{(gu16*)(F.ws + WS_P) + C_MG, NP, 2};
            pg8::gemm_phase<EpiBf, BatchOrder, true, true>(F.lds, gm, S, E);
            continue;
        }
#ifndef P4_MASK
#define P4_MASK 0xf
#endif
#ifndef REP_SCAN
#define REP_SCAN 1
#endif
#ifndef REP_MLA
#define REP_MLA 1
#endif
#ifndef REP_DF
#define REP_DF 1
#endif
        if (u >= N_SCAN) u -= N_GEMM;
        if (u < O_MLA) { const int mix = u >> 5, rem = u & 31, bl = rem >> 2, h = rem & 3;
            _Pragma("nounroll") for (int rep = 0; rep < REP_SCAN; ++rep) { if (mix == 0) { if (P4_MASK & 1) scan_unit<0>(F, l, bl, h); } else { if (P4_MASK & 2) scan_unit<1>(F, l, bl, h); } __syncthreads(); } }
        else if (u < O_DF) { const int v = u - O_MLA, bl = v >> 5, h = (v >> 3) & 3, qb = v & 7; _Pragma("nounroll") for (int rep = 0; rep < REP_MLA; ++rep) { if (P4_MASK & 4) attn_unit<0>(F, l, bl, h, NCTX + qb * 256, TT); __syncthreads(); } }
        else if (u < O_MLAC) { const int v = u - O_DF, bl = v >> 6, h = (v >> 4) & 3, qb = v & 15; _Pragma("nounroll") for (int rep = 0; rep < REP_DF; ++rep) { if (P4_MASK & 8) attn_unit<1>(F, l, bl, h, NCTX + qb * 128, TT); __syncthreads(); } }
        else if (u < O_DFC) { const int v = u - O_MLAC, bl = v >> 2, h = v & 3; if (P4_MASK & 4) attn_unit<0>(F, l, bl, h, 0, NCTX); }
        else { const int v = u - O_DFC, bl = v >> 3, h = (v >> 1) & 3, qb = v & 1; if (P4_MASK & 8) attn_unit<1>(F, l, bl, h, qb * 128, NCTX); }
    }
}

__global__ void __launch_bounds__(512, 2) fwd_kernel(Params prm) {
    extern __shared__ __attribute__((aligned(16))) unsigned char lds_raw[];
    Ctx F;
    F.in = prm.in;
    F.out = (gf32*)prm.out; F.ws = (gu8*)prm.ws; F.ctl = (GAS unsigned*)prm.ws;
    F.wave = __builtin_amdgcn_readfirstlane((int)threadIdx.x >> 6); F.G = gridDim.x;
    F.lds = (LAS unsigned char*)lds_raw;
    if ((int)threadIdx.x < 16) ((LAS unsigned*)(F.lds + LDS_MISC))[(int)threadIdx.x] = 0u;
    __syncthreads();
    XcdBarrier bar = xcd_barrier_post(F.ctl, (volatile LAS unsigned*)(F.lds + LDS_BARW));
    const int s_lo = prm.s_lo, s_hi = prm.s_hi;
#ifndef PH_MASK
#define PH_MASK 0xff
#endif
#define IN(s) (s_lo <= (s) && (s) < s_hi)
#define PHON(k) ((PH_MASK >> (k)) & 1)
#ifndef REP_P1
#define REP_P1 1
#endif
#ifndef REP_P2
#define REP_P2 1
#endif
#ifndef REP_P3G
#define REP_P3G 1
#endif
#ifndef REP_P3BG
#define REP_P3BG 1
#endif
#ifndef REP_P5
#define REP_P5 1
#endif
#ifndef REP_GATES
#define REP_GATES 1
#endif
#define FRESH() do { unsigned char* w_ = prm.ws; float* o_ = prm.out; asm volatile("" : "+s"(w_), "+s"(o_)); F.ws = (gu8*)w_; F.ctl = (GAS unsigned*)w_; F.out = (gf32*)o_; } while (0)
#ifdef TPROBE
    unsigned long long tph_prev = __builtin_amdgcn_s_memrealtime();
#define PSTAMP(k) do { if (blockIdx.x == 0 && threadIdx.x == 0) { const unsigned long long tn_ = __builtin_amdgcn_s_memrealtime(); __hip_atomic_fetch_add((GAS unsigned long long*)(F.ctl + 8192) + 16 + (k), tn_ - tph_prev, __ATOMIC_RELAXED, __HIP_MEMORY_SCOPE_AGENT); tph_prev = tn_; } } while (0)
#else
#define PSTAMP(k) do { } while (0)
#endif
#define SEAM(s) do { if ((s) + 1 < s_hi) { XcdBarrier b_ = bar; asm volatile("" : "+s"(b_.bar)); xcd_barrier(b_); } } while (0)
    if (PHON(0) && IN(0)) { FRESH(); p0_prologue(F); SEAM(0); PSTAMP(0); }
    for (int it = 0; it < DEPTH * NGRP; ++it) {
        const int l = it / NGRP, g = it % NGRP, sb = 1 + it * 7;
        if (sb + 7 <= s_lo || sb >= s_hi) continue;
        if (PHON(1) && IN(sb + 0)) { FRESH(); _Pragma("nounroll") for (int rep = 0; rep < REP_P1; ++rep) p1_norm(F, l, g); SEAM(sb + 0); PSTAMP(1); }
        if (PHON(2) && IN(sb + 1)) {
            FRESH(); gu16* Pb = (gu16*)(F.ws + WS_P);
            pg8::Gemm gm{(const gu16*)(F.ws + WS_H), (const gu16*)(F.ws + WS_WIN) + (size_t)l * NP * 1024, MG, NP, 1024, 1024};
            pg8::StaticOrder S; S.init(MG, NP, F.G, (int)blockIdx.x);
            EpiBf E{Pb, NP, 0};
            _Pragma("nounroll") for (int rep = 0; rep < REP_P2; ++rep) pg8::gemm_phase<EpiBf, pg8::StaticOrder, true, true>(F.lds, gm, S, E);
            SEAM(sb + 1); PSTAMP(2);
        }
        if (PHON(3) && IN(sb + 2)) {
            FRESH(); gu16* Pb = (gu16*)(F.ws + WS_P);
            _Pragma("nounroll") for (int rep = 0; rep < REP_P3G; ++rep) {
            { pg8::Gemm gm{Pb + C_CQ, (const gu16*)(F.ws + WS_WUQ) + (size_t)l * 768 * 384, MG, 768, 384, NP};
              pg8::StaticOrder S; S.init(MG, 768, F.G, (int)blockIdx.x);
              EpiBf E{(gu16*)(F.ws + WS_Q), 768, 0};
              pg8::gemm_phase<EpiBf, pg8::StaticOrder, true, true>(F.lds, gm, S, E); }
            { pg8::Gemm gm{Pb + C_CKV, (const gu16*)(F.ws + WS_WUKV) + (size_t)l * 1024 * 256, MG, 1024, 256, NP};
              int c2 = (int)blockIdx.x + 40; if (c2 >= F.G) c2 -= F.G;
              pg8::StaticOrder S; S.init(MG, 1024, F.G, c2);
              EpiBf E{(gu16*)(F.ws + WS_KV), 1024, 0};
              pg8::gemm_phase<EpiBf, pg8::StaticOrder, true, true>(F.lds, gm, S, E); }
            }
            __syncthreads();
            PSTAMP(11);
            p3_rows(F, l);
            PSTAMP(12);
            _Pragma("nounroll") for (int rep = 0; rep < REP_GATES; ++rep) p3_gates(F, l);
            PSTAMP(10);
            SEAM(sb + 2); PSTAMP(3);
        }
        if (PHON(4) && IN(sb + 3)) {
            FRESH();
            p3b_rows(F, l);
            _Pragma("nounroll") for (int rep = 0; rep < REP_P3BG; ++rep)
            { pg8::Gemm gm{(const gu16*)(F.ws + WS_XC), (const gu16*)(F.ws + WS_WQK) + (size_t)l * 512 * 512, MG, 512, 512, 512};
              pg8::StaticOrder S; S.init(MG, 512, F.G, (int)blockIdx.x);
              EpiBf E{(gu16*)(F.ws + WS_QKML), 512, 0};
              pg8::gemm_phase<EpiBf, pg8::StaticOrder, true, true>(F.lds, gm, S, E); }
            SEAM(sb + 3); PSTAMP(4);
        }
        if (PHON(5) && IN(sb + 4)) { FRESH(); p4_mixers(F, l, it); SEAM(sb + 4); PSTAMP(5); }
        if (PHON(6) && IN(sb + 5)) {
            FRESH(); gu16* Pb = (gu16*)(F.ws + WS_P);
#pragma nounroll
            for (int i4 = 0; i4 < 4 * REP_P5; ++i4) { const int i = i4 & 3;
                pg8::Gemm gm{(const gu16*)(F.ws + WS_Y) + (size_t)i * MG * 512, (const gu16*)(F.ws + WS_BR) + ((size_t)l * 4 + i) * 1024 * 512, MG, 1024, 512, 512};
                pg8::StaticOrder S; S.init(MG, 1024, F.G, (int)blockIdx.x);
                EpiMerge E{(gu16*)(F.ws + WS_MB), Pb + C_MG + i * 1024, i == 0 ? 0 : 1};
                pg8::gemm_phase<EpiMerge, pg8::StaticOrder, true, true>(F.lds, gm, S, E);
            }
            SEAM(sb + 5); PSTAMP(6);
        }
        if (PHON(7) && IN(sb + 6)) {
            FRESH();
            pg8::Gemm gm{(const gu16*)(F.ws + WS_MB), (const gu16*)(F.ws + WS_WO) + (size_t)l * 1024 * 1024, MG, 1024, 1024, 1024};
            pg8::StaticOrder S; S.init(MG, 1024, F.G, (int)blockIdx.x);
            EpiOut E{l == 0 ? FIN(0) : F.out, F.out, l == 0 ? FIN(2) : (const gf32*)(F.ws + WS_CTX), (gf32*)(F.ws + WS_CTX),
                     (const gf32*)(F.ws + WS_MOD) + (size_t)l * 33 * 3072, g, l == DEPTH - 1 ? 1 : 0};
            pg8::gemm_phase<EpiOut, pg8::StaticOrder, true, true>(F.lds, gm, S, E);
            SEAM(sb + 6); PSTAMP(7);
        }
    }
#ifdef TPROBE
    if (blockIdx.x == 0 && threadIdx.x == 0) {
        unsigned long long sum = 0;
#ifdef TPROBE_MASK
        for (int k = 0; k < 32; ++k) if ((TPROBE_MASK >> k) & 1) sum += __hip_atomic_load((GAS unsigned long long*)(F.ctl + 8192) + k, __ATOMIC_RELAXED, __HIP_MEMORY_SCOPE_AGENT);
#else
        sum = __hip_atomic_load((GAS unsigned long long*)(F.ctl + 8192) + TPROBE, __ATOMIC_RELAXED, __HIP_MEMORY_SCOPE_AGENT);
#endif
        const unsigned long long delay = sum * TPROBE_AMP / 512ull; const unsigned long long t0 = __builtin_amdgcn_s_memrealtime();
        while (__builtin_amdgcn_s_memrealtime() - t0 < delay) __builtin_amdgcn_s_sleep(8);
    }
#endif
#undef IN
#undef SEAM
}

extern "C" void kernel_launch(void* const* d_in, const int* in_sizes, int n_in, void* d_out, int out_size, void* d_ws, size_t ws_size, hipStream_t stream) {
    static int grid = 0;
    if (grid == 0) {
        if (n_in != 29 || out_size != NB * SEQ * DM || ws_size < WS_END) { fprintf(stderr, "kernel_launch: unexpected shapes (n_in %d, out %d, ws %zu < %zu)\n", n_in, out_size, ws_size, (size_t)WS_END); grid = -1; return; }
        int dev = 0, cus = 0, per_cu = 0;
        if (hipGetDevice(&dev) != hipSuccess || hipDeviceGetAttribute(&cus, hipDeviceAttributeMultiprocessorCount, dev) != hipSuccess) { grid = -1; return; }
        if (hipFuncSetAttribute((const void*)fwd_kernel, hipFuncAttributeMaxDynamicSharedMemorySize, LDS_BYTES) != hipSuccess) { fprintf(stderr, "kernel_launch: hipFuncSetAttribute failed\n"); grid = -1; return; }
        if (hipOccupancyMaxActiveBlocksPerMultiprocessor(&per_cu, (const void*)fwd_kernel, 512, LDS_BYTES) != hipSuccess || per_cu < 1) { fprintf(stderr, "kernel_launch: occupancy query reports %d blocks per CU\n", per_cu); }
        (void)hipGetLastError();
        grid = cus;
    }
    if (grid < 0) return;
    (void)hipMemsetAsync((char*)d_ws + WS_CTL, 0, CTL_BYTES, stream);
    Params p{};
    for (int i = 0; i < 29; ++i) p.in[i] = (const float*)d_in[i];
    p.out = (float*)d_out; p.ws = (unsigned char*)d_ws;
#if MK_MULTI
    for (int s = 0; s < NSTEP; ++s) { p.s_lo = s; p.s_hi = s + 1; hipLaunchKernelGGL(fwd_kernel, dim3(grid), dim3(512), LDS_BYTES, stream, p); }
#else
    p.s_lo = 0; p.s_hi = NSTEP;
    hipLaunchKernelGGL(fwd_kernel, dim3(grid), dim3(512), LDS_BYTES, stream, p);
#endif
    const hipError_t le = hipPeekAtLastError();
    if (le != hipSuccess) fprintf(stderr, "kernel_launch: launch failed: %s\n", hipGetErrorName(le));
}
```

```cpp
#include <hip/hip_runtime.h>
#include <cstdio>
#include <cstdint>
#include <cstddef>

#ifndef MK_MULTI
#define MK_MULTI 0
#endif

#define XB_TMO      128
#define XB_XCNT(j)  (256  + 64 * (j))
#define XB_XSUB(j)  (1280 + 64 * (j))
#define XB_XGEN(j)  (2304 + 64 * (j))
#define XB_TOP      3328
#define XB_TOPGEN   3392
#define XCD_BAR_WORDS 3456
#define XB_SPIN_CAP (1u << 18)
#define LAS __attribute__((address_space(3)))
#define XB_GAS __attribute__((address_space(1)))

__device__ __forceinline__ unsigned xb_ld(XB_GAS unsigned* p)              { return __hip_atomic_load(p, __ATOMIC_RELAXED, __HIP_MEMORY_SCOPE_AGENT); }
__device__ __forceinline__ unsigned xb_add(XB_GAS unsigned* p, unsigned v) { return __hip_atomic_fetch_add(p, v, __ATOMIC_RELAXED, __HIP_MEMORY_SCOPE_AGENT); }
__device__ __forceinline__ unsigned xb_xcc_id() { return (unsigned)__builtin_amdgcn_s_getreg((3 << 11) | 20) & 0xFu; }
#define XB_SPIN(cond, bar) do { unsigned _sp = 0; while (cond) { __builtin_amdgcn_s_sleep(1); \
    if ((++_sp & 255u) == 0u) { if (xb_ld(&(bar)[XB_TMO])) break; if (_sp > XB_SPIN_CAP) { (void)xb_add(&(bar)[XB_TMO], 1u); break; } } } } while (0)

struct XcdBarrier {
    XB_GAS unsigned* bar; unsigned x;
    volatile LAS unsigned* st;
};

__device__ __forceinline__ XcdBarrier xcd_barrier_post(XB_GAS unsigned* bar, volatile LAS unsigned* st) {
    XcdBarrier b; b.bar = bar; b.x = xb_xcc_id(); b.st = st;
    if (threadIdx.x == 0) (void)xb_add(&bar[XB_XCNT(b.x)], 1u);
    return b;
}
__device__ __forceinline__ void xcd_barrier_complete(XB_GAS unsigned* bar, unsigned x, unsigned& nloc, unsigned& nx) {
    const unsigned G = gridDim.x * gridDim.y * gridDim.z;
    unsigned sum, cnt, mine, sp = 0u;
    for (;;) {
        sum = 0u; cnt = 0u; mine = 0u;
#pragma unroll
        for (unsigned j = 0; j < 16; ++j) { const unsigned c = xb_ld(&bar[XB_XCNT(j)]); sum += c; cnt += (c > 0u) ? 1u : 0u; mine = (j == x) ? c : mine; }
        if (sum == G) break;
        __builtin_amdgcn_s_sleep(1);
        if ((++sp & 255u) == 0u) { if (xb_ld(&bar[XB_TMO])) break; if (sp > XB_SPIN_CAP) { (void)xb_add(&bar[XB_TMO], 1u); break; } }
    }
    nloc = mine > 0u ? mine : 1u; nx = cnt > 0u ? cnt : 1u;
}

__device__ __forceinline__ void xcd_barrier(const XcdBarrier& b) {
    asm volatile("s_waitcnt vmcnt(0)" ::: "memory");
    __syncthreads();
    if (threadIdx.x == 0) {
        XB_GAS unsigned* bar = b.bar;
        __builtin_amdgcn_s_waitcnt(0);
        unsigned nloc = b.st[0], nx = b.st[1];
        if (nloc == 0u) { xcd_barrier_complete(bar, b.x, nloc, nx); b.st[0] = nloc; b.st[1] = nx; }
        const unsigned old = xb_add(&bar[XB_XSUB(b.x)], 1u);
        const unsigned gen = old / nloc;
        if (old + 1u == (gen + 1u) * nloc) {
            __builtin_amdgcn_fence(__ATOMIC_RELEASE, "agent");
            asm volatile("s_waitcnt vmcnt(0)" ::: "memory");
            const unsigned og = xb_add(&bar[XB_TOP], 1u);
            const unsigned tg = og / nx;
            if (og + 1u == (tg + 1u) * nx) xb_add(&bar[XB_TOPGEN], 1u);
            else XB_SPIN(xb_ld(&bar[XB_TOPGEN]) == tg, bar);
            __builtin_amdgcn_fence(__ATOMIC_ACQUIRE, "agent");
            xb_add(&bar[XB_XGEN(b.x)], 1u);
            asm volatile("s_waitcnt vmcnt(0)" ::: "memory");
        } else {
            XB_SPIN(xb_ld(&bar[XB_XGEN(b.x)]) == gen, bar);
            __builtin_amdgcn_fence(__ATOMIC_ACQUIRE, "agent");
            asm volatile("s_waitcnt vmcnt(0)" ::: "memory");
        }
    }
    __syncthreads();
}

namespace pg8 {
#define PG8_LAS __attribute__((address_space(3)))
typedef unsigned short bf16_t;
typedef short bf16x8 __attribute__((ext_vector_type(8)));
typedef float f32x4 __attribute__((ext_vector_type(4)));
typedef unsigned u32x4 __attribute__((ext_vector_type(4)));
constexpr int BM = 256, BK = 64, HALF = 128, HTB = HALF * BK * 2  , STAGE_BYTES = 8 * HTB, NXCD = 8, WGM = 8;

__host__ __device__ __forceinline__ int lds_byte(int r, int c) { const int st = (r >> 4) * 2 + (c >> 5), rr = r & 15, cc = c & 31, ob = rr * 64 + cc * 2; return st * 1024 + (ob ^ (((ob >> 9) & 1) << 5)); }
__host__ __device__ __forceinline__ void stage_rc(int b, int& R, int& C) { const int st = b / 1024, sb = b % 1024, swz = sb ^ (((sb >> 9) & 1) << 5); R = (st >> 1) * 16 + swz / 64; C = (st & 1) * 32 + (swz % 64) / 2; }
__host__ __device__ __forceinline__ int perm32(int rho) { const int n = rho >> 4, i = rho & 15; return 8 * (i >> 2) + 4 * n + (i & 3); }

struct Unit { int pm, pn; };
#define PG8_GAS __attribute__((address_space(1)))
struct Gemm { const PG8_GAS bf16_t* A; const PG8_GAS bf16_t* Bt; int M, N, K, lda; };

struct StaticOrder {
    int nM, nN, nwg, G, c;
    __host__ __device__ void init(int M, int N, int G_, int c_) { nM = M / BM; nN = N / BM; nwg = nM * nN; G = G_; c = c_; }
    __host__ __device__ bool next(int i, Unit& u) const {
        const long L = (long)i * G + c; if (L >= nwg) return false;
        int wgid = (int)L; { const int q = nwg / NXCD, r = nwg % NXCD, xcd = wgid % NXCD, off = wgid / NXCD; wgid = (xcd < r ? xcd * (q + 1) : r * (q + 1) + (xcd - r) * q) + off; }
        const int nig = WGM * nN, gid = wgid / nig, fm = gid * WGM, gsz = (nM - fm) < WGM ? (nM - fm) : WGM;
        u.pm = fm + ((wgid % nig) % gsz); u.pn = (wgid % nig) / gsz; return true;
    }
    __device__ __forceinline__ void a_ready(const Unit&) const {}
    __device__ __forceinline__ void done(const Unit&) const {}
};

template <class Epi, class Sched, bool ALIGN_EPI = false, bool SP2 = false>
__device__ __forceinline__ void gemm_phase(PG8_LAS unsigned char* lds, const Gemm g, const Sched& S, const Epi& E) {
    int tid_ = threadIdx.x; asm volatile("" : "+v"(tid_));
    const int tid = tid_, wid = __builtin_amdgcn_readfirstlane(tid >> 6), lane = tid & 63, wr = wid >> 2, wc = wid & 3, fr = lane & 15, fq = lane >> 4;
    const int K = g.K, nt = K / BK;
    unsigned voffA[2], voffB[2];
#pragma unroll
    for (int i = 0; i < 2; ++i) { int R, C; stage_rc(tid * 16 + i * 8192, R, C); const int Rb = Epi::PERM ? ((R & ~31) + perm32(R & 31)) : R;
        voffA[i] = (unsigned)(R * g.lda + C) * 2u; voffB[i] = (unsigned)(Rb * K + C) * 2u; }
    const size_t kstep = (size_t)(BK * 2);
    const size_t hstep = (size_t)HALF * K * 2;
    const size_t tstep = 2 * hstep; const size_t hstepA = (size_t)HALF * g.lda * 2, tstepA = 2 * hstepA;
    const unsigned ldsw = (unsigned)wid * 1024u;
    const int aoff = lds_byte(wr * 64 + fr, fq * 8), boff = lds_byte(wc * 32 + fr, fq * 8);
#define PG8_SA(b, h) (((b) * 2 + (h)) * HTB)
#define PG8_SB(b, h) ((4 + (b) * 2 + (h)) * HTB)
#define PG8_STAGE(bufoff, gbase, voff) do { _Pragma("unroll") for (int _i = 0; _i < 2; ++_i) \
        __builtin_amdgcn_global_load_lds((const PG8_GAS unsigned*)((const PG8_GAS char*)(gbase) + (voff)[_i]), (PG8_LAS unsigned*)(lds + (bufoff) + ldsw + _i * 8192), 16, 0, 0); } while (0)
#define PG8_LDA(dst, b, h) do { _Pragma("unroll") for (int m = 0; m < 4; ++m) _Pragma("unroll") for (int k = 0; k < 2; ++k) dst[m][k] = *(const PG8_LAS bf16x8*)(lds + PG8_SA(b, h) + aoff + m * 2048 + k * 1024); } while (0)
#define PG8_LDB(dst, b, h) do { _Pragma("unroll") for (int n = 0; n < 2; ++n) _Pragma("unroll") for (int k = 0; k < 2; ++k) dst[n][k] = *(const PG8_LAS bf16x8*)(lds + PG8_SB(b, h) + boff + n * 2048 + k * 1024); } while (0)
#define PG8_MMA(ai, bj, At, Bt) do { __builtin_amdgcn_s_setprio(1); _Pragma("unroll") for (int m = 0; m < 4; ++m) _Pragma("unroll") for (int n = 0; n < 2; ++n) _Pragma("unroll") for (int k = 0; k < 2; ++k) \
        acc[ai][bj][m][n] = __builtin_amdgcn_mfma_f32_16x16x32_bf16(Bt[n][k], At[m][k], acc[ai][bj][m][n], 0, 0, 0); __builtin_amdgcn_s_setprio(0); } while (0)
#define PG8_WAIT_V(n) asm volatile("s_waitcnt vmcnt(" #n ")" ::: "memory")
#define PG8_WAIT_L(n) asm volatile("s_waitcnt lgkmcnt(" #n ")" ::: "memory")
#define PG8_BAR __builtin_amdgcn_s_barrier()
#define PG8_SCHED __builtin_amdgcn_sched_barrier(0)
    Unit cur, nxt; int ui = 0;
    if (!S.next(0, cur)) return;
    f32x4 acc[2][2][4][2];
#pragma unroll
    for (int a = 0; a < 2; ++a)
#pragma unroll
        for (int b = 0; b < 2; ++b)
#pragma unroll
            for (int m = 0; m < 4; ++m)
#pragma unroll
                for (int n = 0; n < 2; ++n) acc[a][b][m][n] = (f32x4){0.f, 0.f, 0.f, 0.f};
    bf16x8 At[4][2], B0[2][2], B1[2][2];
    const PG8_GAS char* cA = (const PG8_GAS char*)g.A + (size_t)cur.pm * tstepA; const PG8_GAS char* cB = (const PG8_GAS char*)g.Bt + (size_t)cur.pn * tstep;
    S.a_ready(cur);
    if constexpr (SP2) {
        PG8_STAGE(PG8_SB(0, 0), cB, voffB); PG8_STAGE(PG8_SB(0, 1), cB + hstep, voffB); PG8_STAGE(PG8_SA(0, 0), cA, voffA); PG8_STAGE(PG8_SA(0, 1), cA + hstepA, voffA);
        if (wr == 1) PG8_BAR;
        PG8_WAIT_V(2); PG8_BAR;
        PG8_STAGE(PG8_SB(1, 0), cB + kstep, voffB); PG8_STAGE(PG8_SA(1, 0), cA + kstep, voffA); PG8_STAGE(PG8_SB(1, 1), cB + hstep + kstep, voffB);
        PG8_WAIT_V(6); PG8_BAR;
    } else {
        PG8_STAGE(PG8_SB(0, 0), cB, voffB); PG8_STAGE(PG8_SA(0, 0), cA, voffA); PG8_STAGE(PG8_SB(0, 1), cB + hstep, voffB); PG8_STAGE(PG8_SA(0, 1), cA + hstepA, voffA);
        if (wr == 1) PG8_BAR;
        PG8_WAIT_V(4); PG8_BAR;
        PG8_STAGE(PG8_SB(1, 0), cB + kstep, voffB); PG8_STAGE(PG8_SA(1, 0), cA + kstep, voffA); PG8_STAGE(PG8_SB(1, 1), cB + hstep + kstep, voffB);
        PG8_WAIT_V(6); PG8_BAR;
    }
    for (;;) {
        const bool has_next = S.next(ui + 1, nxt);
        const PG8_GAS char* nA = has_next ? (const PG8_GAS char*)g.A + (size_t)nxt.pm * tstepA : cA; const PG8_GAS char* nB = has_next ? (const PG8_GAS char*)g.Bt + (size_t)nxt.pn * tstep : cB;
        for (int t = 0; t < nt; t += 2) {
            const bool last = (t == nt - 2);
            const PG8_GAS char* a1 = cA + (size_t)(t + 1) * kstep;
            const PG8_GAS char* a2 = last ? nA : cA + (size_t)(t + 2) * kstep; const PG8_GAS char* b2 = last ? nB : cB + (size_t)(t + 2) * kstep;
            const PG8_GAS char* a3 = a2 + kstep; const PG8_GAS char* b3 = b2 + kstep;
            if (last && has_next) S.a_ready(nxt);
            if constexpr (SP2) {
            PG8_LDB(B0, 0, 0); PG8_LDB(B1, 0, 1); PG8_SCHED; PG8_LDA(At, 0, 0); PG8_STAGE(PG8_SA(1, 1), a1 + hstepA, voffA);
            PG8_WAIT_V(8); PG8_WAIT_L(0); PG8_BAR; PG8_MMA(0, 0, At, B0); PG8_MMA(0, 1, At, B1); PG8_BAR; PG8_SCHED;
            PG8_LDA(At, 0, 1); PG8_STAGE(PG8_SB(0, 0), b2, voffB); PG8_STAGE(PG8_SB(0, 1), b2 + hstep, voffB); PG8_STAGE(PG8_SA(0, 0), a2, voffA);
            PG8_WAIT_V(8); PG8_WAIT_L(0); PG8_BAR; PG8_MMA(1, 0, At, B0); PG8_MMA(1, 1, At, B1); PG8_BAR; PG8_SCHED;
            PG8_LDB(B0, 1, 0); PG8_LDB(B1, 1, 1); PG8_SCHED; PG8_LDA(At, 1, 0); PG8_STAGE(PG8_SA(0, 1), a2 + hstepA, voffA);
            PG8_WAIT_V(8); PG8_WAIT_L(0); PG8_BAR; PG8_MMA(0, 0, At, B0); PG8_MMA(0, 1, At, B1); PG8_BAR; PG8_SCHED;
            PG8_LDA(At, 1, 1); PG8_STAGE(PG8_SB(1, 0), b3, voffB); PG8_STAGE(PG8_SB(1, 1), b3 + hstep, voffB); PG8_STAGE(PG8_SA(1, 0), a3, voffA);
            PG8_WAIT_V(8); PG8_WAIT_L(0); PG8_BAR; PG8_MMA(1, 0, At, B0); PG8_MMA(1, 1, At, B1); PG8_BAR; PG8_SCHED;
            } else {
            PG8_LDB(B0, 0, 0); PG8_SCHED; PG8_LDA(At, 0, 0); PG8_STAGE(PG8_SA(1, 1), a1 + hstepA, voffA);
            PG8_WAIT_L(8); PG8_BAR; PG8_WAIT_L(0); PG8_MMA(0, 0, At, B0); PG8_BAR; PG8_SCHED;
            PG8_LDB(B1, 0, 1); PG8_STAGE(PG8_SB(0, 0), b2, voffB);
            PG8_BAR; PG8_WAIT_L(0); PG8_MMA(0, 1, At, B1); PG8_BAR;
            PG8_LDA(At, 0, 1); PG8_STAGE(PG8_SA(0, 0), a2, voffA);
            PG8_BAR; PG8_WAIT_L(0); PG8_MMA(1, 0, At, B0); PG8_BAR; PG8_SCHED;
            PG8_STAGE(PG8_SB(0, 1), b2 + hstep, voffB);
            PG8_WAIT_V(6); PG8_BAR; PG8_MMA(1, 1, At, B1); PG8_BAR;
            PG8_LDB(B0, 1, 0); PG8_SCHED; PG8_LDA(At, 1, 0); PG8_STAGE(PG8_SA(0, 1), a2 + hstepA, voffA);
            PG8_WAIT_L(8); PG8_BAR; PG8_WAIT_L(0); PG8_MMA(0, 0, At, B0); PG8_BAR; PG8_SCHED;
            PG8_LDB(B1, 1, 1); PG8_STAGE(PG8_SB(1, 0), b3, voffB);
            PG8_BAR; PG8_WAIT_L(0); PG8_MMA(0, 1, At, B1); PG8_BAR;
            PG8_LDA(At, 1, 1); PG8_STAGE(PG8_SA(1, 0), a3, voffA);
            PG8_BAR; PG8_WAIT_L(0); PG8_MMA(1, 0, At, B0); PG8_BAR; PG8_SCHED;
            PG8_STAGE(PG8_SB(1, 1), b3 + hstep, voffB);
            PG8_WAIT_V(6); PG8_BAR; PG8_MMA(1, 1, At, B1); PG8_BAR;
            }
        }
        if constexpr (ALIGN_EPI) { if (wr == 0) PG8_BAR; }
        if constexpr (!Epi::AFTER_DRAIN) { E(acc, cur, wr, wc, fr, fq); S.done(cur); }
        if (!has_next) break;
#pragma unroll
        for (int a = 0; a < 2; ++a)
#pragma unroll
            for (int b = 0; b < 2; ++b)
#pragma unroll
                for (int m = 0; m < 4; ++m)
#pragma unroll
                    for (int n = 0; n < 2; ++n) acc[a][b][m][n] = (f32x4){0.f, 0.f, 0.f, 0.f};
        cur = nxt; cA = nA; cB = nB; ++ui;
        if constexpr (ALIGN_EPI) { if (wr == 1) PG8_BAR; }
    }
    PG8_WAIT_V(0);
    if constexpr (!ALIGN_EPI) { if (wr == 0) PG8_BAR; }
    PG8_BAR;
    if constexpr (Epi::AFTER_DRAIN) { E.fused(acc, cur, wr, wc, fr, fq, lds, wid, lane); S.done(cur); }
#undef PG8_SA
#undef PG8_SB
#undef PG8_STAGE
#undef PG8_LDA
#undef PG8_LDB
#undef PG8_MMA
#undef PG8_WAIT_V
#undef PG8_WAIT_L
#undef PG8_BAR
#undef PG8_SCHED
}
}

typedef unsigned short u16;
typedef short bf16x8 __attribute__((ext_vector_type(8)));
typedef short s16x4 __attribute__((ext_vector_type(4)));
typedef float f32x4 __attribute__((ext_vector_type(4)));
typedef float f32x16 __attribute__((ext_vector_type(16)));
typedef unsigned u32x4 __attribute__((ext_vector_type(4)));
typedef unsigned u32x2 __attribute__((ext_vector_type(2)));
typedef __bf16 bf16x2_t __attribute__((ext_vector_type(2)));
typedef float f32x2_t __attribute__((ext_vector_type(2)));
#define DI __device__ __forceinline__

constexpr int NB = 32, SEQ = 2048, NCTX = 256, TT = 2304, DM = 1024, DEPTH = 4;
constexpr int NGRP = 4, BGR = 8, MG = BGR * TT;
constexpr int DIN = 10992, NP = 11008;
constexpr float EPS = 1e-6f;
constexpr int C_CQ = 0, C_KR = 384, C_AF = 448, C_AB = 464, C_IF = 480, C_CKV = 512, C_MZ = 768, C_GQ = 1280, C_GK = 1536, C_GV = 1792, C_GZ = 2304,
              C_MX = 2816, C_MV = 3328, C_MO = 3840, C_MLZ = 4352, C_DQ = 4864, C_DK = 5376, C_DV = 5888, C_DZ = 6400, C_MG = 6912;
constexpr int NSTEP = 1 + DEPTH * NGRP * 7;
constexpr int LDS_BYTES = 163840;
constexpr int LDS_BARW = LDS_BYTES - 16;
constexpr int LDS_MISC = LDS_BYTES - 64;

constexpr size_t al256(size_t x) { return (x + 255) / 256 * 256; }
constexpr size_t WS_CTL = 0;
constexpr size_t CTL_BYTES = 65536;
constexpr size_t WS_MOD  = WS_CTL + CTL_BYTES;
constexpr size_t WS_ROPE = WS_MOD + al256((size_t)DEPTH * 33 * 3072 * 4);
constexpr size_t WS_LAM  = WS_ROPE + 8192;
constexpr size_t WS_WIN  = WS_LAM + 256;
constexpr size_t WS_BR   = WS_WIN + (size_t)DEPTH * NP * 1024 * 2;
constexpr size_t WS_WO   = WS_BR + (size_t)DEPTH * 4 * 1024 * 512 * 2;
constexpr size_t WS_WUQ  = WS_WO + (size_t)DEPTH * 1024 * 1024 * 2;
constexpr size_t WS_WUKV = WS_WUQ + (size_t)DEPTH * 768 * 384 * 2;
constexpr size_t WS_WQK  = WS_WUKV + (size_t)DEPTH * 1024 * 256 * 2;
constexpr size_t WS_CTX  = WS_WQK + (size_t)DEPTH * 512 * 512 * 2;
constexpr size_t WS_H    = WS_CTX + (size_t)NB * NCTX * DM * 4;
constexpr size_t WS_P    = WS_H + (size_t)MG * 1024 * 2;
constexpr size_t WS_Q    = WS_P + (size_t)MG * NP * 2;
constexpr size_t WS_KV   = WS_Q + (size_t)MG * 768 * 2;
constexpr size_t WS_XC   = WS_KV + (size_t)MG * 1024 * 2;
constexpr size_t WS_QKML = WS_XC + (size_t)MG * 512 * 2;
constexpr size_t WS_BG   = WS_QKML + (size_t)MG * 512 * 2;
constexpr size_t WS_SCAL = WS_BG + (size_t)2 * MG * 256 * 4;
constexpr size_t WS_Y    = WS_SCAL + (size_t)2 * MG * 16 * 4;
constexpr size_t WS_OSC  = WS_Y + (size_t)4 * MG * 512 * 2;
constexpr size_t WS_MF   = WS_OSC;
constexpr size_t WS_MB   = WS_OSC + (size_t)4 * MG * 512 * 2;
constexpr size_t WS_END  = WS_MB + (size_t)MG * 1024 * 2;
static_assert((size_t)MG * 1024 * 4 == (size_t)4 * MG * 512 * 2, "merge accumulator aliases the scan scratch");
static_assert(WS_END <= (size_t)1000 * 1024 * 1024, "workspace map must stay below 1000 MiB");
constexpr int CW_QUEUE = 4096;

#define GAS __attribute__((address_space(1)))
typedef GAS float gf32; typedef GAS unsigned short gu16; typedef GAS unsigned char gu8;
#define FIN(k) ((const gf32*)F.in[k])
struct Params { const float* in[29]; float* out; unsigned char* ws; int s_lo, s_hi; };

struct Ctx {
    const float* const* in; gf32* out; gu8* ws; GAS unsigned* ctl;
    int wave, G;
    LAS unsigned char* lds;
};

DI float bf2f(u16 v) { return __uint_as_float((unsigned)v << 16); }
DI float bflo(unsigned w) { return __uint_as_float(w << 16); }
DI float bfhi(unsigned w) { return __uint_as_float(w & 0xffff0000u); }
DI unsigned pk2(float lo, float hi) { f32x2_t v = {lo, hi}; bf16x2_t b = __builtin_convertvector(v, bf16x2_t); return __builtin_bit_cast(unsigned, b); }
DI u16 f2bf(float f) { return (u16)(pk2(f, 0.f) & 0xffffu); }
DI void unpack8(u32x4 w, float* f) { f[0] = bflo(w.x); f[1] = bfhi(w.x); f[2] = bflo(w.y); f[3] = bfhi(w.y); f[4] = bflo(w.z); f[5] = bfhi(w.z); f[6] = bflo(w.w); f[7] = bfhi(w.w); }
DI u32x4 pack8(const float* f) { u32x4 w; w.x = pk2(f[0], f[1]); w.y = pk2(f[2], f[3]); w.z = pk2(f[4], f[5]); w.w = pk2(f[6], f[7]); return w; }
DI float sigmoid_f(float x) { return __builtin_amdgcn_rcpf(1.f + __expf(-x)); }
DI float silu_f(float x) { return x * sigmoid_f(x); }
DI float logsig_f(float x) { return fminf(x, 0.f) - __logf(1.f + __expf(-fabsf(x))); }
DI int crow(int r, int hi) { return (r & 3) + 8 * (r >> 2) + 4 * hi; }
DI int swz64(int row, int colB) { return row * 128 + (colB ^ (((row >> 1) & 7) << 4)); }
DI int kswz(int row, int colB) { return row * 256 + (colB ^ ((row & 7) << 4)); }
DI int v_st(int k, int c) { const int kk = (k & ~0xC) | ((k & 4) << 1) | ((k & 8) >> 1); return ((kk >> 3) * 4 + (c >> 5)) * 512 + ((kk & 7) * 32 + (c & 31)) * 2; }
DI int v_rd_base(int lane) { return ((lane & 3) << 3) | (((lane >> 2) & 3) << 6) | (((lane >> 4) & 1) << 5) | (((lane >> 5) & 1) << 8); }
template <int OFF> DI s16x4 tr_read(int vb) { s16x4 r; asm volatile("ds_read_b64_tr_b16 %0, %1 offset:%2" : "=&v"(r) : "v"(vb), "i"(OFF) : "memory"); return r; }
#define SBAR() __builtin_amdgcn_sched_barrier(0)
#define MFMA32(a, b, c) __builtin_amdgcn_mfma_f32_32x32x16_bf16((a), (b), (c), 0, 0, 0)
DI bf16x8 ldsv(const LAS unsigned char* p) { return *(const LAS bf16x8*)p; }
DI float wave_sum(float v) {
#pragma unroll
    for (int o = 32; o >= 1; o >>= 1) v += __shfl_xor(v, o);
    return v;
}
DI void v_frags(int vb, bf16x8 (&vf)[4]) {
    const s16x4 l0 = tr_read<0>(vb), h0 = tr_read<2048>(vb), l1 = tr_read<4096>(vb), h1 = tr_read<4096 + 2048>(vb);
    const s16x4 l2 = tr_read<8192>(vb), h2 = tr_read<8192 + 2048>(vb), l3 = tr_read<12288>(vb), h3 = tr_read<12288 + 2048>(vb);
    asm volatile("s_waitcnt lgkmcnt(0)" ::: "memory"); SBAR();
#define PKV(L, H) (bf16x8){L[0], L[1], L[2], L[3], H[0], H[1], H[2], H[3]}
    vf[0] = PKV(l0, h0); vf[1] = PKV(l1, h1); vf[2] = PKV(l2, h2); vf[3] = PKV(l3, h3);
#undef PKV
}
DI void p_to_afrag(const f32x16& p0, const f32x16& p1, bf16x8 (&pa)[4]) {
#define PK4(P, BASE, OUT) do { unsigned a0 = pk2(P[BASE + 0], P[BASE + 1]), a1 = pk2(P[BASE + 2], P[BASE + 3]);   \
    unsigned b0 = pk2(P[BASE + 4], P[BASE + 5]), b1 = pk2(P[BASE + 6], P[BASE + 7]);                              \
    auto r0 = __builtin_amdgcn_permlane32_swap(a0, b0, false, false); auto r1 = __builtin_amdgcn_permlane32_swap(a1, b1, false, false); \
    u32x4 w = {r0[0], r1[0], r0[1], r1[1]}; OUT = __builtin_bit_cast(bf16x8, w); } while (0)
    PK4(p0, 0, pa[0]); PK4(p0, 8, pa[1]); PK4(p1, 0, pa[2]); PK4(p1, 8, pa[3]);
#undef PK4
}
DI void p_half_to_afrag(const f32x16& p, bf16x8& pa0, bf16x8& pa1) {
#define PK4(P, BASE, OUT) do { unsigned a0 = pk2(P[BASE + 0], P[BASE + 1]), a1 = pk2(P[BASE + 2], P[BASE + 3]);   \
    unsigned b0 = pk2(P[BASE + 4], P[BASE + 5]), b1 = pk2(P[BASE + 6], P[BASE + 7]);                              \
    auto r0 = __builtin_amdgcn_permlane32_swap(a0, b0, false, false); auto r1 = __builtin_amdgcn_permlane32_swap(a1, b1, false, false); \
    u32x4 w = {r0[0], r1[0], r0[1], r1[1]}; OUT = __builtin_bit_cast(bf16x8, w); } while (0)
    PK4(p, 0, pa0); PK4(p, 8, pa1);
#undef PK4
}
DI float half_swap_sum(float v) { auto rr = __builtin_amdgcn_permlane32_swap(__float_as_uint(v), __float_as_uint(v), false, false); return __uint_as_float(rr[0]) + __uint_as_float(rr[1]); }
DI float half_swap_max(float v) { auto rr = __builtin_amdgcn_permlane32_swap(__float_as_uint(v), __float_as_uint(v), false, false); return fmaxf(__uint_as_float(rr[0]), __uint_as_float(rr[1])); }
using pg8::Unit;
typedef f32x4 AccT[2][2][4][2];

DI int p_act(int pn) {
    if (pn >= 27) return 2;
    if (pn == 15 || pn == 16) return 2;
    if (pn == 3 || pn == 4 || pn == 9 || pn == 10 || pn == 17 || pn == 18 || pn == 25 || pn == 26) return 1;
    return 0;
}
struct EpiBf {
    static constexpr bool PERM = true, AFTER_DRAIN = false;
    gu16* O; int ldc; int actsel;
    DI void operator()(const AccT& acc, const Unit& u, int wr, int wc, int fr, int fq) const {
        const int row0 = u.pm * 256 + wr * 64 + fr, col0 = u.pn * 256 + wc * 32 + 8 * fq;
        const int act = actsel == 1 ? p_act(u.pn) : actsel;
#pragma unroll
        for (int ai = 0; ai < 2; ++ai)
#pragma unroll
            for (int m = 0; m < 4; ++m) { gu16* rowp = O + (size_t)(row0 + ai * 128 + m * 16) * ldc + col0;
#pragma unroll
                for (int bj = 0; bj < 2; ++bj) { f32x4 v0 = acc[ai][bj][m][0], v1 = acc[ai][bj][m][1];
                    float f[8] = {v0[0], v0[1], v0[2], v0[3], v1[0], v1[1], v1[2], v1[3]};
                    if (act == 1) {
#pragma unroll
                        for (int e = 0; e < 8; ++e) f[e] = silu_f(f[e]);
                    } else if (act == 2) {
#pragma unroll
                        for (int e = 0; e < 8; ++e) f[e] = sigmoid_f(f[e]);
                    }
                    *(GAS u32x4*)(rowp + bj * 128) = pack8(f); } }
    }
};
struct EpiMerge {
    static constexpr bool PERM = true, AFTER_DRAIN = false;
    gu16* MB; const gu16* gate; int mode;
    DI void operator()(const AccT& acc, const Unit& u, int wr, int wc, int fr, int fq) const {
        const int row0 = u.pm * 256 + wr * 64 + fr, col0 = u.pn * 256 + wc * 32 + 8 * fq;
#pragma unroll
        for (int ai = 0; ai < 2; ++ai) {
            u32x4 gv[4][2], ov[4][2];
#pragma unroll
            for (int m = 0; m < 4; ++m) { const size_t r = (size_t)(row0 + ai * 128 + m * 16);
#pragma unroll
                for (int bj = 0; bj < 2; ++bj) { const int c = col0 + bj * 128; gv[m][bj] = *(const GAS u32x4*)(gate + r * NP + c); if (mode != 0) ov[m][bj] = *(const GAS u32x4*)(MB + r * 1024 + c); } }
#pragma unroll
            for (int m = 0; m < 4; ++m) { const size_t r = (size_t)(row0 + ai * 128 + m * 16);
#pragma unroll
                for (int bj = 0; bj < 2; ++bj) { const int c = col0 + bj * 128;
                    f32x4 v0 = acc[ai][bj][m][0], v1 = acc[ai][bj][m][1];
                    float g[8]; unpack8(gv[m][bj], g);
#pragma unroll
                    for (int e = 0; e < 8; ++e) g[e] = sigmoid_f(g[e]);
                    float f[8] = {v0[0] * g[0], v0[1] * g[1], v0[2] * g[2], v0[3] * g[3], v1[0] * g[4], v1[1] * g[5], v1[2] * g[6], v1[3] * g[7]};
                    if (mode != 0) { float o[8]; unpack8(ov[m][bj], o);
#pragma unroll
                        for (int e = 0; e < 8; ++e) f[e] += o[e]; }
                    *(GAS u32x4*)(MB + r * 1024 + c) = pack8(f); } }
        }
    }
};
struct EpiOut {
    static constexpr bool PERM = false, AFTER_DRAIN = false;
    const gf32* xsrc; gf32* xdst; const gf32* csrc; gf32* cdst; const gf32* mod; int grp; int last;
    DI void operator()(const AccT& acc, const Unit& u, int wr, int wc, int fr, int fq) const {
        const int bl = u.pm / 9, tb = u.pm % 9, b = grp * BGR + bl;
        if (tb == 0 && last) return;
        const gf32* src; gf32* dst; const gf32* gt;
        if (tb == 0) { src = csrc + (size_t)b * NCTX * DM; dst = cdst + (size_t)b * NCTX * DM; gt = mod + 32 * 3072 + 2048; }
        else { src = xsrc + ((size_t)b * SEQ + (size_t)(tb - 1) * 256) * DM; dst = xdst + ((size_t)b * SEQ + (size_t)(tb - 1) * 256) * DM; gt = mod + b * 3072 + 2048; }
        const int row0 = wr * 64 + fr, col0 = u.pn * 256 + wc * 32 + 4 * fq;
        f32x4 gv[2][2];
#pragma unroll
        for (int bj = 0; bj < 2; ++bj)
#pragma unroll
            for (int n = 0; n < 2; ++n) gv[bj][n] = *(const GAS f32x4*)(gt + col0 + bj * 128 + n * 16);
#pragma unroll
        for (int ai = 0; ai < 2; ++ai)
#pragma unroll
            for (int mh = 0; mh < 2; ++mh) {
                f32x4 xo[2][2][2];
#pragma unroll
                for (int m2 = 0; m2 < 2; ++m2) { const size_t ro = (size_t)(row0 + ai * 128 + (mh * 2 + m2) * 16) * DM + col0;
#pragma unroll
                    for (int bj = 0; bj < 2; ++bj)
#pragma unroll
                        for (int n = 0; n < 2; ++n) xo[m2][bj][n] = *(const GAS f32x4*)(src + ro + bj * 128 + n * 16); }
#pragma unroll
                for (int m2 = 0; m2 < 2; ++m2) { const int m = mh * 2 + m2; const size_t ro = (size_t)(row0 + ai * 128 + m * 16) * DM + col0;
#pragma unroll
                    for (int bj = 0; bj < 2; ++bj)
#pragma unroll
                        for (int n = 0; n < 2; ++n) *(GAS f32x4*)(dst + ro + bj * 128 + n * 16) = xo[m2][bj][n] + gv[bj][n] * acc[ai][bj][m][n]; } }
    }
};

DI int pmap(int n, float& sc) {
    sc = 1.f;
    if (n < 384) return n;
    if (n < 448) return 640 + (n - 384);
    if (n < 464) return 2240 + (n - 448);
    if (n < 480) return 2256 + (n - 464);
    if (n < 496) return 4320 + (n - 480);
    if (n < 512) return -1;
    if (n < 768) return 384 + (n - 512);
    if (n < 1280) return 704 + (n - 768);
    if (n < 1536) { sc = 0.125f; return 1216 + (n - 1280); }
    if (n < 1792) return 1472 + (n - 1536);
    if (n < 2304) return 1728 + (n - 1792);
    if (n < 2816) return 2272 + (n - 2304);
    if (n < 3328) return 2784 + (n - 2816);
    if (n < 3840) return 3296 + (n - 3328);
    if (n < 4352) return 3808 + (n - 3840);
    if (n < 4864) return 4336 + (n - 4352);
    if (n < 5376) return 4848 + (n - 4864);
    if (n < 5888) return 5360 + (n - 5376);
    if (n < 6400) return 5872 + (n - 5888);
    if (n < 6912) return 6384 + (n - 6400);
    return 6896 + (n - 6912);
}
struct MapWin { DI int operator()(int n, float& sc) const { return pmap(n, sc); } };
struct MapId  { DI int operator()(int n, float& sc) const { sc = 1.f; return n; } };
struct MapQ   { DI int operator()(int n, float& sc) const { sc = 1.f; return n < 512 ? (n >> 7) * 192 + (n & 127) : ((n - 512) >> 6) * 192 + 128 + ((n - 512) & 63); } };
struct MapKV  { DI int operator()(int n, float& sc) const { sc = 1.f; return n < 512 ? (n >> 7) * 256 + (n & 127) : ((n - 512) >> 7) * 256 + 128 + ((n - 512) & 127); } };

template <class Map>
DI void xpose_tile(const gf32* __restrict__ src, int ldsrc, gu16* __restrict__ dst, int K, int n0, int k0, const gf32* __restrict__ kscale, Map map, LAS float* tl) {
    const int tid = threadIdx.x;
    { const int kk = tid >> 3, ng = (tid & 7) * 8; float sc; const int sn = map(n0 + ng, sc);
      f32x4 a = {0.f, 0.f, 0.f, 0.f}, b = {0.f, 0.f, 0.f, 0.f};
      if (sn >= 0) { const gf32* p = src + (size_t)(k0 + kk) * ldsrc + sn; a = *(const GAS f32x4*)p; b = *(const GAS f32x4*)(p + 4); }
      const float ks = (kscale ? kscale[k0 + kk] : 1.f) * sc;
      tl[(ng + 0) * 65 + kk] = a[0] * ks; tl[(ng + 1) * 65 + kk] = a[1] * ks; tl[(ng + 2) * 65 + kk] = a[2] * ks; tl[(ng + 3) * 65 + kk] = a[3] * ks;
      tl[(ng + 4) * 65 + kk] = b[0] * ks; tl[(ng + 5) * 65 + kk] = b[1] * ks; tl[(ng + 6) * 65 + kk] = b[2] * ks; tl[(ng + 7) * 65 + kk] = b[3] * ks; }
    __syncthreads();
    { const int nn = tid >> 3, kg = (tid & 7) * 8; float f[8];
#pragma unroll
      for (int e = 0; e < 8; ++e) f[e] = tl[nn * 65 + kg + e];
      *(GAS u32x4*)(dst + (size_t)(n0 + nn) * K + k0 + kg) = pack8(f); }
    __syncthreads();
}

DI void p0_prologue(const Ctx& F) {
    int tz = (int)threadIdx.x; asm volatile("" : "+v"(tz));
    const int tid = tz;
    LAS float* lf = (LAS float*)F.lds;
    constexpr int U_ADA = 96, U_WIN = DEPTH * (NP / 64) * 16, U_BR = DEPTH * 4 * 16 * 8, U_WO = DEPTH * 16 * 16, U_WUQ = DEPTH * 12 * 6, U_WUKV = DEPTH * 16 * 4, U_WQK = DEPTH * 64, U_MISC = 1;
    constexpr int O_WIN = U_ADA, O_BR = O_WIN + U_WIN, O_WO = O_BR + U_BR, O_WUQ = O_WO + U_WO, O_WUKV = O_WUQ + U_WUQ, O_WQK = O_WUKV + U_WUKV, O_MISC = O_WQK + U_WQK, U_ALL = O_MISC + U_MISC;
    for (int u = blockIdx.x; u < U_ALL; u += F.G) {
        if (u < U_ADA) {
            const int l = u / 24, col0 = (u % 24) * 128, col = tid & 127, kq = tid >> 7;
            const gf32* aw = FIN(4) + (size_t)l * 1024 * 3072;
            float acc[33];
#pragma unroll
            for (int r = 0; r < 33; ++r) acc[r] = 0.f;
            for (int kc = 0; kc < 1024; kc += 256) {
                __syncthreads();
                for (int idx = tid; idx < 33 * 256; idx += 512) { const int r = idx >> 8, k = idx & 255; const float cv = (r < 32) ? FIN(1)[r * 1024 + kc + k] : FIN(3)[kc + k]; lf[idx] = silu_f(cv); }
                __syncthreads();
                for (int k = kq * 64; k < kq * 64 + 64; ++k) { const float w = aw[(size_t)(kc + k) * 3072 + col0 + col];
#pragma unroll
                    for (int r = 0; r < 33; ++r) acc[r] += lf[r * 256 + k] * w; }
            }
            __syncthreads();
#pragma unroll
            for (int r = 0; r < 33; ++r) lf[(kq * 33 + r) * 128 + col] = acc[r];
            __syncthreads();
            gf32* mod = (gf32*)(F.ws + WS_MOD) + (size_t)l * 33 * 3072;
            for (int idx = tid; idx < 33 * 128; idx += 512) { const int r = idx >> 7, c = idx & 127;
                mod[r * 3072 + col0 + c] = lf[(0 * 33 + r) * 128 + c] + lf[(1 * 33 + r) * 128 + c] + lf[(2 * 33 + r) * 128 + c] + lf[(3 * 33 + r) * 128 + c] + FIN(5)[l * 3072 + col0 + c]; }
            __syncthreads();
        } else if (u < O_BR) {
            const int v = u - O_WIN, l = v / ((NP / 64) * 16), t = v % ((NP / 64) * 16), nt = t / 16, kt = t % 16;
            xpose_tile(FIN(7) + (size_t)l * 1024 * DIN, DIN, (gu16*)(F.ws + WS_WIN) + (size_t)l * NP * 1024, 1024, nt * 64, kt * 64, nullptr, MapWin(), lf);
        } else if (u < O_WO) {
            const int v = u - O_BR, li = v / 128, t = v % 128, nt = t / 8, kt = t % 8;
            xpose_tile(FIN(27) + (size_t)li * 512 * 1024, 1024, (gu16*)(F.ws + WS_BR) + (size_t)li * 1024 * 512, 512, nt * 64, kt * 64, nullptr, MapId(), lf);
        } else if (u < O_WUQ) {
            const int v = u - O_WO, l = v / 256, t = v % 256, nt = t / 16, kt = t % 16;
            xpose_tile(FIN(28) + (size_t)l * 1024 * 1024, 1024, (gu16*)(F.ws + WS_WO) + (size_t)l * 1024 * 1024, 1024, nt * 64, kt * 64, nullptr, MapId(), lf);
        } else if (u < O_WUKV) {
            const int v = u - O_WUQ, l = v / 72, t = v % 72, nt = t / 6, kt = t % 6;
            xpose_tile(FIN(10) + (size_t)l * 384 * 768, 768, (gu16*)(F.ws + WS_WUQ) + (size_t)l * 768 * 384, 384, nt * 64, kt * 64, FIN(8) + l * 384, MapQ(), lf);
        } else if (u < O_WQK) {
            const int v = u - O_WUKV, l = v / 64, t = v % 64, nt = t / 4, kt = t % 4;
            xpose_tile(FIN(11) + (size_t)l * 256 * 1024, 1024, (gu16*)(F.ws + WS_WUKV) + (size_t)l * 1024 * 256, 256, nt * 64, kt * 64, FIN(9) + l * 256, MapKV(), lf);
        } else if (u < O_MISC) {
            const int v = u - O_WQK, l = v / 64, t = v % 64;
            gu16* dst = (gu16*)(F.ws + WS_WQK) + (size_t)l * 512 * 512;
            for (int e = tid; e < 4096; e += 512) { const int idx = t * 4096 + e, n = idx >> 9, k = idx & 511;
                const int isk = n >> 8, hn = (n & 255) >> 6, dd = n & 63, hk = k >> 7, c = k & 127;
                float val = 0.f;
                if (hn == hk) { const gf32* w = (isk ? FIN(20) : FIN(19)) + (((size_t)l * 4 + hn) * 128 + c) * 64 + dd; val = isk ? *w * 0.125f : *w; }
                dst[idx] = f2bf(val); }
        } else {
            gf32* rope = (gf32*)(F.ws + WS_ROPE);
            for (int e = tid; e < 1024; e += 512) { const int pos = e >> 4, i = e & 15;
                const float inv = powf(10000.f, -(float)i / 16.f); const float ang = (float)pos * inv;
                rope[e] = cosf(ang); rope[1024 + e] = sinf(ang); }
            if (tid < 4) { const gf32* lp = FIN(25) + tid * 256; float s0 = 0.f, s1 = 0.f;
                for (int d = 0; d < 64; ++d) { s0 += lp[d] * lp[64 + d]; s1 += lp[128 + d] * lp[192 + d]; }
                const float lam_init = 0.8f - 0.6f * expf(-0.3f * (float)tid);
                ((gf32*)(F.ws + WS_LAM))[tid] = expf(s0) - expf(s1) + lam_init; }
        }
    }
}

DI void p1_norm(const Ctx& F, int l, int g) {
    const gf32* mod = (const gf32*)(F.ws + WS_MOD) + (size_t)l * 33 * 3072;
    const gf32* ng = FIN(6) + l * 1024;
    const gf32* xs = (l == 0) ? FIN(0) : F.out;
    const gf32* cs = (l == 0) ? FIN(2) : (const gf32*)(F.ws + WS_CTX);
    gu16* H = (gu16*)(F.ws + WS_H);
    int lz = ((int)threadIdx.x & 63); asm volatile("" : "+v"(lz));
    const int lane = lz;
    int row0 = blockIdx.x * 8 + F.wave; asm volatile("" : "+s"(row0));
    for (int row = row0; row < MG; row += F.G * 8) {
        const int bl = row / TT, t = row % TT, b = g * BGR + bl;
        const gf32* src; const gf32* md;
        if (t < NCTX) { src = cs + ((size_t)b * NCTX + t) * DM; md = mod + 32 * 3072; } else { src = xs + ((size_t)b * SEQ + (t - NCTX)) * DM; md = mod + b * 3072; }
        f32x4 v[4]; float ss = 0.f;
#pragma unroll
        for (int i = 0; i < 4; ++i) { v[i] = *(const GAS f32x4*)(src + i * 256 + lane * 4); ss += v[i][0] * v[i][0] + v[i][1] * v[i][1] + v[i][2] * v[i][2] + v[i][3] * v[i][3]; }
        ss = wave_sum(ss);
        const float rstd = rsqrtf(ss * (1.f / 1024.f) + EPS);
#pragma unroll
        for (int i = 0; i < 4; ++i) { const int c = i * 256 + lane * 4;
            const f32x4 gg = *(const GAS f32x4*)(ng + c), sh = *(const GAS f32x4*)(md + c), sc = *(const GAS f32x4*)(md + 1024 + c);
            const f32x4 y = v[i] * rstd * gg * (sc + 1.f) + sh;
            u32x2 w; w.x = pk2(y[0], y[1]); w.y = pk2(y[2], y[3]);
            *(GAS u32x2*)(H + (size_t)row * 1024 + c) = w; }
    }
}
DI void rope8(float* x, int j8, int t, const gf32* __restrict__ rope) {
    float p[8];
#pragma unroll
    for (int e = 0; e < 8; ++e) p[e] = __shfl_xor(x[e], 2);
    if (t < NCTX) return;
    const int s = t - NCTX, pos = (j8 & 4) ? (s & 63) : (s >> 6), i0 = 8 * (j8 & 1);
    const float sg = (j8 & 2) ? 1.f : -1.f;
#pragma unroll
    for (int e = 0; e < 8; ++e) { const float c = rope[pos * 16 + i0 + e], sn = rope[1024 + pos * 16 + i0 + e]; x[e] = x[e] * c + sg * p[e] * sn; }
}
DI float group_sum(float v, int n) {
    v += __shfl_xor(v, 1); v += __shfl_xor(v, 2); v += __shfl_xor(v, 4); if (n == 16) v += __shfl_xor(v, 8); return v;
}

DI void p3_rows(const Ctx& F, int l) {
    gu16* P = (gu16*)(F.ws + WS_P); gu16* XC = (gu16*)(F.ws + WS_XC);
    const gf32* rope = (const gf32*)(F.ws + WS_ROPE);
    const gf32* cw = FIN(17) + (size_t)l * 3 * 512; const gf32* cb = FIN(18) + l * 512;
    const gf32* qkg = FIN(24) + l * 128; const gf32* kg = FIN(13) + l * 192 + 128;
    int lz = ((int)threadIdx.x & 63); asm volatile("" : "+v"(lz));
    const int lane = lz, c8 = lane * 8, j8 = lane & 7;
    float w0[8], w1[8], w2[8], bb[8], gq[8], gk[8], gr[8];
#pragma unroll
    for (int e = 0; e < 8; ++e) { w0[e] = cw[c8 + e]; w1[e] = cw[512 + c8 + e]; w2[e] = cw[1024 + c8 + e]; bb[e] = cb[c8 + e];
        gq[e] = qkg[j8 * 8 + e]; gk[e] = qkg[64 + j8 * 8 + e]; gr[e] = kg[j8 * 8 + e]; }
    int row0 = blockIdx.x * 8 + F.wave; asm volatile("" : "+s"(row0));
    for (int row = row0; row < MG; row += F.G * 8) {
        const int t = row % TT; gu16* pr = P + (size_t)row * NP;
        const bool hasl = (t != 0 && t != NCTX), hasr = (t != NCTX - 1 && t != TT - 1);
        const u32x4 lx0 = *(const GAS u32x4*)(pr + C_MX + c8);
        const u32x4 lxm = *(const GAS u32x4*)(pr + (hasl ? -NP : 0) + C_MX + c8);
        const u32x4 lxp = *(const GAS u32x4*)(pr + (hasr ? NP : 0) + C_MX + c8);
        const u32x4 ldq = *(const GAS u32x4*)(pr + C_DQ + c8), ldk = *(const GAS u32x4*)(pr + C_DK + c8), lkr = *(const GAS u32x4*)(pr + C_KR + j8 * 8);
        float rc[8], rs_[8];
        { const int s = t < NCTX ? 0 : t - NCTX, pos = (j8 & 4) ? (s & 63) : (s >> 6), i0 = 8 * (j8 & 1);
#pragma unroll
          for (int e = 0; e < 8; ++e) { rc[e] = rope[pos * 16 + i0 + e]; rs_[e] = rope[1024 + pos * 16 + i0 + e]; }
          if (t < NCTX) {
#pragma unroll
              for (int e = 0; e < 8; ++e) { rc[e] = 1.f; rs_[e] = 0.f; } } }
        const float sg = (j8 & 2) ? 1.f : -1.f;
        { float x0[8], xm[8], xp[8], o[8]; unpack8(lx0, x0); unpack8(lxm, xm); unpack8(lxp, xp);
#pragma unroll
          for (int e = 0; e < 8; ++e) { float a = bb[e] + w1[e] * x0[e]; a += hasl ? w0[e] * xm[e] : 0.f; a += hasr ? w2[e] * xp[e] : 0.f; o[e] = silu_f(a); }
          *(GAS u32x4*)(XC + (size_t)row * 512 + c8) = pack8(o); }
#pragma unroll
        for (int which = 0; which < 3; ++which) {
            float x[8]; unpack8(which == 0 ? ldq : (which == 1 ? ldk : lkr), x);
            float ss = 0.f;
#pragma unroll
            for (int e = 0; e < 8; ++e) ss += x[e] * x[e];
            ss = group_sum(ss, 8); const float rstd = rsqrtf(ss * (1.f / 64.f) + EPS);
#pragma unroll
            for (int e = 0; e < 8; ++e) x[e] = x[e] * rstd * (which == 0 ? gq[e] : (which == 1 ? gk[e] : gr[e]));
            float pp[8];
#pragma unroll
            for (int e = 0; e < 8; ++e) pp[e] = __shfl_xor(x[e], 2);
#pragma unroll
            for (int e = 0; e < 8; ++e) x[e] = x[e] * rc[e] + sg * pp[e] * rs_[e];
            if (which == 0) *(GAS u32x4*)(pr + C_DQ + c8) = pack8(x);
            else if (which == 1) *(GAS u32x4*)(pr + C_DK + c8) = pack8(x);
            else if (lane < 8) *(GAS u32x4*)(pr + C_KR + j8 * 8) = pack8(x);
        }
    }
}

DI float wave_incl_sum(float v, int lane) {
#pragma unroll
    for (int o = 1; o < 64; o <<= 1) { const float t = __shfl_up(v, o); if (lane >= o) v += t; }
    return v;
}
DI float wave_incl_max(float v, int lane) {
#pragma unroll
    for (int o = 1; o < 64; o <<= 1) { const float t = __shfl_up(v, o); if (lane >= o) v = fmaxf(v, t); }
    return v;
}
DI void p3_gates(const Ctx& F, int l) {
    const gu16* P = (const gu16*)(F.ws + WS_P);
    gf32* BGp = (gf32*)(F.ws + WS_BG); gf32* SC = (gf32*)(F.ws + WS_SCAL);
    LAS float* af = (LAS float*)F.lds;
    LAS float* gi = af + 64 * 32;
    int tz = (int)threadIdx.x; asm volatile("" : "+v"(tz));
    const int tid = tz, lane = tid & 63, wv = tid >> 6;
    const int dir = tid >> 8, col = tid & 255;
    float aw[16];
#pragma unroll
    for (int r = 0; r < 16; ++r) aw[r] = FIN(14)[(((size_t)l * 2 + dir) * 16 + r) * 256 + col];
    const float ab = FIN(15)[((size_t)l * 2 + dir) * 256 + col];
    const int md = wv >> 2, mh = wv & 3, mg0 = md * 2, mtk = md ? 63 - lane : lane;
    const float mbi = FIN(21)[l * 16 + mg0 * 4 + mh], mbf = FIN(21)[l * 16 + (mg0 + 1) * 4 + mh];
    for (int ch = blockIdx.x; ch < MG / 64; ch += F.G) {
        const size_t r0 = (size_t)ch * 64;
        __syncthreads();
        if (tid < 256) { const int r = tid >> 2, q = tid & 3; float f[8]; unpack8(*(const GAS u32x4*)(P + (r0 + r) * NP + C_AF + q * 8), f);
            *(LAS f32x4*)(af + r * 32 + q * 8) = (f32x4){f[0], f[1], f[2], f[3]}; *(LAS f32x4*)(af + r * 32 + q * 8 + 4) = (f32x4){f[4], f[5], f[6], f[7]}; }
        else if (tid < 384) { const int r = (tid - 256) >> 1, q = tid & 1; float f[8]; unpack8(*(const GAS u32x4*)(P + (r0 + r) * NP + C_IF + q * 8), f);
            *(LAS f32x4*)(gi + r * 16 + q * 8) = (f32x4){f[0], f[1], f[2], f[3]}; *(LAS f32x4*)(gi + r * 16 + q * 8 + 4) = (f32x4){f[4], f[5], f[6], f[7]}; }
        __syncthreads();
        { float run = 0.f; gf32* bo = BGp + ((size_t)dir * MG + r0) * 256 + col;
          for (int i = 0; i < 64; ++i) { const int tk = dir ? 63 - i : i;
              const LAS f32x4* ar = (const LAS f32x4*)(af + tk * 32 + dir * 16);
              const f32x4 a0 = ar[0], a1 = ar[1], a2 = ar[2], a3 = ar[3];
              float x = ab + a0[0] * aw[0] + a0[1] * aw[1] + a0[2] * aw[2] + a0[3] * aw[3] + a1[0] * aw[4] + a1[1] * aw[5] + a1[2] * aw[6] + a1[3] * aw[7]
                           + a2[0] * aw[8] + a2[1] * aw[9] + a2[2] * aw[10] + a2[3] * aw[11] + a3[0] * aw[12] + a3[1] * aw[13] + a3[2] * aw[14] + a3[3] * aw[15];
              run += logsig_f(x) * (1.f / 16.f); bo[(size_t)tk * 256] = run; } }
        { const float li = gi[mtk * 16 + mg0 * 4 + mh] + mbi, lfv = logsig_f(gi[mtk * 16 + (mg0 + 1) * 4 + mh] + mbf);
          const float b = wave_incl_sum(lfv, lane), a = li - b, pm = wave_incl_max(a, lane);
          *(GAS f32x4*)(SC + (((size_t)md * MG + r0 + mtk) * 4 + mh) * 4) = (f32x4){b, a, pm, 0.f}; }
    }
}

DI void p3b_rows(const Ctx& F, int l) {
    const gu16* P = (const gu16*)(F.ws + WS_P); gu16* Q = (gu16*)(F.ws + WS_Q); gu16* KV = (gu16*)(F.ws + WS_KV);
    const gf32* rope = (const gf32*)(F.ws + WS_ROPE);
    const gf32* qg = FIN(12) + l * 192; const gf32* kg = FIN(13) + l * 192;
    int lz = ((int)threadIdx.x & 63); asm volatile("" : "+v"(lz));
    const int lane = lz, c8 = lane * 8, j8 = lane & 7, l32 = lane & 31, d0 = (lane & 15) * 8;
    float gqn[8], gqr[8], gkn[8];
#pragma unroll
    for (int e = 0; e < 8; ++e) { gqn[e] = qg[d0 + e]; gqr[e] = qg[128 + j8 * 8 + e]; gkn[e] = kg[d0 + e]; }
    int row0 = blockIdx.x * 8 + F.wave; asm volatile("" : "+s"(row0));
    for (int row = row0; row < MG; row += F.G * 8) {
        const int t = row % TT; const gu16* pr = P + (size_t)row * NP;
        const u32x4 lcq = *(const GAS u32x4*)(pr + C_CQ + (lane < 48 ? c8 : 0)), lck = *(const GAS u32x4*)(pr + C_CKV + (lane < 32 ? c8 : 0));
        const u32x4 lqn = *(const GAS u32x4*)(Q + (size_t)row * 768 + c8), lqr = *(const GAS u32x4*)(Q + (size_t)row * 768 + 512 + l32 * 8);
        const u32x4 lkn = *(const GAS u32x4*)(KV + (size_t)row * 1024 + c8), lvv = *(const GAS u32x4*)(KV + (size_t)row * 1024 + 512 + c8);
        float rc[8], rs_[8];
        { const int s = t < NCTX ? 0 : t - NCTX, pos = (j8 & 4) ? (s & 63) : (s >> 6), i0 = 8 * (j8 & 1);
#pragma unroll
          for (int e = 0; e < 8; ++e) { rc[e] = rope[pos * 16 + i0 + e]; rs_[e] = rope[1024 + pos * 16 + i0 + e]; }
          if (t < NCTX) {
#pragma unroll
              for (int e = 0; e < 8; ++e) { rc[e] = 1.f; rs_[e] = 0.f; } } }
        const float sg = (j8 & 2) ? 1.f : -1.f;
        float ss = 0.f;
        { float x[8]; unpack8(lcq, x);
#pragma unroll
          for (int e = 0; e < 8; ++e) ss += x[e] * x[e]; }
        const float rq = rsqrtf(wave_sum(lane < 48 ? ss : 0.f) * (1.f / 384.f) + EPS);
        ss = 0.f;
        { float x[8]; unpack8(lck, x);
#pragma unroll
          for (int e = 0; e < 8; ++e) ss += x[e] * x[e]; }
        const float rk = rsqrtf(wave_sum(lane < 32 ? ss : 0.f) * (1.f / 256.f) + EPS);
        { float x[8]; unpack8(lqn, x); float s2 = 0.f;
#pragma unroll
          for (int e = 0; e < 8; ++e) { x[e] *= rq; s2 += x[e] * x[e]; }
          s2 = group_sum(s2, 16); const float rs = rsqrtf(s2 * (1.f / 128.f) + EPS);
#pragma unroll
          for (int e = 0; e < 8; ++e) x[e] = x[e] * rs * gqn[e];
          *(GAS u32x4*)(Q + (size_t)row * 768 + c8) = pack8(x); }
        { float x[8]; unpack8(lqr, x); float s2 = 0.f;
#pragma unroll
          for (int e = 0; e < 8; ++e) { x[e] *= rq; s2 += x[e] * x[e]; }
          s2 = group_sum(s2, 8); const float rs = rsqrtf(s2 * (1.f / 64.f) + EPS);
#pragma unroll
          for (int e = 0; e < 8; ++e) x[e] = x[e] * rs * gqr[e];
          float pp[8];
#pragma unroll
          for (int e = 0; e < 8; ++e) pp[e] = __shfl_xor(x[e], 2);
#pragma unroll
          for (int e = 0; e < 8; ++e) x[e] = x[e] * rc[e] + sg * pp[e] * rs_[e];
          if (lane < 32) *(GAS u32x4*)(Q + (size_t)row * 768 + 512 + l32 * 8) = pack8(x); }
        { float x[8]; unpack8(lkn, x); float s2 = 0.f;
#pragma unroll
          for (int e = 0; e < 8; ++e) { x[e] *= rk; s2 += x[e] * x[e]; }
          s2 = group_sum(s2, 16); const float rs = rsqrtf(s2 * (1.f / 128.f) + EPS);
#pragma unroll
          for (int e = 0; e < 8; ++e) x[e] = x[e] * rs * gkn[e];
          *(GAS u32x4*)(KV + (size_t)row * 1024 + c8) = pack8(x); }
        { float x[8]; unpack8(lvv, x);
#pragma unroll
          for (int e = 0; e < 8; ++e) x[e] *= rk;
          *(GAS u32x4*)(KV + (size_t)row * 1024 + 512 + c8) = pack8(x); }
    }
}
constexpr int AT_KN = 16384, AT_KR = 8192, AT_V = 16384;
constexpr int AT_BUF = AT_V + AT_KN + AT_KR;
constexpr int AT_WS = 147456;
constexpr int AT_EST = 132;
template <int MODE>
DI void attn_unit(const Ctx& F, int l, int bl, int h, int q0, int nkeys) {
#ifdef TPROBE
    const unsigned long long tatt0 = __builtin_amdgcn_s_memrealtime();
#endif
    int tz = (int)threadIdx.x; asm volatile("" : "+v"(tz));
    const int tid = tz, wid = F.wave, lane = tz & 63;
    LAS unsigned char* lds = F.lds;
    const gu16* P = (const gu16*)(F.ws + WS_P); const gu16* Qb = (const gu16*)(F.ws + WS_Q); const gu16* KVb = (const gu16*)(F.ws + WS_KV);
    const size_t rb = (size_t)bl * TT;
    constexpr int NDQ = MODE == 0 ? 12 : 4;
    const float SC = MODE == 0 ? 0.07216878364870322f : 0.125f;
    const float C = SC * 1.4426950408889634f;
    LAS float* wsf = (LAS float*)(lds + AT_WS) + wid * 64;
    const int r32 = lane & 31, hi = lane >> 5;
    const int qrow = q0 + (MODE == 0 ? wid * 32 : (wid & 3) * 32) + r32;
    bf16x8 qr[NDQ];
    if constexpr (MODE == 0) { const gu16* qp = Qb + (rb + qrow) * 768;
#pragma unroll
        for (int d0 = 0; d0 < 8; ++d0) qr[d0] = *(const GAS bf16x8*)(qp + h * 128 + d0 * 16 + hi * 8);
#pragma unroll
        for (int d0 = 0; d0 < 4; ++d0) qr[8 + d0] = *(const GAS bf16x8*)(qp + 512 + h * 64 + d0 * 16 + hi * 8);
    } else { const gu16* qp = P + (rb + qrow) * NP + C_DQ + h * 128 + (wid >> 2) * 64;
#pragma unroll
        for (int d0 = 0; d0 < 4; ++d0) qr[d0] = *(const GAS bf16x8*)(qp + d0 * 16 + hi * 8); }
    const int sr = tid >> 4, sc = (tid & 15) * 8, vst0 = v_st(sr, sc), vst1 = v_st(32 + sr, sc);
    const int kr_r = tid >> 3, kr_c = (tid & 7) * 8;
    const gu16* kbase; const gu16* vbase; size_t kld;
    if (MODE == 0) { kbase = KVb + rb * 1024 + h * 128; vbase = KVb + rb * 1024 + 512 + h * 128; kld = 1024; }
    else { kbase = P + rb * NP + C_DK + h * 128; vbase = P + rb * NP + C_DV + h * 128; kld = NP; }
    const gu16* krbase = P + rb * NP + C_KR;
    u32x4 sv0, sv1, sk0, sk1, skr;
#define SLOAD(k0) do { sv0 = *(const GAS u32x4*)(vbase + (size_t)((k0) + sr) * kld + sc); sv1 = *(const GAS u32x4*)(vbase + (size_t)((k0) + 32 + sr) * kld + sc); \
        sk0 = *(const GAS u32x4*)(kbase + (size_t)((k0) + sr) * kld + sc); sk1 = *(const GAS u32x4*)(kbase + (size_t)((k0) + 32 + sr) * kld + sc); \
        if (MODE == 0) skr = *(const GAS u32x4*)(krbase + (size_t)((k0) + kr_r) * NP + kr_c); } while (0)
#define SWRITE(b) do { LAS unsigned char* bb = lds + (b) * AT_BUF; *(LAS u32x4*)(bb + vst0) = sv0; *(LAS u32x4*)(bb + vst1) = sv1; \
        *(LAS u32x4*)(bb + AT_V + kswz(sr, sc * 2)) = sk0; *(LAS u32x4*)(bb + AT_V + kswz(32 + sr, sc * 2)) = sk1; \
        if (MODE == 0) *(LAS u32x4*)(bb + AT_V + AT_KN + swz64(kr_r, kr_c * 2)) = skr; } while (0)
    float m_reg = -1e30f, l_reg = 0.f; f32x16 o[4];
#pragma unroll
    for (int d = 0; d < 4; ++d)
#pragma unroll
        for (int r = 0; r < 16; ++r) o[d][r] = 0.f;
    const int NT = nkeys / 64;
    const int vrb = (int)(uintptr_t)lds + v_rd_base(lane);
    const int kcol0 = (MODE == 1) ? (wid >> 2) * 128 : 0;
    SLOAD(0); SWRITE(0); if (NT > 1) SLOAD(64); __syncthreads();
    for (int j = 0; j < NT; ++j) {
        const int cur = j & 1;
        f32x16 p0, p1;
#pragma unroll
        for (int r = 0; r < 16; ++r) { p0[r] = 0.f; p1[r] = 0.f; }
        { const LAS unsigned char* kb = lds + cur * AT_BUF + AT_V;
#pragma unroll
          for (int d0 = 0; d0 < (MODE == 0 ? 8 : 4); ++d0) { const int cb = kcol0 + (d0 * 16 + hi * 8) * 2;
              const bf16x8 b0 = ldsv(kb + kswz(r32, cb)), b1 = ldsv(kb + kswz(32 + r32, cb));
              p0 = MFMA32(b0, qr[d0], p0); p1 = MFMA32(b1, qr[d0], p1); }
          if constexpr (MODE == 0) {
#pragma unroll
              for (int d0 = 0; d0 < 4; ++d0) { const int cb = (d0 * 16 + hi * 8) * 2;
                  const bf16x8 b0 = ldsv(kb + AT_KN + swz64(r32, cb)), b1 = ldsv(kb + AT_KN + swz64(32 + r32, cb));
                  p0 = MFMA32(b0, qr[8 + d0], p0); p1 = MFMA32(b1, qr[8 + d0], p1); } } }
        if (j + 1 < NT) SWRITE(cur ^ 1);
        SBAR();
        float pmax = p0[0];
#pragma unroll
        for (int r = 1; r < 16; ++r) pmax = fmaxf(pmax, p0[r]);
#pragma unroll
        for (int r = 0; r < 16; ++r) pmax = fmaxf(pmax, p1[r]);
        pmax = half_swap_max(pmax);
        float mn, alpha;
        if (__all((pmax - m_reg) * SC <= 8.f)) { mn = m_reg; alpha = 1.f; }
        else { mn = fmaxf(m_reg, pmax); alpha = __builtin_amdgcn_exp2f((m_reg - mn) * C); m_reg = mn; }
        const float mnC = -mn * C; float ps = 0.f;
#pragma unroll
        for (int r = 0; r < 16; ++r) { p0[r] = __builtin_amdgcn_exp2f(fmaf(p0[r], C, mnC)); ps += p0[r]; }
#pragma unroll
        for (int r = 0; r < 16; ++r) { p1[r] = __builtin_amdgcn_exp2f(fmaf(p1[r], C, mnC)); ps += p1[r]; }
        ps = half_swap_sum(ps);
        l_reg = l_reg * alpha + ps;
        bf16x8 pa[4]; p_to_afrag(p0, p1, pa);
        SBAR();
        if (j + 2 < NT) SLOAD((j + 2) * 64);
        if (__any(alpha < 1.f)) { if (hi == 0) wsf[r32] = alpha; asm volatile("s_waitcnt lgkmcnt(0)" ::: "memory");
#pragma unroll
            for (int r = 0; r < 16; ++r) { const float a = wsf[crow(r, hi)];
#pragma unroll
                for (int d = 0; d < 4; ++d) o[d][r] *= a; } }
#pragma unroll
        for (int d0 = 0; d0 < 4; ++d0) { bf16x8 vf[4]; v_frags(vrb + cur * AT_BUF + d0 * 512, vf);
#pragma unroll
            for (int ks = 0; ks < 4; ++ks) o[d0] = MFMA32(pa[ks], vf[ks], o[d0]); }
        __syncthreads();
    }
#undef SLOAD
#undef SWRITE
    int lz = lane; asm volatile("" : "+v"(lz));
    const int er = lz & 31, eh = lz >> 5;
    if (eh == 0) wsf[er] = l_reg; asm volatile("s_waitcnt lgkmcnt(0)" ::: "memory");
    float rli[16];
#pragma unroll
    for (int r = 0; r < 16; ++r) rli[r] = __builtin_amdgcn_rcpf(wsf[crow(r, eh)]);
    if constexpr (MODE == 0) {
        gu16* Y = (gu16*)(F.ws + WS_Y);
        const size_t row0 = rb + q0 + wid * 32;
        LAS float* et = (LAS float*)(lds + wid * (32 * AT_EST * 4));
#pragma unroll
        for (int r = 0; r < 16; ++r)
#pragma unroll
            for (int d0 = 0; d0 < 4; ++d0) et[crow(r, eh) * AT_EST + d0 * 32 + er] = o[d0][r] * rli[r];
        asm volatile("s_waitcnt lgkmcnt(0)" ::: "memory");
        u32x4 zz[8];
#pragma unroll
        for (int ps = 0; ps < 8; ++ps) { const int idx = ps * 64 + lz, row = idx >> 4, ch = idx & 15; zz[ps] = *(const GAS u32x4*)(P + (row0 + row) * NP + C_MZ + h * 128 + ch * 8); }
#pragma unroll
        for (int ps = 0; ps < 8; ++ps) { const int idx = ps * 64 + lz, row = idx >> 4, ch = idx & 15;
            const f32x4 a = *(const LAS f32x4*)(et + row * AT_EST + ch * 8), b = *(const LAS f32x4*)(et + row * AT_EST + ch * 8 + 4);
            float z[8]; unpack8(zz[ps], z);
#pragma unroll
            for (int e = 0; e < 8; ++e) z[e] = silu_f(z[e]);
            float f[8] = {a[0] * z[0], a[1] * z[1], a[2] * z[2], a[3] * z[3], b[0] * z[4], b[1] * z[5], b[2] * z[6], b[3] * z[7]};
            *(GAS u32x4*)(Y + (row0 + row) * 512 + h * 128 + ch * 8) = pack8(f); }
    } else {
        LAS float* ex = (LAS float*)lds;
        const int lr0 = (wid & 3) * 32;
        if (wid >= 4) {
#pragma unroll
            for (int r = 0; r < 16; ++r)
#pragma unroll
                for (int d0 = 0; d0 < 4; ++d0) ex[(lr0 + crow(r, eh)) * AT_EST + d0 * 32 + er] = o[d0][r] * rli[r];
        }
        __syncthreads();
        if (wid < 4) {
            const float lam = ((const gf32*)(F.ws + WS_LAM))[l];
            const float lam_init = 0.8f - 0.6f * __expf(-0.3f * (float)l);
            const gf32* og = FIN(26) + l * 128;
            gu16* Y = (gu16*)(F.ws + WS_Y) + (size_t)3 * MG * 512;
            const size_t row0 = rb + q0 + lr0;
            u32x4 zz[8];
#pragma unroll
            for (int ps = 0; ps < 8; ++ps) { const int idx = ps * 64 + lz, row = idx >> 4, ch = idx & 15; zz[ps] = *(const GAS u32x4*)(P + (row0 + row) * NP + C_DZ + h * 128 + ch * 8); }
            float gg[4];
#pragma unroll
            for (int d0 = 0; d0 < 4; ++d0) gg[d0] = og[d0 * 32 + er] * (1.f - lam_init);
#pragma unroll
            for (int r = 0; r < 16; ++r) { const int lr = lr0 + crow(r, eh); float v[4]; float ss = 0.f;
#pragma unroll
                for (int d0 = 0; d0 < 4; ++d0) { v[d0] = o[d0][r] * rli[r] - lam * ex[lr * AT_EST + d0 * 32 + er]; ss += v[d0] * v[d0]; }
                ss += __shfl_xor(ss, 1); ss += __shfl_xor(ss, 2); ss += __shfl_xor(ss, 4); ss += __shfl_xor(ss, 8); ss += __shfl_xor(ss, 16);
                const float rs = rsqrtf(ss * (1.f / 128.f) + EPS);
#pragma unroll
                for (int d0 = 0; d0 < 4; ++d0) ex[lr * AT_EST + d0 * 32 + er] = v[d0] * rs * gg[d0]; }
            asm volatile("s_waitcnt lgkmcnt(0)" ::: "memory");
#pragma unroll
            for (int ps = 0; ps < 8; ++ps) { const int idx = ps * 64 + lz, row = idx >> 4, ch = idx & 15;
                const f32x4 a = *(const LAS f32x4*)(ex + (lr0 + row) * AT_EST + ch * 8), b = *(const LAS f32x4*)(ex + (lr0 + row) * AT_EST + ch * 8 + 4);
                float z[8]; unpack8(zz[ps], z);
#pragma unroll
                for (int e = 0; e < 8; ++e) z[e] = silu_f(z[e]);
                float f[8] = {a[0] * z[0], a[1] * z[1], a[2] * z[2], a[3] * z[3], b[0] * z[4], b[1] * z[5], b[2] * z[6], b[3] * z[7]};
                *(GAS u32x4*)(Y + (row0 + row) * 512 + h * 128 + ch * 8) = pack8(f); }
        }
        __syncthreads();
    }
#ifdef TPROBE
    if (threadIdx.x == 0 && nkeys == TT) __hip_atomic_fetch_add((GAS unsigned long long*)(F.ctl + 8192) + 24 + MODE, __builtin_amdgcn_s_memrealtime() - tatt0, __ATOMIC_RELAXED, __HIP_MEMORY_SCOPE_AGENT);
#endif
}
constexpr int SC_DIR = 40960;
constexpr int SC_QB = 0, SC_KA = 8192, SC_KT = 16384, SC_VI = 24576;
constexpr int SC_ST = 2 * SC_DIR;
constexpr int SC_SCL = SC_ST + 8 * 4096;
constexpr int SC_OST = SC_SCL + 8192;
constexpr int SC_PA = SC_OST + 8 * 2560;
static_assert(SC_PA + 2 * 8192 <= LDS_MISC, "scan LDS map");
template <int MIX>
DI void scan_unit(const Ctx& F, int l, int bl, int h) {
    int tz = (int)threadIdx.x; asm volatile("" : "+v"(tz));
    const int tid = tz, wid = F.wave, lane = tz & 63;
    const int dir = wid >> 2, w4 = wid & 3, tl = tid & 255;
    LAS unsigned char* lds = F.lds;
    LAS unsigned char* db = lds + dir * SC_DIR;
    LAS unsigned char* stp = lds + SC_ST + wid * 4096;
    LAS float* scl = (LAS float*)(lds + SC_SCL + dir * 4096);
    LAS float* xch = scl + 256 + w4 * 32;
    const gu16* P = (const gu16*)(F.ws + WS_P);
    const size_t rb = (size_t)bl * TT;
    gu16* osc = (gu16*)(F.ws + WS_OSC) + ((size_t)(MIX * 2 + dir) * MG) * 512;
    for (int e = lane; e < 1024; e += 64) ((LAS unsigned*)stp)[e] = 0u;
    if (tid < 128) { const int d2 = tid >> 6; ((LAS float*)(lds + SC_SCL + d2 * 4096))[192 + (tid & 63)] = 0.f; }
    f32x16 S[2];
#pragma unroll
    for (int k = 0; k < 2; ++k)
#pragma unroll
        for (int r = 0; r < 16; ++r) S[k][r] = 0.f;
    float m_run = 0.f;
    const int pi = tl >> 2, pd0 = (tl & 3) * 16;
    const int vr = tl >> 4, vc = (tl & 15) * 8;
    const int vrb = (int)(uintptr_t)db + SC_VI + v_rd_base(lane) + w4 * 512;
    u32x4 rq[2], rk[2], rv[4]; f32x4 rb4[4], rl4[1];
#define TOK(c, i) (dir == 0 ? (c) * 64 + (i) : ((c) < 4 ? (3 - (c)) : (39 - (c))) * 64 + 63 - (i))
#define CLOAD(c) do { const size_t g = rb + TOK(c, pi), gl = rb + TOK(c, 63); \
        if (MIX == 0) { const gu16* qp = P + g * NP + C_GQ + h * 64 + pd0; rq[0] = *(const GAS u32x4*)qp; rq[1] = *(const GAS u32x4*)(qp + 8); \
            const gu16* kp = P + g * NP + C_GK + h * 64 + pd0; rk[0] = *(const GAS u32x4*)kp; rk[1] = *(const GAS u32x4*)(kp + 8); \
            const gf32* bp = (const gf32*)(F.ws + WS_BG) + ((size_t)dir * MG + g) * 256 + h * 64 + pd0; \
            _Pragma("unroll") for (int z = 0; z < 4; ++z) rb4[z] = *(const GAS f32x4*)(bp + 4 * z); \
        } else { const gu16* qp = (const gu16*)(F.ws + WS_QKML) + g * 512 + h * 64 + pd0; rq[0] = *(const GAS u32x4*)qp; rq[1] = *(const GAS u32x4*)(qp + 8); \
            rk[0] = *(const GAS u32x4*)(qp + 256); rk[1] = *(const GAS u32x4*)(qp + 264); \
            rb4[0] = *(const GAS f32x4*)((const gf32*)(F.ws + WS_SCAL) + (((size_t)dir * MG + g) * 4 + h) * 4); rl4[0] = *(const GAS f32x4*)((const gf32*)(F.ws + WS_SCAL) + (((size_t)dir * MG + gl) * 4 + h) * 4); } } while (0)
#define VLOAD(c) do { _Pragma("unroll") for (int z = 0; z < 4; ++z) rv[z] = *(const GAS u32x4*)(P + (rb + TOK(c, vr + 16 * z)) * NP + (MIX == 0 ? C_GV : C_MV) + h * 128 + vc); } while (0)
    CLOAD(0); VLOAD(0);
    __syncthreads();
#ifdef TPROBE
    unsigned long long tacc0 = 0, tacc1 = 0, tacc2 = 0, tacc3 = 0, tacc4 = 0, tacc5 = 0, tacc6 = 0; const unsigned long long tunit0 = __builtin_amdgcn_s_memrealtime(); unsigned long long tprev = tunit0;
#define TSTAMP(acc) do { const unsigned long long tn_ = __builtin_amdgcn_s_memrealtime(); acc += tn_ - tprev; tprev = tn_; } while (0)
#else
#define TSTAMP(acc) do { } while (0)
#endif
    for (int c = 0; c < 36; ++c) {
        float m_new = 0.f, decay = 1.f, M63 = 0.f;
#ifndef REP_SPREP
#define REP_SPREP 1
#endif
#ifndef REP_SQB
#define REP_SQB 1
#endif
        _Pragma("nounroll") for (int rep = 0; rep < REP_SPREP; ++rep) {
        { float q[16], k[16]; unpack8(rq[0], q); unpack8(rq[1], q + 8); unpack8(rk[0], k); unpack8(rk[1], k + 8);
          float qe[16], ke[16], kt[16];
          if (MIX == 0) {
#pragma unroll
              for (int e = 0; e < 16; ++e) { const float bb = rb4[e >> 2][e & 3];
                  qe[e] = q[e] * __expf(bb); ke[e] = k[e] * __expf(-bb); kt[e] = ke[e]; }
              if (pi == 63) {
#pragma unroll
                  for (int e = 0; e < 16; ++e) scl[pd0 + e] = __expf(rb4[e >> 2][e & 3]); }
          } else {
              const float b_i = rb4[0][0], a_i = rb4[0][1], pm_i = rb4[0][2], bL = rl4[0][0], pmL = rl4[0][2];
              M63 = fmaxf(m_run, pmL); m_new = bL + M63; decay = __expf(m_run - M63);
              const float wu = __expf(a_i - M63);
#pragma unroll
              for (int e = 0; e < 16; ++e) { qe[e] = q[e]; ke[e] = k[e]; kt[e] = k[e] * wu; }
              float qn = 0.f;
#pragma unroll
              for (int e = 0; e < 16; ++e) qn += q[e] * scl[192 + pd0 + e];
              qn += __shfl_xor(qn, 1); qn += __shfl_xor(qn, 2);
              if ((tl & 3) == 0) { scl[pi] = b_i; scl[64 + pi] = a_i; scl[128 + pi] = pm_i; scl[384 + pi] = qn; }
          }
          *(LAS u32x4*)(db + SC_QB + swz64(pi, pd0 * 2)) = pack8(qe); *(LAS u32x4*)(db + SC_QB + swz64(pi, pd0 * 2 + 16)) = pack8(qe + 8);
          *(LAS u32x4*)(db + SC_KA + swz64(pi, pd0 * 2)) = pack8(ke); *(LAS u32x4*)(db + SC_KA + swz64(pi, pd0 * 2 + 16)) = pack8(ke + 8);
#pragma unroll
          for (int e = 0; e < 16; ++e) *(LAS u16*)(db + SC_KT + swz64(pd0 + e, pi * 2)) = f2bf(kt[e]);
        }
#pragma unroll
        for (int z = 0; z < 4; ++z) *(LAS u32x4*)(db + SC_VI + v_st(vr + 16 * z, vc)) = rv[z];
        }
        if (c + 1 < 36) { CLOAD(c + 1); VLOAD(c + 1); }
        TSTAMP(tacc0);
        __syncthreads();
        TSTAMP(tacc1);
        int lz = lane; asm volatile("" : "+v"(lz));
        const int r32 = lz & 31, hi = lz >> 5;
        LAS unsigned char* pab = lds + SC_PA + dir * 8192;
        { const int sqb = w4 & 1, skh = w4 >> 1;
          bf16x8 qf[4];
#pragma unroll
          for (int ks = 0; ks < 4; ++ks) qf[ks] = ldsv(db + SC_QB + sqb * 4096 + swz64(r32, (ks * 16 + hi * 8) * 2));
          f32x16 p;
#pragma unroll
          for (int r = 0; r < 16; ++r) p[r] = 0.f;
#pragma unroll
          for (int ks = 0; ks < 4; ++ks) p = MFMA32(ldsv(db + SC_KA + skh * 4096 + swz64(r32, (ks * 16 + hi * 8) * 2)), qf[ks], p);
          const int qi = 32 * sqb + r32;
          if (MIX == 0) {
#pragma unroll
              for (int r = 0; r < 16; ++r) p[r] = (crow(r, hi) + 32 * skh <= qi) ? p[r] : 0.f;
          } else {
              const float Mq = fmaxf(m_run, scl[128 + qi]); float rs = 0.f;
              float av[16];
#pragma unroll
              for (int r = 0; r < 16; ++r) av[r] = scl[64 + 32 * skh + crow(r, hi)];
#pragma unroll
              for (int r = 0; r < 16; ++r) { const int kk = crow(r, hi) + 32 * skh; const float e = __expf(fminf(av[r] - Mq, 0.f));
                  p[r] = p[r] * ((kk <= qi) ? e : 0.f); rs += p[r]; }
              rs = half_swap_sum(rs);
              if (hi == 0) scl[448 + skh * 64 + qi] = rs;
          }
#pragma unroll
          for (int g4 = 0; g4 < 4; ++g4) { u32x2 w; w.x = pk2(p[4 * g4], p[4 * g4 + 1]); w.y = pk2(p[4 * g4 + 2], p[4 * g4 + 3]);
              *(LAS u32x2*)(pab + swz64(qi, (32 * skh + 8 * g4 + 4 * hi) * 2)) = w; }
        }
        TSTAMP(tacc2);
        __syncthreads();
        TSTAMP(tacc3);
        bf16x8 bs[4];
#pragma unroll
        for (int ks = 0; ks < 4; ++ks) bs[ks] = ldsv(stp + swz64(r32, (ks * 16 + hi * 8) * 2));
        bf16x8 vf[4]; v_frags(vrb, vf);
#pragma nounroll
        for (int qb2 = 0; qb2 < 2 * REP_SQB; ++qb2) { const int qb = qb2 & 1;
            f32x16 o;
#pragma unroll
            for (int r = 0; r < 16; ++r) o[r] = 0.f;
#pragma unroll
            for (int ks = 0; ks < 4; ++ks) o = MFMA32(bs[ks], ldsv(db + SC_QB + qb * 4096 + swz64(r32, (ks * 16 + hi * 8) * 2)), o);
            const int qi = 32 * qb + r32;
            float scale_q = 1.f;
            if (MIX == 1) {
                const float Mq = fmaxf(m_run, scl[128 + qi]);
                const float iw = __expf(m_run - Mq), den = iw * scl[384 + qi] + scl[448 + qi] + scl[512 + qi], mi = scl[qi] + Mq;
                scale_q = 1.f / fmaxf(fabsf(den), __expf(-mi));
#pragma unroll
                for (int r = 0; r < 16; ++r) o[r] *= iw;
            }
#pragma unroll
            for (int ks = 0; ks < 4; ++ks) o = MFMA32(vf[ks], ldsv(pab + qb * 4096 + swz64(r32, (ks * 16 + hi * 8) * 2)), o);
            unsigned d[4][2];
#pragma unroll
            for (int g4 = 0; g4 < 4; ++g4) { d[g4][0] = pk2(o[4 * g4] * scale_q, o[4 * g4 + 1] * scale_q); d[g4][1] = pk2(o[4 * g4 + 2] * scale_q, o[4 * g4 + 3] * scale_q); }
            u32x4 w0, w1;
            { auto a0 = __builtin_amdgcn_permlane32_swap(d[0][0], d[2][0], false, false); auto a1 = __builtin_amdgcn_permlane32_swap(d[0][1], d[2][1], false, false);
              auto b0 = __builtin_amdgcn_permlane32_swap(d[1][0], d[3][0], false, false); auto b1 = __builtin_amdgcn_permlane32_swap(d[1][1], d[3][1], false, false);
              w0 = (u32x4){a0[0], a1[0], a0[1], a1[1]}; w1 = (u32x4){b0[0], b1[0], b0[1], b1[1]}; }
            gu16* orow = osc + (rb + TOK(c, qi)) * 512 + h * 128 + w4 * 32 + hi * 16;
            *(GAS u32x4*)orow = w0; *(GAS u32x4*)(orow + 8) = w1;
        }
        TSTAMP(tacc4);
        float nnew = 0.f;
#pragma unroll
        for (int dk = 0; dk < 2; ++dk) {
            if (MIX == 1) {
#pragma unroll
                for (int r = 0; r < 16; ++r) S[dk][r] *= decay;
            }
#pragma unroll
            for (int ks = 0; ks < 4; ++ks) { const bf16x8 a = ldsv(db + SC_KT + swz64(32 * dk + r32, (ks * 16 + hi * 8) * 2)); S[dk] = MFMA32(a, vf[ks], S[dk]); }
            if (MIX == 0) {
#pragma unroll
                for (int r = 0; r < 16; ++r) S[dk][r] *= scl[32 * dk + crow(r, hi)];
            }
        }
        if (MIX == 1 && w4 == 0) {
            float sum = 0.f;
#pragma unroll
            for (int j = 0; j < 8; ++j) { float kv[8]; unpack8(__builtin_bit_cast(u32x4, ldsv(db + SC_KT + swz64(lane, j * 16))), kv);
#pragma unroll
                for (int e = 0; e < 8; ++e) sum += kv[e]; }
            nnew = decay * scl[192 + lane] + sum;
            scl[192 + lane] = nnew;
        }
#pragma unroll
        for (int dk = 0; dk < 2; ++dk)
#pragma unroll
            for (int g4 = 0; g4 < 4; ++g4) { u32x2 w; w.x = pk2(S[dk][4 * g4], S[dk][4 * g4 + 1]); w.y = pk2(S[dk][4 * g4 + 2], S[dk][4 * g4 + 3]);
                *(LAS u32x2*)(stp + swz64(r32, (32 * dk + 8 * g4 + 4 * hi) * 2)) = w; }
        if (MIX == 1) m_run = m_new;
        TSTAMP(tacc5);
        __syncthreads();
        TSTAMP(tacc6);
    }
#undef CLOAD
    asm volatile("s_waitcnt vmcnt(0)" ::: "memory");
    __syncthreads();
    {
        const gu16* of = (const gu16*)(F.ws + WS_OSC) + ((size_t)(MIX * 2 + 0) * MG) * 512;
        const gu16* ob = (const gu16*)(F.ws + WS_OSC) + ((size_t)(MIX * 2 + 1) * MG) * 512;
        gu16* Y = (gu16*)(F.ws + WS_Y) + (size_t)(MIX == 0 ? 1 : 2) * MG * 512;
        const gf32* og = (MIX == 0 ? FIN(16) : FIN(22)) + l * 512 + h * 128;
        const gf32* skp = FIN(23) + l * 512 + h * 128;
        const gu16* XC = (const gu16*)(F.ws + WS_XC);
        int tq = (int)threadIdx.x; asm volatile("" : "+v"(tq));
        const int c8 = (tq & 15) * 8;
        float g8[8], s8[8];
#pragma unroll
        for (int e = 0; e < 8; ++e) { g8[e] = og[c8 + e]; s8[e] = (MIX == 1) ? skp[c8 + e] : 0.f; }
        for (int t0 = tq >> 4; t0 < TT; t0 += 128) {
            u32x4 la[4], lb[4], lz4[4], lo[4], lx[4];
#pragma unroll
            for (int u = 0; u < 4; ++u) { const size_t row = rb + t0 + 32 * u; const int col = h * 128 + c8;
                la[u] = *(const GAS u32x4*)(of + row * 512 + col); lb[u] = *(const GAS u32x4*)(ob + row * 512 + col);
                lz4[u] = *(const GAS u32x4*)(P + row * NP + (MIX == 0 ? C_GZ : C_MLZ) + col);
                if (MIX == 1) { lo[u] = *(const GAS u32x4*)(P + row * NP + C_MO + col); lx[u] = *(const GAS u32x4*)(XC + row * 512 + col); } }
#pragma unroll
            for (int u = 0; u < 4; ++u) { const size_t row = rb + t0 + 32 * u; const int col = h * 128 + c8;
                float a[8], b[8], v[8]; unpack8(la[u], a); unpack8(lb[u], b);
                float ss = 0.f;
                if (MIX == 1) { float og8[8]; unpack8(lo[u], og8);
#pragma unroll
                    for (int e = 0; e < 8; ++e) og8[e] = sigmoid_f(og8[e]);
#pragma unroll
                    for (int e = 0; e < 8; ++e) { v[e] = (a[e] + b[e]) * og8[e]; ss += v[e] * v[e]; }
                } else {
#pragma unroll
                    for (int e = 0; e < 8; ++e) { v[e] = a[e] + b[e]; ss += v[e] * v[e]; } }
                ss = group_sum(ss, 16);
                const float rs = rsqrtf(ss * (1.f / 128.f) + EPS);
                float z[8]; unpack8(lz4[u], z);
#pragma unroll
                for (int e = 0; e < 8; ++e) z[e] = silu_f(z[e]);
                if (MIX == 1) { float xc[8]; unpack8(lx[u], xc);
#pragma unroll
                    for (int e = 0; e < 8; ++e) v[e] = (v[e] * rs * g8[e] + s8[e] * xc[e]) * z[e];
                } else {
#pragma unroll
                    for (int e = 0; e < 8; ++e) v[e] = v[e] * rs * g8[e] * z[e]; }
                *(GAS u32x4*)(Y + row * 512 + col) = pack8(v); }
        }
    }
    __syncthreads();
#ifdef TPROBE
    if (threadIdx.x == 0) { GAS unsigned long long* tm = (GAS unsigned long long*)(F.ctl + 8192) + MIX * 8;
        const unsigned long long tall = __builtin_amdgcn_s_memrealtime() - tunit0;
        __hip_atomic_fetch_add(tm + 0, tacc0, __ATOMIC_RELAXED, __HIP_MEMORY_SCOPE_AGENT); __hip_atomic_fetch_add(tm + 1, tacc1, __ATOMIC_RELAXED, __HIP_MEMORY_SCOPE_AGENT);
        __hip_atomic_fetch_add(tm + 2, tacc2, __ATOMIC_RELAXED, __HIP_MEMORY_SCOPE_AGENT); __hip_atomic_fetch_add(tm + 3, tacc3, __ATOMIC_RELAXED, __HIP_MEMORY_SCOPE_AGENT);
        __hip_atomic_fetch_add(tm + 4, tacc4, __ATOMIC_RELAXED, __HIP_MEMORY_SCOPE_AGENT); __hip_atomic_fetch_add(tm + 5, tacc5, __ATOMIC_RELAXED, __HIP_MEMORY_SCOPE_AGENT);
        __hip_atomic_fetch_add(tm + 6, tacc6, __ATOMIC_RELAXED, __HIP_MEMORY_SCOPE_AGENT); __hip_atomic_fetch_add(tm + 7, tall, __ATOMIC_RELAXED, __HIP_MEMORY_SCOPE_AGENT); }
#endif
#undef TSTAMP
#undef TOK
}
struct BatchOrder {
    int base, cnt;
    DI bool next(int i, Unit& u) const { if (i >= cnt) return false; u.pm = base % (MG / 256); u.pn = (base / (MG / 256)) * cnt + i; return true; }
    DI void a_ready(const Unit&) const {}
    DI void done(const Unit&) const {}
};
constexpr int MG_BATCH = 4;
DI void p4_mixers(const Ctx& F, int l, int it) {
    const bool last = (l == DEPTH - 1);
    constexpr int N_SCAN = 2 * BGR * 4, N_MLA = BGR * 4 * 8, N_DF = BGR * 4 * 16, N_MLAC = BGR * 4, N_DFC = BGR * 4 * 2;
    constexpr int O_MLA = N_SCAN, O_DF = O_MLA + N_MLA, O_MLAC = O_DF + N_DF, O_DFC = O_MLAC + N_MLAC, N_ALL = O_DFC + N_DFC;
    constexpr int N_GEMM = 0;
    const int n_attn = last ? O_MLAC : N_ALL;
    const int total = n_attn + N_GEMM;
    GAS unsigned* head = F.ctl + CW_QUEUE + 64 * it;
    volatile LAS unsigned* misc = (volatile LAS unsigned*)(F.lds + LDS_MISC);
    for (;;) {
        __syncthreads();
        if ((int)threadIdx.x == 0) misc[0] = __hip_atomic_fetch_add(head, 1u, __ATOMIC_RELAXED, __HIP_MEMORY_SCOPE_AGENT);
        __syncthreads();
        int u = (int)misc[0];
        if (u >= total) break;
        if (u >= N_SCAN && u < N_SCAN + N_GEMM) {
            pg8::Gemm gm{(const gu16*)(F.ws + WS_H), (const gu16*)(F.ws + WS_WIN) + ((size_t)l * NP + C_MG) * 1024, MG, 4096, 1024, 1024};
            BatchOrder S{u - N_SCAN, MG_BATCH};
            EpiBf E{(gu16*)(F.ws + WS_P) + C_MG, NP, 2};
            pg8::gemm_phase<EpiBf, BatchOrder, true, true>(F.lds, gm, S, E);
            continue;
        }
#ifndef P4_MASK
#define P4_MASK 0xf
#endif
#ifndef REP_SCAN
#define REP_SCAN 1
#endif
#ifndef REP_MLA
#define REP_MLA 1
#endif
#ifndef REP_DF
#define REP_DF 1
#endif
        if (u >= N_SCAN) u -= N_GEMM;
        if (u < O_MLA) { const int mix = u >> 5, rem = u & 31, bl = rem >> 2, h = rem & 3;
            _Pragma("nounroll") for (int rep = 0; rep < REP_SCAN; ++rep) { if (mix == 0) { if (P4_MASK & 1) scan_unit<0>(F, l, bl, h); } else { if (P4_MASK & 2) scan_unit<1>(F, l, bl, h); } __syncthreads(); } }
        else if (u < O_DF) { const int v = u - O_MLA, bl = v >> 5, h = (v >> 3) & 3, qb = v & 7; _Pragma("nounroll") for (int rep = 0; rep < REP_MLA; ++rep) { if (P4_MASK & 4) attn_unit<0>(F, l, bl, h, NCTX + qb * 256, TT); __syncthreads(); } }
        else if (u < O_MLAC) { const int v = u - O_DF, bl = v >> 6, h = (v >> 4) & 3, qb = v & 15; _Pragma("nounroll") for (int rep = 0; rep < REP_DF; ++rep) { if (P4_MASK & 8) attn_unit<1>(F, l, bl, h, NCTX + qb * 128, TT); __syncthreads(); } }
        else if (u < O_DFC) { const int v = u - O_MLAC, bl = v >> 2, h = v & 3; if (P4_MASK & 4) attn_unit<0>(F, l, bl, h, 0, NCTX); }
        else { const int v = u - O_DFC, bl = v >> 3, h = (v >> 1) & 3, qb = v & 1; if (P4_MASK & 8) attn_unit<1>(F, l, bl, h, qb * 128, NCTX); }
    }
}

__global__ void __launch_bounds__(512, 2) fwd_kernel(Params prm) {
    extern __shared__ __attribute__((aligned(16))) unsigned char lds_raw[];
    Ctx F;
    F.in = prm.in;
    F.out = (gf32*)prm.out; F.ws = (gu8*)prm.ws; F.ctl = (GAS unsigned*)prm.ws;
    F.wave = __builtin_amdgcn_readfirstlane((int)threadIdx.x >> 6); F.G = gridDim.x;
    F.lds = (LAS unsigned char*)lds_raw;
    if ((int)threadIdx.x < 16) ((LAS unsigned*)(F.lds + LDS_MISC))[(int)threadIdx.x] = 0u;
    __syncthreads();
    XcdBarrier bar = xcd_barrier_post(F.ctl, (volatile LAS unsigned*)(F.lds + LDS_BARW));
    const int s_lo = prm.s_lo, s_hi = prm.s_hi;
#ifndef PH_MASK
#define PH_MASK 0xff
#endif
#define IN(s) (s_lo <= (s) && (s) < s_hi)
#define PHON(k) ((PH_MASK >> (k)) & 1)
#ifndef REP_P1
#define REP_P1 1
#endif
#ifndef REP_P2
#define REP_P2 1
#endif
#ifndef REP_P3G
#define REP_P3G 1
#endif
#ifndef REP_P3BG
#define REP_P3BG 1
#endif
#ifndef REP_P5
#define REP_P5 1
#endif
#ifndef REP_GATES
#define REP_GATES 1
#endif
#define FRESH() do { unsigned char* w_ = prm.ws; float* o_ = prm.out; asm volatile("" : "+s"(w_), "+s"(o_)); F.ws = (gu8*)w_; F.ctl = (GAS unsigned*)w_; F.out = (gf32*)o_; } while (0)
#ifdef TPROBE
    unsigned long long tph_prev = __builtin_amdgcn_s_memrealtime();
#define PSTAMP(k) do { if (blockIdx.x == 0 && threadIdx.x == 0) { const unsigned long long tn_ = __builtin_amdgcn_s_memrealtime(); __hip_atomic_fetch_add((GAS unsigned long long*)(F.ctl + 8192) + 16 + (k), tn_ - tph_prev, __ATOMIC_RELAXED, __HIP_MEMORY_SCOPE_AGENT); tph_prev = tn_; } } while (0)
#else
#define PSTAMP(k) do { } while (0)
#endif
#define SEAM(s) do { if ((s) + 1 < s_hi) { XcdBarrier b_ = bar; asm volatile("" : "+s"(b_.bar)); xcd_barrier(b_); } } while (0)
    if (PHON(0) && IN(0)) { FRESH(); p0_prologue(F); SEAM(0); PSTAMP(0); }
    for (int it = 0; it < DEPTH * NGRP; ++it) {
        const int l = it / NGRP, g = it % NGRP, sb = 1 + it * 7;
        if (sb + 7 <= s_lo || sb >= s_hi) continue;
        if (PHON(1) && IN(sb + 0)) { FRESH(); _Pragma("nounroll") for (int rep = 0; rep < REP_P1; ++rep) p1_norm(F, l, g); SEAM(sb + 0); PSTAMP(1); }
        if (PHON(2) && IN(sb + 1)) {
            FRESH(); gu16* Pb = (gu16*)(F.ws + WS_P);
            pg8::Gemm gm{(const gu16*)(F.ws + WS_H), (const gu16*)(F.ws + WS_WIN) + (size_t)l * NP * 1024, MG, NP, 1024, 1024};
            pg8::StaticOrder S; S.init(MG, NP, F.G, (int)blockIdx.x);
            EpiBf E{Pb, NP, 0};
            _Pragma("nounroll") for (int rep = 0; rep < REP_P2; ++rep) pg8::gemm_phase<EpiBf, pg8::StaticOrder, true, true>(F.lds, gm, S, E);
            SEAM(sb + 1); PSTAMP(2);
        }
        if (PHON(3) && IN(sb + 2)) {
            FRESH(); gu16* Pb = (gu16*)(F.ws + WS_P);
            _Pragma("nounroll") for (int rep = 0; rep < REP_P3G; ++rep) {
            { pg8::Gemm gm{Pb + C_CQ, (const gu16*)(F.ws + WS_WUQ) + (size_t)l * 768 * 384, MG, 768, 384, NP};
              pg8::StaticOrder S; S.init(MG, 768, F.G, (int)blockIdx.x);
              EpiBf E{(gu16*)(F.ws + WS_Q), 768, 0};
              pg8::gemm_phase<EpiBf, pg8::StaticOrder, true, true>(F.lds, gm, S, E); }
            { pg8::Gemm gm{Pb + C_CKV, (const gu16*)(F.ws + WS_WUKV) + (size_t)l * 1024 * 256, MG, 1024, 256, NP};
              int c2 = (int)blockIdx.x + 40; if (c2 >= F.G) c2 -= F.G;
              pg8::StaticOrder S; S.init(MG, 1024, F.G, c2);
              EpiBf E{(gu16*)(F.ws + WS_KV), 1024, 0};
              pg8::gemm_phase<EpiBf, pg8::StaticOrder, true, true>(F.lds, gm, S, E); }
            }
            __syncthreads();
            PSTAMP(11);
            p3_rows(F, l);
            PSTAMP(12);
            _Pragma("nounroll") for (int rep = 0; rep < REP_GATES; ++rep) p3_gates(F, l);
            PSTAMP(10);
            SEAM(sb + 2); PSTAMP(3);
        }
        if (PHON(4) && IN(sb + 3)) {
            FRESH();
            p3b_rows(F, l);
            _Pragma("nounroll") for (int rep = 0; rep < REP_P3BG; ++rep)
            { pg8::Gemm gm{(const gu16*)(F.ws + WS_XC), (const gu16*)(F.ws + WS_WQK) + (size_t)l * 512 * 512, MG, 512, 512, 512};
              pg8::StaticOrder S; S.init(MG, 512, F.G, (int)blockIdx.x);
              EpiBf E{(gu16*)(F.ws + WS_QKML), 512, 0};
              pg8::gemm_phase<EpiBf, pg8::StaticOrder, true, true>(F.lds, gm, S, E); }
            SEAM(sb + 3); PSTAMP(4);
        }
        if (PHON(5) && IN(sb + 4)) { FRESH(); p4_mixers(F, l, it); SEAM(sb + 4); PSTAMP(5); }
        if (PHON(6) && IN(sb + 5)) {
            FRESH(); gu16* Pb = (gu16*)(F.ws + WS_P);
#pragma nounroll
            for (int i4 = 0; i4 < 4 * REP_P5; ++i4) { const int i = i4 & 3;
                pg8::Gemm gm{(const gu16*)(F.ws + WS_Y) + (size_t)i * MG * 512, (const gu16*)(F.ws + WS_BR) + ((size_t)l * 4 + i) * 1024 * 512, MG, 1024, 512, 512};
                pg8::StaticOrder S; S.init(MG, 1024, F.G, (int)blockIdx.x);
                EpiMerge E{(gu16*)(F.ws + WS_MB), Pb + C_MG + i * 1024, i == 0 ? 0 : 1};
                pg8::gemm_phase<EpiMerge, pg8::StaticOrder, true, true>(F.lds, gm, S, E);
            }
            SEAM(sb + 5); PSTAMP(6);
        }
        if (PHON(7) && IN(sb + 6)) {
            FRESH();
            pg8::Gemm gm{(const gu16*)(F.ws + WS_MB), (const gu16*)(F.ws + WS_WO) + (size_t)l * 1024 * 1024, MG, 1024, 1024, 1024};
            pg8::StaticOrder S; S.init(MG, 1024, F.G, (int)blockIdx.x);
            EpiOut E{l == 0 ? FIN(0) : F.out, F.out, l == 0 ? FIN(2) : (const gf32*)(F.ws + WS_CTX), (gf32*)(F.ws + WS_CTX),
                     (const gf32*)(F.ws + WS_MOD) + (size_t)l * 33 * 3072, g, l == DEPTH - 1 ? 1 : 0};
            pg8::gemm_phase<EpiOut, pg8::StaticOrder, true, true>(F.lds, gm, S, E);
            SEAM(sb + 6); PSTAMP(7);
        }
    }
#ifdef TPROBE
    if (blockIdx.x == 0 && threadIdx.x == 0) {
        unsigned long long sum = 0;
#ifdef TPROBE_MASK
        for (int k = 0; k < 32; ++k) if ((TPROBE_MASK >> k) & 1) sum += __hip_atomic_load((GAS unsigned long long*)(F.ctl + 8192) + k, __ATOMIC_RELAXED, __HIP_MEMORY_SCOPE_AGENT);
#else
        sum = __hip_atomic_load((GAS unsigned long long*)(F.ctl + 8192) + TPROBE, __ATOMIC_RELAXED, __HIP_MEMORY_SCOPE_AGENT);
#endif
        const unsigned long long delay = sum * TPROBE_AMP / 512ull; const unsigned long long t0 = __builtin_amdgcn_s_memrealtime();
        while (__builtin_amdgcn_s_memrealtime() - t0 < delay) __builtin_amdgcn_s_sleep(8);
    }
#endif
#undef IN
#undef SEAM
}

extern "C" void kernel_launch(void* const* d_in, const int* in_sizes, int n_in, void* d_out, int out_size, void* d_ws, size_t ws_size, hipStream_t stream) {
    static int grid = 0;
    if (grid == 0) {
        if (n_in != 29 || out_size != NB * SEQ * DM || ws_size < WS_END) { fprintf(stderr, "kernel_launch: unexpected shapes (n_in %d, out %d, ws %zu < %zu)\n", n_in, out_size, ws_size, (size_t)WS_END); grid = -1; return; }
        int dev = 0, cus = 0, per_cu = 0;
        if (hipGetDevice(&dev) != hipSuccess || hipDeviceGetAttribute(&cus, hipDeviceAttributeMultiprocessorCount, dev) != hipSuccess) { grid = -1; return; }
        if (hipFuncSetAttribute((const void*)fwd_kernel, hipFuncAttributeMaxDynamicSharedMemorySize, LDS_BYTES) != hipSuccess) { fprintf(stderr, "kernel_launch: hipFuncSetAttribute failed\n"); grid = -1; return; }
        if (hipOccupancyMaxActiveBlocksPerMultiprocessor(&per_cu, (const void*)fwd_kernel, 512, LDS_BYTES) != hipSuccess || per_cu < 1) { fprintf(stderr, "kernel_launch: occupancy query reports %d blocks per CU\n", per_cu); }
        (void)hipGetLastError();
        grid = cus;
    }
    if (grid < 0) return;
    (void)hipMemsetAsync((char*)d_ws + WS_CTL, 0, CTL_BYTES, stream);
    Params p{};
    for (int i = 0; i < 29; ++i) p.in[i] = (const float*)d_in[i];
    p.out = (float*)d_out; p.ws = (unsigned char*)d_ws;
#if MK_MULTI
    for (int s = 0; s < NSTEP; ++s) { p.s_lo = s; p.s_hi = s + 1; hipLaunchKernelGGL(fwd_kernel, dim3(grid), dim3(512), LDS_BYTES, stream, p); }
#else
    p.s_lo = 0; p.s_hi = NSTEP;
    hipLaunchKernelGGL(fwd_kernel, dim3(grid), dim3(512), LDS_BYTES, stream, p);
#endif
    const hipError_t le = hipPeekAtLastError();
    if (le != hipSuccess) fprintf(stderr, "kernel_launch: launch failed: %s\n", hipGetErrorName(le));
}
```
